# Optimizing an MI355X kernel written in HIP

```python
import jax, jax.numpy as jnp
from jax import lax
import numpy as np

D_MODEL = 1024
BATCH = 8
SEQ = 2048
DEPTH = 4
DEC_BATCH = 128
DEC_SEQ = 1
PAST_LEN = 16384
PAGE_SIZE = 128

N_MIXERS = 3
N_RGLRU = len(range(0, DEPTH, N_MIXERS))
N_GDN = len(range(1, DEPTH, N_MIXERS))
N_SSD = len(range(2, DEPTH, N_MIXERS))
CONV_W = 4
EPS = 1e-6
MLP_HIDDEN = 4 * D_MODEL
RG_WIDTH = D_MODEL
RG_BLOCK = 256
RG_BLOCKS = RG_WIDTH // RG_BLOCK
RG_C = 8.0
GDN_DK = 128
GDN_DV = 128
GDN_HEADS = D_MODEL // GDN_DK
GDN_QKV = GDN_HEADS * (2 * GDN_DK + GDN_DV)
GDN_IN = GDN_QKV + GDN_HEADS * GDN_DV + 2 * GDN_HEADS
GDN_CHUNK = 64
SSM_D_INNER = 2 * D_MODEL
SSM_HEADDIM = 64
SSM_HEADS = SSM_D_INNER // SSM_HEADDIM
SSM_STATE = 128
SSM_GROUPS = 4
SSM_HPG = SSM_HEADS // SSM_GROUPS
SSM_CONV_DIM = SSM_D_INNER + 2 * SSM_GROUPS * SSM_STATE
SSM_IN = SSM_D_INNER + SSM_CONV_DIM + SSM_HEADS
SSM_CHUNK = 64

kernel_name = 'hybrid_rglru_gdn_ssd_adaln_step'

F32 = jnp.float32


def rmsnorm(x):
    xf = x.astype(F32)
    return (xf * lax.rsqrt(jnp.mean(xf * xf, axis=-1, keepdims=True) + EPS)).astype(x.dtype)


def l2norm(x):
    xf = x.astype(F32)
    return xf * lax.rsqrt(jnp.sum(xf * xf, axis=-1, keepdims=True) + EPS)


def causal_conv(x, buf, w, b=None):
    L = x.shape[1]
    xp = jnp.concatenate([buf.astype(x.dtype), x], axis=1)
    y = xp[:, 0:L] * w[0]
    for k in range(1, CONV_W):
        y = y + xp[:, k:k + L] * w[k]
    if b is not None:
        y = y + b
    return y, xp[:, L:]


def lin_combine(left, right):
    a_l, b_l = left
    a_r, b_r = right
    return a_l * a_r, a_r * b_l + b_r


def rglru_mixer(u, conv_buf, h0, w_in, conv_w, conv_b, gate_w, gate_b, lam, w_out):
    Bsz, L, _ = u.shape
    proj = u @ w_in
    y_br = jax.nn.gelu(proj[..., :RG_WIDTH])
    x_br, new_buf = causal_conv(proj[..., RG_WIDTH:], conv_buf, conv_w, conv_b)
    xb = x_br.reshape(Bsz, L, RG_BLOCKS, RG_BLOCK)
    gates = jnp.einsum('blnj,gnjk->gblnk', xb, gate_w).reshape(2, Bsz, L, RG_WIDTH) + gate_b[:, None, None, :]
    r = jax.nn.sigmoid(gates[0].astype(F32))
    i = jax.nn.sigmoid(gates[1].astype(F32))
    log_a = RG_C * r * jax.nn.log_sigmoid(lam.astype(F32))
    a = jnp.exp(log_a)
    bx = jnp.sqrt(-jnp.expm1(2.0 * log_a)) * i * x_br.astype(F32)
    a_cum, b_cum = lax.associative_scan(lin_combine, (a, bx), axis=1)
    h = a_cum * h0.astype(F32)[:, None, :] + b_cum
    out = (h.astype(u.dtype) * y_br) @ w_out
    return out, new_buf, h[:, -1]


def gated_delta_chunked(q, k, v, g, beta, S0):
    Bsz, L, H, DK = q.shape
    DV = v.shape[-1]
    C = GDN_CHUNK if L % GDN_CHUNK == 0 else L
    n = L // C

    def chunks(t):
        return t.astype(F32).reshape(Bsz, n, C, H, -1).transpose(0, 3, 1, 2, 4)

    q, k, v = chunks(q), chunks(k), chunks(v)
    g = g.reshape(Bsz, n, C, H).transpose(0, 3, 1, 2)
    beta = beta.reshape(Bsz, n, C, H).transpose(0, 3, 1, 2)
    G = jnp.cumsum(g, axis=-1)
    causal = jnp.tril(jnp.ones((C, C), dtype=bool))
    strict = jnp.tril(jnp.ones((C, C), dtype=bool), -1)
    diff = G[..., :, None] - G[..., None, :]
    decay = jnp.where(causal, jnp.exp(jnp.where(causal, diff, 0.0)), 0.0)
    kb = k * beta[..., None]
    A = jnp.where(strict, jnp.einsum('bhnik,bhnjk->bhnij', kb, k) * decay, 0.0)
    lhs = A + jnp.eye(C, dtype=F32)
    rhs = jnp.concatenate([v * beta[..., None], kb * jnp.exp(G)[..., None]], axis=-1)
    sol = lax.linalg.triangular_solve(lhs, rhs, left_side=True, lower=True)
    U, W = sol[..., :DV], sol[..., DV:]
    qk = jnp.einsum('bhnik,bhnjk->bhnij', q, k) * decay
    q_dec = q * jnp.exp(G)[..., None]
    k_dec = k * jnp.exp(G[..., -1:] - G)[..., None]
    g_last = jnp.exp(G[..., -1])

    def step(S, inp):
        U_c, W_c, qk_c, qd_c, kd_c, gl_c = inp
        v_new = U_c - jnp.einsum('bhck,bhkv->bhcv', W_c, S)
        o_c = jnp.einsum('bhck,bhkv->bhcv', qd_c, S) + jnp.einsum('bhij,bhjv->bhiv', qk_c, v_new)
        S = gl_c[..., None, None] * S + jnp.einsum('bhck,bhcv->bhkv', kd_c, v_new)
        return S, o_c

    mv = lambda t: jnp.moveaxis(t, 2, 0)
    S_fin, o = lax.scan(step, S0.astype(F32), (mv(U), mv(W), mv(qk), mv(q_dec), mv(k_dec), mv(g_last)))
    o = o.transpose(1, 0, 3, 2, 4).reshape(Bsz, L, H, DV)
    return o, S_fin


def gdn_mixer(u, conv_buf, S0, w_in, conv_w, A_log, dt_bias, norm_g, w_out):
    Bsz, L, _ = u.shape
    HK = GDN_HEADS * GDN_DK
    HV = GDN_HEADS * GDN_DV
    proj = u @ w_in
    qkv = proj[..., :GDN_QKV]
    gate = proj[..., GDN_QKV:GDN_QKV + HV]
    a_in = proj[..., GDN_QKV + HV:GDN_QKV + HV + GDN_HEADS]
    b_in = proj[..., GDN_QKV + HV + GDN_HEADS:]
    qkv, new_buf = causal_conv(qkv, conv_buf, conv_w)
    qkv = jax.nn.silu(qkv)
    q = l2norm(qkv[..., :HK].reshape(Bsz, L, GDN_HEADS, GDN_DK)) * (GDN_DK ** -0.5)
    k = l2norm(qkv[..., HK:2 * HK].reshape(Bsz, L, GDN_HEADS, GDN_DK))
    v = qkv[..., 2 * HK:].reshape(Bsz, L, GDN_HEADS, GDN_DV)
    beta = jax.nn.sigmoid(b_in.astype(F32))
    g = -jnp.exp(A_log.astype(F32)) * jax.nn.softplus(a_in.astype(F32) + dt_bias)
    o, S_fin = gated_delta_chunked(q, k, v, g, beta, S0)
    o = rmsnorm(o.astype(u.dtype)) * norm_g * jax.nn.silu(gate.reshape(Bsz, L, GDN_HEADS, GDN_DV))
    return o.reshape(Bsz, L, HV) @ w_out, new_buf, S_fin


def ssd_chunked(x, dt, A, Bm, Cm, h0):
    Bsz, L, H, P = x.shape
    C = SSM_CHUNK if L % SSM_CHUNK == 0 else L
    n = L // C
    G, Hg, N = SSM_GROUPS, SSM_HPG, SSM_STATE
    x = x.astype(F32).reshape(Bsz, n, C, G, Hg, P)
    dt = dt.reshape(Bsz, n, C, G, Hg)
    Bm = Bm.astype(F32).reshape(Bsz, n, C, G, N)
    Cm = Cm.astype(F32).reshape(Bsz, n, C, G, N)
    a = (dt * A.reshape(G, Hg)).transpose(0, 1, 3, 4, 2)
    Acs = jnp.cumsum(a, axis=-1)
    causal = jnp.tril(jnp.ones((C, C), dtype=bool))
    seg = Acs[..., :, None] - Acs[..., None, :]
    Lmat = jnp.where(causal, jnp.exp(jnp.where(causal, seg, 0.0)), 0.0)
    xdt = x * dt[..., None]
    CB = jnp.einsum('bnlgd,bnsgd->bngls', Cm, Bm)
    y_diag = jnp.einsum('bnghls,bnsghp->bnlghp', CB[:, :, :, None] * Lmat, xdt)
    decay_states = jnp.exp(Acs[..., -1:] - Acs)
    states = jnp.einsum('bnsgd,bnghs,bnsghp->bnghpd', Bm, decay_states, xdt)
    chunk_decay = jnp.exp(Acs[..., -1])

    def step(h, inp):
        dec_c, st_c = inp
        return dec_c[..., None, None] * h + st_c, h

    h_fin, h_prev = lax.scan(step, h0.astype(F32).reshape(Bsz, G, Hg, P, N),
                             (jnp.moveaxis(chunk_decay, 1, 0), jnp.moveaxis(states, 1, 0)))
    h_prev = jnp.moveaxis(h_prev, 0, 1)
    y_off = jnp.einsum('bnlgd,bnghpd,bnghl->bnlghp', Cm, h_prev, jnp.exp(Acs))
    y = (y_diag + y_off).reshape(Bsz, L, H, P)
    return y, h_fin.reshape(Bsz, H, P, N)


def ssd_mixer(u, conv_buf, h0, w_in, conv_w, conv_b, A_log, dt_bias, D_skip, norm_g, w_out):
    Bsz, L, _ = u.shape
    GN = SSM_GROUPS * SSM_STATE
    proj = u @ w_in
    z = proj[..., :SSM_D_INNER]
    xBC = proj[..., SSM_D_INNER:SSM_D_INNER + SSM_CONV_DIM]
    dt_in = proj[..., SSM_D_INNER + SSM_CONV_DIM:]
    xBC, new_buf = causal_conv(xBC, conv_buf, conv_w, conv_b)
    xBC = jax.nn.silu(xBC)
    xs = xBC[..., :SSM_D_INNER].reshape(Bsz, L, SSM_HEADS, SSM_HEADDIM)
    Bm = xBC[..., SSM_D_INNER:SSM_D_INNER + GN].reshape(Bsz, L, SSM_GROUPS, SSM_STATE)
    Cm = xBC[..., SSM_D_INNER + GN:].reshape(Bsz, L, SSM_GROUPS, SSM_STATE)
    dt = jax.nn.softplus(dt_in.astype(F32) + dt_bias)
    A = -jnp.exp(A_log.astype(F32))
    y, h_fin = ssd_chunked(xs, dt, A, Bm, Cm, h0)
    y = y + D_skip[:, None] * xs.astype(F32)
    y = (y.reshape(Bsz, L, SSM_D_INNER) * jax.nn.silu(z.astype(F32))).astype(u.dtype)
    y = rmsnorm(y.reshape(Bsz, L, SSM_GROUPS, SSM_D_INNER // SSM_GROUPS)).reshape(Bsz, L, SSM_D_INNER) * norm_g
    return y @ w_out, new_buf, h_fin


def sq_relu_mlp(u, w_up, w_down):
    h = jax.nn.relu(u @ w_up)
    return (h * h) @ w_down


def trunk(x, c, rg_conv, rg_h, gdn_conv, gdn_S, ssd_conv, ssd_h, p):
    new_rg_conv, new_rg_h, new_gdn_conv, new_gdn_S, new_ssd_conv, new_ssd_h = [], [], [], [], [], []
    for i in range(DEPTH):
        j = i // N_MIXERS
        mod = jax.nn.silu(c) @ p['w_mod'][i] + p['b_mod'][i]
        sh1, sc1, g1, sh2, sc2, g2 = jnp.split(mod[:, None, :], 6, axis=-1)
        u = rmsnorm(x) * (1.0 + sc1) + sh1
        kind = i % N_MIXERS
        if kind == 0:
            out, cb, st = rglru_mixer(u, rg_conv[j], rg_h[j], p['rg_w_in'][j], p['rg_conv_w'][j], p['rg_conv_b'][j],
                                      p['rg_gate_w'][j], p['rg_gate_b'][j], p['rg_lambda'][j], p['rg_w_out'][j])
            new_rg_conv.append(cb)
            new_rg_h.append(st)
        elif kind == 1:
            out, cb, st = gdn_mixer(u, gdn_conv[j], gdn_S[j], p['gdn_w_in'][j], p['gdn_conv_w'][j], p['gdn_A_log'][j],
                                    p['gdn_dt_bias'][j], p['gdn_norm_g'][j], p['gdn_w_out'][j])
            new_gdn_conv.append(cb)
            new_gdn_S.append(st)
        else:
            out, cb, st = ssd_mixer(u, ssd_conv[j], ssd_h[j], p['ssd_w_in'][j], p['ssd_conv_w'][j], p['ssd_conv_b'][j],
                                    p['ssd_A_log'][j], p['ssd_dt_bias'][j], p['ssd_D'][j], p['ssd_norm_g'][j], p['ssd_w_out'][j])
            new_ssd_conv.append(cb)
            new_ssd_h.append(st)
        x = x + g1 * out
        u = rmsnorm(x) * (1.0 + sc2) + sh2
        x = x + g2 * sq_relu_mlp(u, p['w_mlp_up'][i], p['w_mlp_down'][i])
    y = rmsnorm(x) * p['final_norm_g']
    return (y, jnp.stack(new_rg_conv), jnp.stack(new_rg_h), jnp.stack(new_gdn_conv), jnp.stack(new_gdn_S),
            jnp.stack(new_ssd_conv), jnp.stack(new_ssd_h))


def setup_inputs(seed: int = 0) -> dict:
    key = jax.random.key(seed)
    ks = iter(jax.random.split(key, 48))

    def nrm(shape, scale):
        return jax.random.normal(next(ks), shape, F32) * scale

    def unif(shape, lo, hi):
        return jax.random.uniform(next(ks), shape, F32, lo, hi)

    def dt_bias_init(shape):
        dt = jnp.exp(unif(shape, float(np.log(1e-3)), float(np.log(1e-1))))
        return dt + jnp.log(-jnp.expm1(-dt))

    D = D_MODEL
    s_lam = unif((N_RGLRU, RG_WIDTH), 0.9, 0.999)
    return {
        'x_prompt': nrm((BATCH, SEQ, D), 1.0),
        'x_sample': nrm((DEC_BATCH, DEC_SEQ, D), 1.0),
        'state_rglru_conv': nrm((N_RGLRU, DEC_BATCH, CONV_W - 1, RG_WIDTH), 1.0),
        'state_rglru_h': nrm((N_RGLRU, DEC_BATCH, RG_WIDTH), 0.5),
        'state_gdn_conv': nrm((N_GDN, DEC_BATCH, CONV_W - 1, GDN_QKV), 1.0),
        'state_gdn_S': nrm((N_GDN, DEC_BATCH, GDN_HEADS, GDN_DK, GDN_DV), 0.1),
        'state_ssd_conv': nrm((N_SSD, DEC_BATCH, CONV_W - 1, SSM_CONV_DIM), 1.0),
        'state_ssd_h': nrm((N_SSD, DEC_BATCH, SSM_HEADS, SSM_HEADDIM, SSM_STATE), 0.1),
        'c_prompt': nrm((BATCH, D), 1.0),
        'c_sample': nrm((DEC_BATCH, D), 1.0),
        'w_mod': nrm((DEPTH, D, 6 * D), D ** -0.5),
        'b_mod': nrm((DEPTH, 6 * D), 0.02),
        'w_mlp_up': nrm((DEPTH, D, MLP_HIDDEN), D ** -0.5),
        'w_mlp_down': nrm((DEPTH, MLP_HIDDEN, D), MLP_HIDDEN ** -0.5),
        'final_norm_g': 1.0 + nrm((D,), 0.02),
        'rg_w_in': nrm((N_RGLRU, D, 2 * RG_WIDTH), D ** -0.5),
        'rg_conv_w': nrm((N_RGLRU, CONV_W, RG_WIDTH), CONV_W ** -0.5),
        'rg_conv_b': nrm((N_RGLRU, RG_WIDTH), 0.02),
        'rg_gate_w': nrm((N_RGLRU, 2, RG_BLOCKS, RG_BLOCK, RG_BLOCK), RG_BLOCK ** -0.5),
        'rg_gate_b': nrm((N_RGLRU, 2, RG_WIDTH), 0.02),
        'rg_lambda': jnp.log(s_lam) - jnp.log1p(-s_lam),
        'rg_w_out': nrm((N_RGLRU, RG_WIDTH, D), RG_WIDTH ** -0.5),
        'gdn_w_in': nrm((N_GDN, D, GDN_IN), D ** -0.5),
        'gdn_conv_w': nrm((N_GDN, CONV_W, GDN_QKV), CONV_W ** -0.5),
        'gdn_A_log': jnp.log(unif((N_GDN, GDN_HEADS), 1.0, 16.0)),
        'gdn_dt_bias': dt_bias_init((N_GDN, GDN_HEADS)),
        'gdn_norm_g': 1.0 + nrm((N_GDN, GDN_DV), 0.02),
        'gdn_w_out': nrm((N_GDN, GDN_HEADS * GDN_DV, D), (GDN_HEADS * GDN_DV) ** -0.5),
        'ssd_w_in': nrm((N_SSD, D, SSM_IN), D ** -0.5),
        'ssd_conv_w': nrm((N_SSD, CONV_W, SSM_CONV_DIM), CONV_W ** -0.5),
        'ssd_conv_b': nrm((N_SSD, SSM_CONV_DIM), 0.02),
        'ssd_A_log': jnp.log(unif((N_SSD, SSM_HEADS), 1.0, 16.0)),
        'ssd_dt_bias': dt_bias_init((N_SSD, SSM_HEADS)),
        'ssd_D': 1.0 + nrm((N_SSD, SSM_HEADS), 0.02),
        'ssd_norm_g': 1.0 + nrm((N_SSD, SSM_D_INNER), 0.02),
        'ssd_w_out': nrm((N_SSD, SSM_D_INNER, D), SSM_D_INNER ** -0.5),
    }


def reference(x_prompt, x_sample, state_rglru_conv, state_rglru_h, state_gdn_conv, state_gdn_S,
              state_ssd_conv, state_ssd_h, c_prompt, c_sample, w_mod, b_mod, w_mlp_up, w_mlp_down,
              final_norm_g, rg_w_in, rg_conv_w, rg_conv_b, rg_gate_w, rg_gate_b, rg_lambda, rg_w_out,
              gdn_w_in, gdn_conv_w, gdn_A_log, gdn_dt_bias, gdn_norm_g, gdn_w_out,
              ssd_w_in, ssd_conv_w, ssd_conv_b, ssd_A_log, ssd_dt_bias, ssd_D, ssd_norm_g, ssd_w_out):
    p = dict(w_mod=w_mod, b_mod=b_mod, w_mlp_up=w_mlp_up, w_mlp_down=w_mlp_down, final_norm_g=final_norm_g,
             rg_w_in=rg_w_in, rg_conv_w=rg_conv_w, rg_conv_b=rg_conv_b, rg_gate_w=rg_gate_w, rg_gate_b=rg_gate_b,
             rg_lambda=rg_lambda, rg_w_out=rg_w_out, gdn_w_in=gdn_w_in, gdn_conv_w=gdn_conv_w, gdn_A_log=gdn_A_log,
             gdn_dt_bias=gdn_dt_bias, gdn_norm_g=gdn_norm_g, gdn_w_out=gdn_w_out, ssd_w_in=ssd_w_in,
             ssd_conv_w=ssd_conv_w, ssd_conv_b=ssd_conv_b, ssd_A_log=ssd_A_log, ssd_dt_bias=ssd_dt_bias,
             ssd_D=ssd_D, ssd_norm_g=ssd_norm_g, ssd_w_out=ssd_w_out)
    Bp = x_prompt.shape[0]
    dtp = x_prompt.dtype
    z_rg_conv = jnp.zeros((N_RGLRU, Bp, CONV_W - 1, RG_WIDTH), dtp)
    z_rg_h = jnp.zeros((N_RGLRU, Bp, RG_WIDTH), dtp)
    z_gdn_conv = jnp.zeros((N_GDN, Bp, CONV_W - 1, GDN_QKV), dtp)
    z_gdn_S = jnp.zeros((N_GDN, Bp, GDN_HEADS, GDN_DK, GDN_DV), dtp)
    z_ssd_conv = jnp.zeros((N_SSD, Bp, CONV_W - 1, SSM_CONV_DIM), dtp)
    z_ssd_h = jnp.zeros((N_SSD, Bp, SSM_HEADS, SSM_HEADDIM, SSM_STATE), dtp)
    (y_prompt, p_rg_conv, p_rg_h, p_gdn_conv, p_gdn_S, p_ssd_conv, p_ssd_h) = trunk(
        x_prompt, c_prompt, z_rg_conv, z_rg_h, z_gdn_conv, z_gdn_S, z_ssd_conv, z_ssd_h, p)
    (y_sample, s_rg_conv, s_rg_h, s_gdn_conv, s_gdn_S, s_ssd_conv, s_ssd_h) = trunk(
        x_sample, c_sample, state_rglru_conv, state_rglru_h, state_gdn_conv, state_gdn_S,
        state_ssd_conv, state_ssd_h, p)
    return (y_prompt, y_sample, p_rg_conv, p_rg_h, p_gdn_conv, p_gdn_S, p_ssd_conv, p_ssd_h,
            s_rg_conv, s_rg_h, s_gdn_conv, s_gdn_S, s_ssd_conv, s_ssd_h)
```

```cpp
#include <hip/hip_runtime.h>
#include <hip/hip_cooperative_groups.h>
#include <cstdio>
namespace cg = cooperative_groups;
namespace pg8 {
#define PG8_LAS __attribute__((address_space(3)))
typedef unsigned short bf16_t;
typedef short bf16x8 __attribute__((ext_vector_type(8)));
typedef float f32x4 __attribute__((ext_vector_type(4)));
typedef unsigned u32x4 __attribute__((ext_vector_type(4)));
constexpr int BM = 256, BK = 64, HALF = 128, HTB = HALF * BK * 2  , STAGE_BYTES = 8 * HTB, NXCD = 8, WGM = 8;

__host__ __device__ __forceinline__ int lds_byte(int r, int c) { const int st = (r >> 4) * 2 + (c >> 5), rr = r & 15, cc = c & 31, ob = rr * 64 + cc * 2; return st * 1024 + (ob ^ (((ob >> 9) & 1) << 5)); }
__host__ __device__ __forceinline__ void stage_rc(int b, int& R, int& C) { const int st = b / 1024, sb = b % 1024, swz = sb ^ (((sb >> 9) & 1) << 5); R = (st >> 1) * 16 + swz / 64; C = (st & 1) * 32 + (swz % 64) / 2; }
__host__ __device__ __forceinline__ int perm32(int rho) { const int n = rho >> 4, i = rho & 15; return 8 * (i >> 2) + 4 * n + (i & 3); }

struct Unit { int pm, pn; };
struct Gemm { const bf16_t* A; const bf16_t* Bt; int M, N, K, lda, ldb, ksh, kmul; };

struct StaticOrder {
    int nM, nN, nwg, G, c;
    __host__ __device__ void init(int M, int N, int G_, int c_) { nM = M / BM; nN = N / BM; nwg = nM * nN; G = G_; c = c_; }
    __host__ __device__ bool next(int i, Unit& u) const {
        const long L = (long)i * G + c; if (L >= nwg) return false;
        int wgid = (int)L; { const int q = nwg / NXCD, r = nwg % NXCD, xcd = wgid % NXCD, off = wgid / NXCD; wgid = (xcd < r ? xcd * (q + 1) : r * (q + 1) + (xcd - r) * q) + off; }
        const int nig = WGM * nN, gid = wgid / nig, fm = gid * WGM, gsz = (nM - fm) < WGM ? (nM - fm) : WGM;
        u.pm = fm + ((wgid % nig) % gsz); u.pn = (wgid % nig) / gsz; return true;
    }
    __device__ __forceinline__ void a_ready(const Unit&) const {}
    __device__ __forceinline__ void done(const Unit&) const {}
};
__device__ __forceinline__ unsigned cvt_pk_bf16(float lo, float hi) { unsigned r; asm volatile("v_cvt_pk_bf16_f32 %0, %1, %2" : "=v"(r) : "v"(lo), "v"(hi)); return r; }
typedef float f32x2 __attribute__((ext_vector_type(2)));
template <class Epi, class Sched>
__device__ __forceinline__ void gemm_phase(PG8_LAS unsigned char* lds, const Gemm g, const Sched& S, const Epi& E, const int tid_in) {
    const int tid = tid_in, wid = __builtin_amdgcn_readfirstlane(tid >> 6), lane = tid & 63, wr = wid >> 2, wc = wid & 3, fr = lane & 15, fq = lane >> 4;
    const int K = g.K, nt = K / BK;

    unsigned voffA[2], voffB[2];
#pragma unroll
    for (int i = 0; i < 2; ++i) { int R, C; stage_rc(tid * 16 + i * 8192, R, C); const int Rb = Epi::PERM ? ((R & ~31) + perm32(R & 31)) : R;
        voffA[i] = (unsigned)(R * g.lda + C) * 2u; voffB[i] = (unsigned)(Rb * g.ldb + C) * 2u; }
    const size_t kstep = (size_t)(BK * 2);
    const size_t hstepA = (size_t)HALF * g.lda * 2, hstepB = (size_t)HALF * g.ldb * 2;
    const size_t tstepA = 2 * hstepA, tstepB = 2 * hstepB;
    const unsigned ldsw = (unsigned)wid * 1024u;
    const int aoff = lds_byte(wr * 64 + fr, fq * 8), boff = lds_byte(wc * 32 + fr, fq * 8);
#define PG8_SA(b, h) (((b) * 2 + (h)) * HTB)
#define PG8_SB(b, h) ((4 + (b) * 2 + (h)) * HTB)
#define PG8_STAGE(bufoff, gbase, voff) do { _Pragma("unroll") for (int _i = 0; _i < 2; ++_i) \
        __builtin_amdgcn_global_load_lds((const unsigned*)((const char*)(gbase) + (voff)[_i]), (PG8_LAS unsigned*)(lds + (bufoff) + ldsw + _i * 8192), 16, 0, 0); } while (0)
#define PG8_LDA(dst, b, h) do { _Pragma("unroll") for (int m = 0; m < 4; ++m) _Pragma("unroll") for (int k = 0; k < 2; ++k) dst[m][k] = *(const PG8_LAS bf16x8*)(lds + PG8_SA(b, h) + aoff + m * 2048 + k * 1024); } while (0)
#define PG8_LDB(dst, b, h) do { _Pragma("unroll") for (int n = 0; n < 2; ++n) _Pragma("unroll") for (int k = 0; k < 2; ++k) dst[n][k] = *(const PG8_LAS bf16x8*)(lds + PG8_SB(b, h) + boff + n * 2048 + k * 1024); } while (0)
#define PG8_MMA(ai, bj, At, Bt) do { __builtin_amdgcn_s_setprio(1); _Pragma("unroll") for (int m = 0; m < 4; ++m) _Pragma("unroll") for (int n = 0; n < 2; ++n) _Pragma("unroll") for (int k = 0; k < 2; ++k) \
        acc[ai][bj][m][n] = __builtin_amdgcn_mfma_f32_16x16x32_bf16(Bt[n][k], At[m][k], acc[ai][bj][m][n], 0, 0, 0); __builtin_amdgcn_s_setprio(0); } while (0)
#define PG8_WAIT_V(n) asm volatile("s_waitcnt vmcnt(" #n ")" ::: "memory")
#define PG8_WAIT_L(n) asm volatile("s_waitcnt lgkmcnt(" #n ")" ::: "memory")
#define PG8_BAR __builtin_amdgcn_s_barrier()
#define PG8_SCHED __builtin_amdgcn_sched_barrier(0)
    Unit cur, nxt; int ui = 0;
    if (!S.next(0, cur)) return;
    f32x4 acc[2][2][4][2];
#pragma unroll
    for (int a = 0; a < 2; ++a)
#pragma unroll
        for (int b = 0; b < 2; ++b)
#pragma unroll
            for (int m = 0; m < 4; ++m)
#pragma unroll
                for (int n = 0; n < 2; ++n) acc[a][b][m][n] = (f32x4){0.f, 0.f, 0.f, 0.f};
    bf16x8 At[4][2], B0[2][2], B1[2][2];
    const char* cA = (const char*)g.A + (size_t)cur.pm * tstepA + (size_t)((cur.pn >> g.ksh) * g.kmul) * 2; const char* cB = (const char*)g.Bt + (size_t)cur.pn * tstepB;
    S.a_ready(cur);
    PG8_STAGE(PG8_SB(0, 0), cB, voffB); PG8_STAGE(PG8_SA(0, 0), cA, voffA); PG8_STAGE(PG8_SB(0, 1), cB + hstepB, voffB); PG8_STAGE(PG8_SA(0, 1), cA + hstepA, voffA);
    if (wr == 1) PG8_BAR;
    PG8_WAIT_V(4); PG8_BAR;
    PG8_STAGE(PG8_SB(1, 0), cB + kstep, voffB); PG8_STAGE(PG8_SA(1, 0), cA + kstep, voffA); PG8_STAGE(PG8_SB(1, 1), cB + hstepB + kstep, voffB);
    PG8_WAIT_V(6); PG8_BAR;

    for (;;) {
        const bool has_next = S.next(ui + 1, nxt);
        const char* nA = has_next ? (const char*)g.A + (size_t)nxt.pm * tstepA + (size_t)((nxt.pn >> g.ksh) * g.kmul) * 2 : cA; const char* nB = has_next ? (const char*)g.Bt + (size_t)nxt.pn * tstepB : cB;
        for (int t = 0; t < nt; t += 2) {
            const bool last = (t == nt - 2);
            const char* a1 = cA + (size_t)(t + 1) * kstep;
            const char* a2 = last ? nA : cA + (size_t)(t + 2) * kstep; const char* b2 = last ? nB : cB + (size_t)(t + 2) * kstep;
            const char* a3 = a2 + kstep; const char* b3 = b2 + kstep;
            if (last && has_next) S.a_ready(nxt);
            PG8_LDB(B0, 0, 0); PG8_SCHED; PG8_LDA(At, 0, 0); PG8_STAGE(PG8_SA(1, 1), a1 + hstepA, voffA);
            PG8_WAIT_L(8); PG8_BAR; PG8_WAIT_L(0); PG8_MMA(0, 0, At, B0); PG8_BAR; PG8_SCHED;
            PG8_LDB(B1, 0, 1); PG8_STAGE(PG8_SB(0, 0), b2, voffB);
            PG8_BAR; PG8_WAIT_L(0); PG8_MMA(0, 1, At, B1); PG8_BAR;
            PG8_LDA(At, 0, 1); PG8_STAGE(PG8_SA(0, 0), a2, voffA);
            PG8_BAR; PG8_WAIT_L(0); PG8_MMA(1, 0, At, B0); PG8_BAR; PG8_SCHED;
            PG8_STAGE(PG8_SB(0, 1), b2 + hstepB, voffB);
            PG8_WAIT_V(6); PG8_BAR; PG8_MMA(1, 1, At, B1); PG8_BAR;
            PG8_LDB(B0, 1, 0); PG8_SCHED; PG8_LDA(At, 1, 0); PG8_STAGE(PG8_SA(0, 1), a2 + hstepA, voffA);
            PG8_WAIT_L(8); PG8_BAR; PG8_WAIT_L(0); PG8_MMA(0, 0, At, B0); PG8_BAR; PG8_SCHED;
            PG8_LDB(B1, 1, 1); PG8_STAGE(PG8_SB(1, 0), b3, voffB);
            PG8_BAR; PG8_WAIT_L(0); PG8_MMA(0, 1, At, B1); PG8_BAR;
            PG8_LDA(At, 1, 1); PG8_STAGE(PG8_SA(1, 0), a3, voffA);
            PG8_BAR; PG8_WAIT_L(0); PG8_MMA(1, 0, At, B0); PG8_BAR; PG8_SCHED;
            PG8_STAGE(PG8_SB(1, 1), b3 + hstepB, voffB);
            PG8_WAIT_V(6); PG8_BAR; PG8_MMA(1, 1, At, B1); PG8_BAR;
        }

        if constexpr (!Epi::AFTER_DRAIN) { E(acc, cur, wr, wc, fr, fq); S.done(cur); }

        if (!has_next) break;
#pragma unroll
        for (int a = 0; a < 2; ++a)
#pragma unroll
            for (int b = 0; b < 2; ++b)
#pragma unroll
                for (int m = 0; m < 4; ++m)
#pragma unroll
                    for (int n = 0; n < 2; ++n) acc[a][b][m][n] = (f32x4){0.f, 0.f, 0.f, 0.f};
        cur = nxt; cA = nA; cB = nB; ++ui;
    }
    PG8_WAIT_V(0);
    if (wr == 0) PG8_BAR;
    PG8_BAR;
    if constexpr (Epi::AFTER_DRAIN) { E.fused(acc, cur, wr, wc, fr, fq, lds, wid, lane); S.done(cur); }

#undef PG8_SA
#undef PG8_SB
#undef PG8_STAGE
#undef PG8_LDA
#undef PG8_LDB
#undef PG8_MMA
#undef PG8_WAIT_V
#undef PG8_WAIT_L
#undef PG8_BAR
#undef PG8_SCHED
}
}
using pg8::bf16_t; using pg8::bf16x8; using pg8::f32x4; using pg8::u32x4; using pg8::f32x2;
typedef unsigned u32x2 __attribute__((ext_vector_type(2)));
#define LAS __attribute__((address_space(3)))
typedef LAS unsigned char* ldsp;
#define DI __device__ __forceinline__
#define MFMA16(a, b, c) __builtin_amdgcn_mfma_f32_16x16x32_bf16((a), (b), (c), 0, 0, 0)

constexpr int D = 1024, NP = 16384, NS = 128, NR = NP + NS, RP = 16640, SEQL = 2048, NSEQ = 136, MODW = 6144;
constexpr int GDN_N = 4112, GDN_NP = 4352, SSD_N = 5152, SSD_NP = 5376;
constexpr float EPS = 1e-6f;
constexpr int LDS_BYTES = 132096;
constexpr size_t al256(size_t x) { return (x + 255) & ~(size_t)255; }
constexpr size_t WS_WUP = 0;
constexpr size_t WS_WDN = WS_WUP + (size_t)4 * 4096 * 1024 * 2;
constexpr size_t WS_RGIN = WS_WDN + (size_t)4 * 4096 * 1024 * 2;
constexpr size_t WS_RGGATE = WS_RGIN + (size_t)2 * 2048 * 1024 * 2;
constexpr size_t WS_RGOUT = WS_RGGATE + (size_t)2 * 2048 * 256 * 2;
constexpr size_t WS_GDNIN = WS_RGOUT + (size_t)2 * 1024 * 1024 * 2;
constexpr size_t WS_GDNOUT = WS_GDNIN + (size_t)GDN_NP * 1024 * 2;
constexpr size_t WS_SSDIN = WS_GDNOUT + (size_t)1024 * 1024 * 2;
constexpr size_t WS_SSDOUT = WS_SSDIN + (size_t)SSD_NP * 1024 * 2;
constexpr size_t WS_SC = WS_SSDOUT + (size_t)1024 * 2048 * 2;
constexpr size_t WS_MOD = WS_SC + (size_t)256 * 1024 * 2;
constexpr size_t WS_AB = al256(WS_MOD + (size_t)4 * NSEQ * MODW * 4);
constexpr size_t WS_GB = WS_AB + (size_t)RP * 16 * 4;
constexpr size_t WS_DTR = WS_GB + (size_t)RP * 16 * 4;
constexpr size_t WS_DT = WS_DTR + (size_t)RP * 32 * 4;
constexpr size_t WS_GL = WS_DT + (size_t)RP * 32 * 4;
constexpr size_t WS_XSN = WS_GL + 2048 * 4;
constexpr size_t WS_QKVS = WS_XSN + (size_t)128 * 2048 * 2;
constexpr size_t WS_LS8 = WS_QKVS + (size_t)3 * 128 * 1024 * 2;
constexpr size_t WS_X = al256(WS_LS8 + 2 * 1024 * 4);
constexpr size_t WS_UB = WS_X + (size_t)RP * 1024 * 4;
constexpr size_t WS_P = WS_UB + (size_t)RP * 1024 * 2;
constexpr size_t P_BYTES = (size_t)RP * 5120 * 2;
constexpr size_t WS_S = WS_P + P_BYTES;
constexpr size_t S_BYTES = (size_t)RP * 1024 * 10;
constexpr size_t WS_END = WS_S + S_BYTES;
constexpr int O_Y = 0, O_PRGC = 16908288, O_PRGH = O_PRGC + 49152, O_PGDC = O_PRGH + 16384, O_PGDS = O_PGDC + 73728, O_PSSC = O_PGDS + 1048576, O_PSSH = O_PSSC + 73728,
              O_SRGC = O_PSSH + 2097152, O_SRGH = O_SRGC + 786432, O_SGDC = O_SRGH + 262144, O_SGDS = O_SGDC + 1179648, O_SSSC = O_SGDS + 16777216, O_SSSH = O_SSSC + 1179648;

struct Args { const float* in[36]; float* out; unsigned char* ws; int lo, hi; };
struct Ctx { ldsp lds; int tid, lane, wave, bid, G; };

DI float bf2f(unsigned short b) { return __uint_as_float(((unsigned)b) << 16); }
DI unsigned f2bf(float f) { unsigned u = __float_as_uint(f); return (u + 0x7fffu + ((u >> 16) & 1u)) >> 16; }
DI unsigned pk2(float lo, float hi) { return f2bf(lo) | (f2bf(hi) << 16); }
DI float lo16(unsigned w) { return __uint_as_float(w << 16); }
DI float hi16(unsigned w) { return __uint_as_float(w & 0xffff0000u); }
DI void unpack8(u32x4 w, float* f) { f[0] = lo16(w.x); f[1] = hi16(w.x); f[2] = lo16(w.y); f[3] = hi16(w.y); f[4] = lo16(w.z); f[5] = hi16(w.z); f[6] = lo16(w.w); f[7] = hi16(w.w); }
DI u32x4 pack8(const float* f) { u32x4 w; w.x = pk2(f[0], f[1]); w.y = pk2(f[2], f[3]); w.z = pk2(f[4], f[5]); w.w = pk2(f[6], f[7]); return w; }
DI float sigmoidf_(float x) { return 1.0f / (1.0f + __expf(-x)); }
DI float siluf_(float x) { return x / (1.0f + __expf(-x)); }
DI float softplusf_(float x) { return x > 20.f ? x : log1pf(__expf(x)); }
DI float gelu_tanh(float x) { const float y = 1.5957691216f * (x + 0.044715f * x * x * x); return x / (1.0f + __expf(-y)); }
DI float wave_sum(float v) {
#pragma unroll
    for (int o = 1; o < 64; o <<= 1) v += __shfl_xor(v, o);
    return v;
}
DI int seq_of(int row) { int q = row < NP ? (row >> 11) : 8 + row - NP; return q > NSEQ - 1 ? NSEQ - 1 : q; }

struct EpiMod {
    static constexpr bool PERM = false, AFTER_DRAIN = false;
    float* MOD; const float* bias;
    DI void operator()(const f32x4 (&acc)[2][2][4][2], const pg8::Unit& u, int wr, int wc, int fr, int fq) const {
        const int row0 = u.pm * 256 + wr * 64 + fr, col0 = u.pn * 256 + wc * 32 + 4 * fq;
#pragma unroll
        for (int ai = 0; ai < 2; ++ai)
#pragma unroll
            for (int m = 0; m < 4; ++m) { const int row = row0 + ai * 128 + m * 16;
                if (row < NSEQ) {
#pragma unroll
                    for (int bj = 0; bj < 2; ++bj)
#pragma unroll
                        for (int n = 0; n < 2; ++n) { const int col = col0 + bj * 128 + n * 16, layer = col / MODW, c = col - layer * MODW;
                            *(f32x4*)(MOD + ((size_t)layer * NSEQ + row) * MODW + c) = acc[ai][bj][m][n] + *(const f32x4*)(bias + col); } } }
    }
};
struct EpiRes {
    static constexpr bool PERM = false, AFTER_DRAIN = false;
    const float* bp; const float* bs; float* X; const float* gate;
    DI void operator()(const f32x4 (&acc)[2][2][4][2], const pg8::Unit& u, int wr, int wc, int fr, int fq) const {
        const int row0 = u.pm * 256 + wr * 64 + fr, col0 = u.pn * 256 + wc * 32 + 4 * fq;
#pragma unroll
        for (int ai = 0; ai < 2; ++ai)
#pragma unroll
            for (int m = 0; m < 4; ++m) { const int row = row0 + ai * 128 + m * 16;
                if (row < NR) { const float* base = row < NP ? bp + (size_t)row * D : bs + (size_t)(row - NP) * D; const float* gp = gate + (size_t)seq_of(row) * MODW; float* o = X + (size_t)row * D;
#pragma unroll
                    for (int bj = 0; bj < 2; ++bj)
#pragma unroll
                        for (int n = 0; n < 2; ++n) { const int col = col0 + bj * 128 + n * 16;
                            *(f32x4*)(o + col) = *(const f32x4*)(base + col) + *(const f32x4*)(gp + col) * acc[ai][bj][m][n]; } } }
    }
};
struct EpiSplit {
    static constexpr bool PERM = true, AFTER_DRAIN = false;
    int act; bf16_t* O0; int ld0, b1; bf16_t* O1; int ld1, b2; float* F; int ldf, ntail;
    DI void operator()(const f32x4 (&acc)[2][2][4][2], const pg8::Unit& u, int wr, int wc, int fr, int fq) const {
        const int row0 = u.pm * 256 + wr * 64 + fr; const int colt = u.pn * 256;
        if (colt >= b2) {
            const int c0 = colt - b2 + wc * 32 + 8 * fq;
#pragma unroll
            for (int ai = 0; ai < 2; ++ai)
#pragma unroll
                for (int m = 0; m < 4; ++m) { const int row = row0 + ai * 128 + m * 16;
#pragma unroll
                    for (int bj = 0; bj < 2; ++bj)
#pragma unroll
                        for (int n = 0; n < 2; ++n) { const int c = c0 + bj * 128 + 4 * n; if (c < ntail) *(f32x4*)(F + (size_t)row * ldf + c) = acc[ai][bj][m][n]; } }
            return;
        }
        const bool s0 = colt < b1; bf16_t* base = s0 ? O0 : O1; const int ld = s0 ? ld0 : ld1; const int col0 = (s0 ? colt : colt - b1) + wc * 32 + 8 * fq;
#pragma unroll
        for (int ai = 0; ai < 2; ++ai)
#pragma unroll
            for (int m = 0; m < 4; ++m) { bf16_t* rowp = base + (size_t)(row0 + ai * 128 + m * 16) * ld + col0;
#pragma unroll
                for (int bj = 0; bj < 2; ++bj) { f32x4 v0 = acc[ai][bj][m][0], v1 = acc[ai][bj][m][1];
                    if (act == 1 && s0) {
#pragma unroll
                        for (int j = 0; j < 4; ++j) { v0[j] = gelu_tanh(v0[j]); v1[j] = gelu_tanh(v1[j]); } }
                    if (act == 2) {
#pragma unroll
                        for (int j = 0; j < 4; ++j) { const float a = fmaxf(v0[j], 0.f), b = fmaxf(v1[j], 0.f); v0[j] = a * a; v1[j] = b * b; } }
                    u32x4 w; w.x = pg8::cvt_pk_bf16(v0[0], v0[1]); w.y = pg8::cvt_pk_bf16(v0[2], v0[3]); w.z = pg8::cvt_pk_bf16(v1[0], v1[1]); w.w = pg8::cvt_pk_bf16(v1[2], v1[3]);
                    *(u32x4*)(rowp + bj * 128) = w; } }
    }
};
struct EpiGate {
    static constexpr bool PERM = false, AFTER_DRAIN = false;
    const bf16_t* XB; const float* gb; const float* ls8; float* LA; float* BX;
    DI void operator()(const f32x4 (&acc)[2][2][4][2], const pg8::Unit& u, int wr, int wc, int fr, int fq) const {
        const int row0 = u.pm * 256 + wr * 64 + fr, ch0 = u.pn * 128 + wc * 32 + 4 * fq;
#pragma unroll
        for (int n = 0; n < 2; ++n) { const int ch = ch0 + n * 16; const f32x4 br = *(const f32x4*)(gb + ch), bi = *(const f32x4*)(gb + D + ch), ls = *(const f32x4*)(ls8 + ch);
#pragma unroll
            for (int ai = 0; ai < 2; ++ai)
#pragma unroll
                for (int m = 0; m < 4; ++m) { const int row = row0 + ai * 128 + m * 16;
                    if (row < NR) { const u32x2 xw = *(const u32x2*)(XB + (size_t)row * D + ch);
                        const float xb[4] = {lo16(xw.x), hi16(xw.x), lo16(xw.y), hi16(xw.y)}; f32x4 la, bx;
#pragma unroll
                        for (int j = 0; j < 4; ++j) { const float r = sigmoidf_(acc[ai][0][m][n][j] + br[j]), ig = sigmoidf_(acc[ai][1][m][n][j] + bi[j]);
                            const float l = r * ls[j], a = __expf(l); la[j] = l; bx[j] = sqrtf(fmaxf(1.0f - a * a, 0.f)) * ig * xb[j]; }
                        *(f32x4*)(LA + (size_t)row * D + ch) = la; *(f32x4*)(BX + (size_t)row * D + ch) = bx; } } }
    }
};
DI void transpose_item(const float* W, int K, int N, bf16_t* WT, int row_off, LAS float* scr, int kb, int nb, int lane) {
    const int k0 = 64 * kb, n0 = 32 * nb; const int nn = n0 + (lane & 31); const bool ok = nn < N;
#pragma unroll 8
    for (int i = 0; i < 32; ++i) { const int kk = 2 * i + (lane >> 5); scr[kk * 33 + (lane & 31)] = ok ? W[(size_t)(k0 + kk) * N + nn] : 0.f; }
    asm volatile("s_waitcnt lgkmcnt(0)" ::: "memory");
    const int c = lane & 7;
#pragma unroll
    for (int j = 0; j < 4; ++j) { const int n = (lane >> 3) + 8 * j; const LAS float* s = scr + (8 * c) * 33 + n;
        u32x4 o; o.x = pk2(s[0 * 33], s[1 * 33]); o.y = pk2(s[2 * 33], s[3 * 33]); o.z = pk2(s[4 * 33], s[5 * 33]); o.w = pk2(s[6 * 33], s[7 * 33]);
        if (n0 + n < N) *(u32x4*)(WT + (size_t)(row_off + n0 + n) * K + k0 + 8 * c) = o; }
    asm volatile("s_waitcnt lgkmcnt(0)" ::: "memory");
}
struct TJob { const float* W; bf16_t* WT; int K, N, mode, aux; };
DI void prep_phase(const Ctx& c, const Args& a) {
    unsigned char* ws = a.ws;
    LAS TJob* jobs = (LAS TJob*)(c.lds + 131072 - 4096); LAS int* cum = (LAS int*)(c.lds + 131072 - 512);
    constexpr int NJ = 40;
    if (c.tid == 0) {
        int j = 0;
        auto add = [&](const float* W, bf16_t* WT, int K, int N, int mode, int aux) { jobs[j].W = W; jobs[j].WT = WT; jobs[j].K = K; jobs[j].N = N; jobs[j].mode = mode; jobs[j].aux = aux; ++j; };
        for (int i = 0; i < 4; ++i) add(a.in[10] + (size_t)i * 1024 * MODW, (bf16_t*)(ws + WS_P) + (size_t)i * MODW * 1024, 1024, MODW, 0, 0);
        for (int i = 0; i < 4; ++i) add(a.in[12] + (size_t)i * 1024 * 4096, (bf16_t*)(ws + WS_WUP) + (size_t)i * 4096 * 1024, 1024, 4096, 0, 0);
        for (int i = 0; i < 4; ++i) add(a.in[13] + (size_t)i * 1024 * 4096, (bf16_t*)(ws + WS_WDN) + (size_t)i * 4096 * 1024, 4096, 1024, 0, 0);
        for (int i = 0; i < 2; ++i) add(a.in[15] + (size_t)i * 1024 * 2048, (bf16_t*)(ws + WS_RGIN) + (size_t)i * 2048 * 1024, 1024, 2048, 0, 0);
        for (int i = 0; i < 16; ++i) add(a.in[18] + (size_t)i * 65536, (bf16_t*)(ws + WS_RGGATE) + (size_t)(i >> 3) * 2048 * 256, 256, 256, 1, i & 7);
        for (int i = 0; i < 2; ++i) add(a.in[21] + (size_t)i * 1024 * 1024, (bf16_t*)(ws + WS_RGOUT) + (size_t)i * 1024 * 1024, 1024, 1024, 0, 0);
        add(a.in[22], (bf16_t*)(ws + WS_GDNIN), 1024, GDN_N, 0, 0);
        add(a.in[27], (bf16_t*)(ws + WS_GDNOUT), 1024, 1024, 0, 0);
        add(a.in[28], (bf16_t*)(ws + WS_SSDIN), 1024, SSD_N, 0, 0);
        add(a.in[35], (bf16_t*)(ws + WS_SSDOUT), 2048, 1024, 0, 0);
        int s = 0; for (int i = 0; i < NJ; ++i) { if (i < j) s += (jobs[i].K / 64) * ((jobs[i].N + 31) / 32); cum[i] = s; }
    }
    __syncthreads();
    const int total = cum[NJ - 1]; const int gw = c.bid * 8 + c.wave, NGW = c.G * 8;
    LAS float* scr = (LAS float*)(c.lds + c.wave * 8704);
    for (int it = gw; it < total; it += NGW) {
        int j = 0; while (cum[j] <= it) ++j;
        const int r = it - (j ? cum[j - 1] : 0); const int K = jobs[j].K, N = jobs[j].N, nblk = (N + 31) / 32, kb = r / nblk, nb = r % nblk;
        int row_off = 0;
        if (jobs[j].mode == 1) { const int g = jobs[j].aux >> 2, blk = jobs[j].aux & 3, n0 = nb * 32; row_off = 256 * (2 * blk + (n0 >> 7)) + 128 * g + (n0 & 127) - n0; }
        transpose_item(jobs[j].W, K, N, jobs[j].WT, row_off, scr, kb, nb, c.lane);
    }
    const int gt = c.bid * 512 + c.tid, NT = c.G * 512;
    bf16_t* SC = (bf16_t*)(ws + WS_SC);
    for (int i = gt; i < 256 * 128; i += NT) { const int row = i >> 7, c8 = (i & 127) * 8; float f[8];
        if (row < NSEQ) { const float* src = row < 8 ? a.in[8] + row * D + c8 : a.in[9] + (row - 8) * D + c8;
#pragma unroll
            for (int e = 0; e < 8; ++e) f[e] = siluf_(src[e]); }
        else {
#pragma unroll
            for (int e = 0; e < 8; ++e) f[e] = 0.f; }
        *(u32x4*)(SC + (size_t)row * D + c8) = pack8(f); }
    for (int i = gt; i < 2 * D; i += NT) ((float*)(ws + WS_LS8))[i] = -8.0f * log1pf(__expf(-a.in[20][i]));
    const u32x4 z4 = {0u, 0u, 0u, 0u};
    for (int i = gt; i < (GDN_NP - GDN_N) * 128; i += NT) *(u32x4*)((bf16_t*)(ws + WS_GDNIN) + (size_t)GDN_N * 1024 + (size_t)i * 8) = z4;
    for (int i = gt; i < (SSD_NP - SSD_N) * 128; i += NT) *(u32x4*)((bf16_t*)(ws + WS_SSDIN) + (size_t)SSD_N * 1024 + (size_t)i * 8) = z4;
}

DI void norm_mod_phase(const Ctx& c, const float* xp, const float* xs, const float* sc, const float* sh, bf16_t* out) {
    for (int r = c.bid * 8 + c.wave; r < NR; r += c.G * 8) {
        const float* xr = r < NP ? xp + (size_t)r * D : xs + (size_t)(r - NP) * D; const int q = seq_of(r);
        f32x4 v[4]; float ss = 0.f;
#pragma unroll
        for (int j = 0; j < 4; ++j) { v[j] = *(const f32x4*)(xr + c.lane * 4 + 256 * j); ss += (v[j].x * v[j].x + v[j].y * v[j].y) + (v[j].z * v[j].z + v[j].w * v[j].w); }
        const float rstd = rsqrtf(wave_sum(ss) * (1.0f / D) + EPS);
#pragma unroll
        for (int j = 0; j < 4; ++j) { const int col = c.lane * 4 + 256 * j; const f32x4 s1 = *(const f32x4*)(sc + (size_t)q * MODW + col), s2 = *(const f32x4*)(sh + (size_t)q * MODW + col);
            const f32x4 o = v[j] * rstd * (s1 + 1.0f) + s2; u32x2 w; w.x = pk2(o.x, o.y); w.y = pk2(o.z, o.w); *(u32x2*)(out + (size_t)r * D + col) = w; }
    }
}
DI void final_norm_phase(const Ctx& c, const float* X, const float* g, float* out) {
    for (int r = c.bid * 8 + c.wave; r < NR; r += c.G * 8) {
        const float* xr = X + (size_t)r * D; f32x4 v[4]; float ss = 0.f;
#pragma unroll
        for (int j = 0; j < 4; ++j) { v[j] = *(const f32x4*)(xr + c.lane * 4 + 256 * j); ss += (v[j].x * v[j].x + v[j].y * v[j].y) + (v[j].z * v[j].z + v[j].w * v[j].w); }
        const float rstd = rsqrtf(wave_sum(ss) * (1.0f / D) + EPS);
#pragma unroll
        for (int j = 0; j < 4; ++j) { const int col = c.lane * 4 + 256 * j; *(f32x4*)(out + (size_t)r * D + col) = v[j] * rstd * *(const f32x4*)(g + col); }
    }
}

DI void conv8(const bf16_t* P, int ld, int row, int t, const float* st, int nch, const float* w, const float* b, int ch, float* f, float* cur) {
    float x[4][8];
    unpack8(*(const u32x4*)(P + (size_t)row * ld), x[3]);
#pragma unroll
    for (int k = 0; k < 3; ++k) {
        if (t < 0) { const f32x4 a0 = *(const f32x4*)(st + k * nch + ch), a1 = *(const f32x4*)(st + k * nch + ch + 4); x[k][0] = a0.x; x[k][1] = a0.y; x[k][2] = a0.z; x[k][3] = a0.w; x[k][4] = a1.x; x[k][5] = a1.y; x[k][6] = a1.z; x[k][7] = a1.w; }
        else if (t - 3 + k >= 0) unpack8(*(const u32x4*)(P + (size_t)(row - 3 + k) * ld), x[k]);
        else {
#pragma unroll
            for (int e = 0; e < 8; ++e) x[k][e] = 0.f; }
    }
#pragma unroll
    for (int e = 0; e < 8; ++e) { f[e] = b ? b[ch + e] : 0.f; cur[e] = x[3][e]; }
#pragma unroll
    for (int k = 0; k < 4; ++k) { const f32x4 w0 = *(const f32x4*)(w + k * nch + ch), w1 = *(const f32x4*)(w + k * nch + ch + 4);
        f[0] += x[k][0] * w0.x; f[1] += x[k][1] * w0.y; f[2] += x[k][2] * w0.z; f[3] += x[k][3] * w0.w; f[4] += x[k][4] * w1.x; f[5] += x[k][5] * w1.y; f[6] += x[k][6] * w1.z; f[7] += x[k][7] * w1.w; }
}
DI void conv_state8(int row, int t, const float* cur, const float* st, int nch, int ch, float* pout  , float* sout  ) {
    if (t >= 0) { if (t >= SEQL - 3) { float* o = pout + ((size_t)(row >> 11) * 3 + (t - (SEQL - 3))) * nch + ch; *(f32x4*)o = (f32x4){cur[0], cur[1], cur[2], cur[3]}; *(f32x4*)(o + 4) = (f32x4){cur[4], cur[5], cur[6], cur[7]}; } }
    else { const int s = row - NP; float* o = sout + (size_t)s * 3 * nch + ch;
        *(f32x4*)o = *(const f32x4*)(st + nch + ch); *(f32x4*)(o + 4) = *(const f32x4*)(st + nch + ch + 4);
        *(f32x4*)(o + nch) = *(const f32x4*)(st + 2 * nch + ch); *(f32x4*)(o + nch + 4) = *(const f32x4*)(st + 2 * nch + ch + 4);
        *(f32x4*)(o + 2 * nch) = (f32x4){cur[0], cur[1], cur[2], cur[3]}; *(f32x4*)(o + 2 * nch + 4) = (f32x4){cur[4], cur[5], cur[6], cur[7]}; }
}

DI void rg_conv_phase(const Ctx& c, const bf16_t* P  , const float* cw, const float* cb, const float* st  , bf16_t* XB, float* pout, float* sout) {
    for (int i = c.bid * 512 + c.tid; i < NR * 128; i += c.G * 512) {
        const int row = i >> 7, ch = (i & 127) * 8; const int t = row < NP ? (row & (SEQL - 1)) : -1;
        const float* sp = t < 0 ? st + (size_t)(row - NP) * 3 * D : nullptr;
        float f[8], cur[8]; conv8(P + 1024 + ch, 2048, row, t, sp, D, cw, cb, ch, f, cur);
        *(u32x4*)(XB + (size_t)row * D + ch) = pack8(f);
        conv_state8(row, t, cur, sp, D, ch, pout, sout);
    }
}
DI void rg_scan_phase(const Ctx& c, const float* LA, const float* BX, const bf16_t* P  , const float* h0  , bf16_t* HY, float* ph  , float* sh  ) {
    LAS float* sA = (LAS float*)c.lds; LAS float* sB = sA + 512;
    for (int it = c.bid; it < 256; it += c.G) {
        const int b = it >> 5, ch = (it & 31) * 32 + (c.tid & 31), seg = c.tid >> 5; const int r0 = b * SEQL + seg * 128;
        float h = 0.f, ap = 0.f;
        for (int t = 0; t < 128; ++t) { const size_t o = (size_t)(r0 + t) * D + ch; const float la = LA[o], bx = BX[o]; h = __expf(la) * h + bx; ap += la; }
        sA[c.tid] = __expf(ap); sB[c.tid] = h;
        __syncthreads();
        float hin = 0.f;
        for (int s = 0; s < seg; ++s) hin = sA[s * 32 + (c.tid & 31)] * hin + sB[s * 32 + (c.tid & 31)];
        h = hin;
        for (int t = 0; t < 128; ++t) { const size_t o = (size_t)(r0 + t) * D + ch; const float la = LA[o], bx = BX[o]; h = __expf(la) * h + bx;
            HY[o] = (bf16_t)f2bf(h * bf2f(P[(size_t)(r0 + t) * 2048 + ch])); }
        if (seg == 15) ph[b * D + ch] = h;
        __syncthreads();
    }
    for (int i = c.bid * 512 + c.tid; i < NS * D; i += c.G * 512) { const int s = i >> 10, ch = i & 1023; const size_t o = (size_t)(NP + s) * D + ch;
        const float h = __expf(LA[o]) * h0[i] + BX[o]; sh[i] = h; HY[o] = (bf16_t)f2bf(h * bf2f(P[(size_t)(NP + s) * 2048 + ch])); }
}
DI void gdn_conv_phase(const Ctx& c, const bf16_t* P, const float* cw  , const float* st  , const float* AB, const float* A_log, const float* dt_bias,
                       bf16_t* Q, bf16_t* K, bf16_t* V, bf16_t* QKVS, float* GB, float* pout, float* sout) {
    for (int row = c.bid * 8 + c.wave; row < NR; row += c.G * 8) {
        const int t = row < NP ? (row & (SEQL - 1)) : -1; const float* sp = t < 0 ? st + (size_t)(row - NP) * 3 * 3072 : nullptr;
#pragma unroll 1
        for (int pass = 0; pass < 6; ++pass) {
            const int ch = pass * 512 + c.lane * 8; float f[8], cur[8];
            conv8(P + ch, 3072, row, t, sp, 3072, cw, nullptr, ch, f, cur);
            conv_state8(row, t, cur, sp, 3072, ch, pout, sout);
            float ss = 0.f;
#pragma unroll
            for (int e = 0; e < 8; ++e) { f[e] = siluf_(f[e]); ss += f[e] * f[e]; }
            if (pass < 4) { ss += __shfl_xor(ss, 1); ss += __shfl_xor(ss, 2); ss += __shfl_xor(ss, 4); ss += __shfl_xor(ss, 8);
                const float sc = rsqrtf(ss + EPS) * (pass < 2 ? 0.08838834764831845f : 1.0f);
#pragma unroll
                for (int e = 0; e < 8; ++e) f[e] *= sc; }
            bf16_t* dst = t >= 0 ? (pass < 2 ? Q : (pass < 4 ? K : V)) + (size_t)row * D : QKVS + ((size_t)(pass >> 1) * NS + (row - NP)) * D;
            *(u32x4*)(dst + (pass & 1) * 512 + c.lane * 8) = pack8(f);
        }
        if (c.lane < 8) { const float a_in = AB[(size_t)row * 16 + c.lane], b_in = AB[(size_t)row * 16 + 8 + c.lane];
            GB[(size_t)row * 16 + c.lane] = -__expf(A_log[c.lane]) * softplusf_(a_in + dt_bias[c.lane]); GB[(size_t)row * 16 + 8 + c.lane] = sigmoidf_(b_in); }
    }
}
DI void gdn_prep_phase(const Ctx& c, const bf16_t* Q, const bf16_t* K, const bf16_t* V, const float* GB, float* UT, bf16_t* NW, bf16_t* QD, bf16_t* KDT, bf16_t* QKG, float* GL) {
    const int half = c.tid >> 8, t = c.tid & 255, w4 = c.wave & 3, lr = c.lane & 15, quad = c.lane >> 4;
    ldsp L = c.lds + half * 65536; ldsp kS = L, qS = L + 17408; LAS float* AT = (LAS float*)(L + 34816); LAS float* Gs = (LAS float*)(L + 51200); LAS float* Bs = Gs + 64; LAS float* EGs = Gs + 128;
    for (int pair = c.bid; pair < 1024; pair += c.G) {
        const int item = pair * 2 + half, n = item & 31, h = (item >> 5) & 7, b = item >> 8, r0 = b * SEQL + n * 64;
        if (t < 64) { float G = GB[(size_t)(r0 + t) * 16 + h]; const float be = GB[(size_t)(r0 + t) * 16 + 8 + h];
#pragma unroll
            for (int o = 1; o < 64; o <<= 1) { const float v = __shfl_up(G, o); if (c.lane >= o) G += v; }
            Gs[t] = G; Bs[t] = be; EGs[t] = __expf(G); }
#pragma unroll
        for (int i = 0; i < 4; ++i) { const int ci = t + i * 256, row = ci >> 4, cc = ci & 15; const size_t go = (size_t)(r0 + row) * D + h * 128 + cc * 8;
            *(LAS u32x4*)(kS + row * 272 + cc * 16) = *(const u32x4*)(K + go); *(LAS u32x4*)(qS + row * 272 + cc * 16) = *(const u32x4*)(Q + go); }
        __syncthreads();
        {
            const int ib = w4; float Gi[4], bi[4];
#pragma unroll
            for (int jj = 0; jj < 4; ++jj) { Gi[jj] = Gs[ib * 16 + quad * 4 + jj]; bi[jj] = Bs[ib * 16 + quad * 4 + jj]; }
            bf16_t* qkg = QKG + (size_t)item * 4096;
#pragma unroll 1
            for (int jb = 0; jb < 4; ++jb) {
                if (jb <= ib) {
                    f32x4 akk = {0.f, 0.f, 0.f, 0.f}, aqk = {0.f, 0.f, 0.f, 0.f};
#pragma unroll
                    for (int ks = 0; ks < 4; ++ks) { const bf16x8 ak = *(const LAS bf16x8*)(kS + (ib * 16 + lr) * 272 + ks * 64 + quad * 16), aq = *(const LAS bf16x8*)(qS + (ib * 16 + lr) * 272 + ks * 64 + quad * 16),
                                                                  bk = *(const LAS bf16x8*)(kS + (jb * 16 + lr) * 272 + ks * 64 + quad * 16);
                        akk = MFMA16(ak, bk, akk); aqk = MFMA16(aq, bk, aqk); }
                    const int j = jb * 16 + lr; const float Gj = Gs[j]; f32x4 av;
#pragma unroll
                    for (int jj = 0; jj < 4; ++jj) { const int i = ib * 16 + quad * 4 + jj; const float dec = i >= j ? __expf(Gi[jj] - Gj) : 0.f;
                        av[jj] = i > j ? bi[jj] * akk[jj] * dec : 0.f; qkg[i * 64 + j] = (bf16_t)f2bf(aqk[jj] * dec); }
                    *(LAS f32x4*)(AT + j * 64 + ib * 16 + quad * 4) = av;
                } else {
#pragma unroll
                    for (int jj = 0; jj < 4; ++jj) qkg[(ib * 16 + quad * 4 + jj) * 64 + jb * 16 + lr] = 0;
                }
            }
        }
#pragma unroll
        for (int i = 0; i < 4; ++i) { const int ci = t + i * 256, row = ci >> 4, cc = ci & 15; float f[8]; unpack8(*(const LAS u32x4*)(qS + row * 272 + cc * 16), f); const float eg = EGs[row];
#pragma unroll
            for (int e = 0; e < 8; ++e) f[e] *= eg;
            *(u32x4*)(QD + (size_t)(r0 + row) * D + h * 128 + cc * 8) = pack8(f); }
        { const int dk = t & 127, chf = t >> 7; const float Gl = Gs[63];
#pragma unroll
            for (int c8 = 0; c8 < 4; ++c8) { const int c0 = chf * 32 + c8 * 8; float f[8];
#pragma unroll
                for (int e = 0; e < 8; ++e) f[e] = bf2f(*(const LAS bf16_t*)(kS + (c0 + e) * 272 + dk * 2)) * __expf(Gl - Gs[c0 + e]);
                *(u32x4*)(KDT + ((size_t)item * 128 + dk) * 64 + c0) = pack8(f); }
            if (t == 0) GL[item] = __expf(Gl); }
        __syncthreads();
#pragma unroll
        for (int i = 0; i < 4; ++i) { const int ci = t + i * 256, row = ci >> 4, cc = ci & 15; *(LAS u32x4*)(qS + row * 272 + cc * 16) = *(const u32x4*)(V + (size_t)(r0 + row) * D + h * 128 + cc * 8); }
        __syncthreads();
        {
            float x[64];
            if (t < 128) {
#pragma unroll
                for (int i = 0; i < 64; ++i) x[i] = bf2f(*(const LAS bf16_t*)(qS + i * 272 + t * 2)) * Bs[i];
            } else {
#pragma unroll
                for (int i = 0; i < 64; ++i) x[i] = bf2f(*(const LAS bf16_t*)(kS + i * 272 + (t - 128) * 2)) * Bs[i] * EGs[i];
            }
#pragma unroll
            for (int j = 0; j < 63; ++j) {
#pragma unroll
                for (int i4 = ((j + 1) & ~3); i4 < 64; i4 += 4) { const f32x4 av = *(const LAS f32x4*)(AT + j * 64 + i4);
                    if (i4 + 0 > j) x[i4 + 0] -= av.x * x[j];
                    if (i4 + 1 > j) x[i4 + 1] -= av.y * x[j];
                    if (i4 + 2 > j) x[i4 + 2] -= av.z * x[j];
                    if (i4 + 3 > j) x[i4 + 3] -= av.w * x[j]; }
            }
            __syncthreads();
            if (t < 128) { float* o = UT + ((size_t)item * 128 + t) * 64;
#pragma unroll
                for (int i = 0; i < 16; ++i) *(f32x4*)(o + 4 * i) = (f32x4){x[4 * i], x[4 * i + 1], x[4 * i + 2], x[4 * i + 3]};
            } else {
#pragma unroll
                for (int i = 0; i < 64; ++i) *(LAS bf16_t*)(kS + i * 272 + (t - 128) * 2) = (bf16_t)f2bf(-x[i]);
            }
        }
        __syncthreads();
#pragma unroll
        for (int i = 0; i < 4; ++i) { const int ci = t + i * 256, row = ci >> 4, cc = ci & 15; *(u32x4*)(NW + (size_t)(r0 + row) * D + h * 128 + cc * 8) = *(const LAS u32x4*)(kS + row * 272 + cc * 16); }
        __syncthreads();
    }
}
DI void gdn_seq_phase(const Ctx& c, const float* UT, const bf16_t* NW, const bf16_t* QD, const bf16_t* KDT, const bf16_t* QKG, const float* GL, float* O, float* pS,
                      const bf16_t* QKVS, const float* GB, const float* S0, float* sS) {
    const int lr = c.lane & 15, quad = c.lane >> 4, w = c.wave;
    ldsp Ws = c.lds, Qs = c.lds + 17408, KTs = c.lds + 34816, QKs = c.lds + 53248, Sts = c.lds + 62464, VTs = c.lds + 71168;
    for (int item = c.bid; item < 256; item += c.G) {
        const int cb = item & 3, bh = item >> 2, b = bh >> 3, h = bh & 7, ci = w >> 1, vi = w & 1;
        f32x4 Sacc[2] = {{0.f, 0.f, 0.f, 0.f}, {0.f, 0.f, 0.f, 0.f}};
        for (int i = c.tid; i < 8704 / 4; i += 512) ((LAS unsigned*)Sts)[i] = 0u;
        u32x4 pf[7];
        auto fetch = [&](int n) { const int pit = bh * 32 + n, r0 = b * SEQL + n * 64;
#pragma unroll
            for (int i = 0; i < 2; ++i) { const int cidx = c.tid + i * 512, row = cidx >> 4, cc = cidx & 15; const size_t go = (size_t)(r0 + row) * D + h * 128 + cc * 8; pf[i] = *(const u32x4*)(NW + go); pf[2 + i] = *(const u32x4*)(QD + go); }
#pragma unroll
            for (int i = 0; i < 2; ++i) { const int cidx = c.tid + i * 512; pf[4 + i] = *(const u32x4*)(KDT + (size_t)pit * 8192 + cidx * 8); }
            pf[6] = *(const u32x4*)(QKG + (size_t)pit * 4096 + c.tid * 8); };
        auto stash = [&]() {
#pragma unroll
            for (int i = 0; i < 2; ++i) { const int cidx = c.tid + i * 512, row = cidx >> 4, cc = cidx & 15; *(LAS u32x4*)(Ws + row * 272 + cc * 16) = pf[i]; *(LAS u32x4*)(Qs + row * 272 + cc * 16) = pf[2 + i]; }
#pragma unroll
            for (int i = 0; i < 2; ++i) { const int cidx = c.tid + i * 512, row = cidx >> 3, cc = cidx & 7; *(LAS u32x4*)(KTs + row * 144 + cc * 16) = pf[4 + i]; }
            { const int row = c.tid >> 3, cc = c.tid & 7; *(LAS u32x4*)(QKs + row * 144 + cc * 16) = pf[6]; } };
        fetch(0); stash();
        __syncthreads();
#pragma unroll 1
        for (int n = 0; n < 32; ++n) {
            const int pit = bh * 32 + n, r0 = b * SEQL + n * 64;
            if (n + 1 < 32) fetch(n + 1);
            f32x4 acc = *(const f32x4*)(UT + ((size_t)pit * 128 + cb * 32 + vi * 16 + lr) * 64 + ci * 16 + quad * 4);
#pragma unroll
            for (int ks = 0; ks < 4; ++ks) acc = MFMA16(*(const LAS bf16x8*)(Ws + (ci * 16 + lr) * 272 + ks * 64 + quad * 16), *(const LAS bf16x8*)(Sts + (vi * 16 + lr) * 272 + ks * 64 + quad * 16), acc);
            { u32x2 wv; wv.x = pk2(acc[0], acc[1]); wv.y = pk2(acc[2], acc[3]); *(LAS u32x2*)(VTs + (vi * 16 + lr) * 144 + (ci * 16 + quad * 4) * 2) = wv; }
            __syncthreads();
            f32x4 ao = {0.f, 0.f, 0.f, 0.f};
#pragma unroll
            for (int ks = 0; ks < 4; ++ks) ao = MFMA16(*(const LAS bf16x8*)(Qs + (ci * 16 + lr) * 272 + ks * 64 + quad * 16), *(const LAS bf16x8*)(Sts + (vi * 16 + lr) * 272 + ks * 64 + quad * 16), ao);
#pragma unroll
            for (int ks = 0; ks < 2; ++ks) ao = MFMA16(*(const LAS bf16x8*)(QKs + (ci * 16 + lr) * 144 + ks * 64 + quad * 16), *(const LAS bf16x8*)(VTs + (vi * 16 + lr) * 144 + ks * 64 + quad * 16), ao);
#pragma unroll
            for (int jj = 0; jj < 4; ++jj) O[(size_t)(r0 + ci * 16 + quad * 4 + jj) * D + h * 128 + cb * 32 + vi * 16 + lr] = ao[jj];
            const float gl = GL[pit];
#pragma unroll
            for (int v2 = 0; v2 < 2; ++v2) { Sacc[v2] = Sacc[v2] * gl;
#pragma unroll
                for (int ks = 0; ks < 2; ++ks) Sacc[v2] = MFMA16(*(const LAS bf16x8*)(KTs + (w * 16 + lr) * 144 + ks * 64 + quad * 16), *(const LAS bf16x8*)(VTs + (v2 * 16 + lr) * 144 + ks * 64 + quad * 16), Sacc[v2]); }
            __syncthreads();
#pragma unroll
            for (int v2 = 0; v2 < 2; ++v2) { u32x2 wv; wv.x = pk2(Sacc[v2][0], Sacc[v2][1]); wv.y = pk2(Sacc[v2][2], Sacc[v2][3]); *(LAS u32x2*)(Sts + (v2 * 16 + lr) * 272 + (w * 16 + quad * 4) * 2) = wv; }
            if (n + 1 < 32) stash();
            __syncthreads();
        }
#pragma unroll
        for (int v2 = 0; v2 < 2; ++v2)
#pragma unroll
            for (int jj = 0; jj < 4; ++jj) pS[((size_t)bh * 128 + w * 16 + quad * 4 + jj) * 128 + cb * 32 + v2 * 16 + lr] = Sacc[v2][jj];
        __syncthreads();
    }
    LAS float* qf = (LAS float*)c.lds; LAS float* kf = qf + 128; LAS float* red = qf + 256;
    for (int it = c.bid; it < NS * 8; it += c.G) {
        const int s = it >> 3, h = it & 7, row = NP + s, v = c.tid & 127, part = c.tid >> 7;
        __syncthreads();
        if (c.tid < 128) qf[c.tid] = bf2f(QKVS[(size_t)s * D + h * 128 + c.tid]); else if (c.tid < 256) kf[c.tid - 128] = bf2f(QKVS[(size_t)(NS + s) * D + h * 128 + c.tid - 128]);
        __syncthreads();
        const float eg = __expf(GB[(size_t)row * 16 + h]), beta = GB[(size_t)row * 16 + 8 + h];
        const float* sp = S0 + ((size_t)(s * 8 + h) * 128 + part * 32) * 128 + v;
        float s0[32], ksum = 0.f, qsum = 0.f, qk = 0.f;
#pragma unroll
        for (int i = 0; i < 32; ++i) { s0[i] = sp[(size_t)i * 128]; const float kk = kf[part * 32 + i], qq = qf[part * 32 + i]; ksum += kk * s0[i]; qsum += qq * s0[i]; qk += qq * kk; }
        red[part * 128 + v] = ksum; red[512 + part * 128 + v] = qsum; red[1024 + part * 128 + v] = qk;
        __syncthreads();
        ksum = red[v] + red[128 + v] + red[256 + v] + red[384 + v]; qsum = red[512 + v] + red[640 + v] + red[768 + v] + red[896 + v]; qk = red[1024 + v] + red[1152 + v] + red[1280 + v] + red[1408 + v];
        const float vv = bf2f(QKVS[(size_t)(2 * NS + s) * D + h * 128 + v]); const float vn = beta * (vv - eg * ksum);
        if (part == 0) O[(size_t)row * D + h * 128 + v] = eg * qsum + qk * vn;
        float* so = sS + ((size_t)(s * 8 + h) * 128 + part * 32) * 128 + v;
#pragma unroll
        for (int i = 0; i < 32; ++i) so[(size_t)i * 128] = eg * s0[i] + kf[part * 32 + i] * vn;
    }
}
DI void gdn_post_phase(const Ctx& c, const float* O, const bf16_t* GATE, const float* ng, bf16_t* OG) {
    for (int row = c.bid * 8 + c.wave; row < NR; row += c.G * 8) {
#pragma unroll
        for (int pass = 0; pass < 2; ++pass) { const int col = pass * 512 + c.lane * 8, dv = (c.lane & 15) * 8;
            const f32x4 a = *(const f32x4*)(O + (size_t)row * D + col), b2 = *(const f32x4*)(O + (size_t)row * D + col + 4); float f[8] = {a.x, a.y, a.z, a.w, b2.x, b2.y, b2.z, b2.w}, g[8];
            float ss = 0.f;
#pragma unroll
            for (int e = 0; e < 8; ++e) ss += f[e] * f[e];
            ss += __shfl_xor(ss, 1); ss += __shfl_xor(ss, 2); ss += __shfl_xor(ss, 4); ss += __shfl_xor(ss, 8);
            const float rstd = rsqrtf(ss * (1.0f / 128.0f) + EPS);
            unpack8(*(const u32x4*)(GATE + (size_t)row * D + col), g);
#pragma unroll
            for (int e = 0; e < 8; ++e) f[e] = f[e] * rstd * ng[dv + e] * siluf_(g[e]);
            *(u32x4*)(OG + (size_t)row * D + col) = pack8(f); }
    }
}
DI void ssd_conv_phase(const Ctx& c, const bf16_t* P, const float* cw, const float* cb, const float* st  , const float* DTR, const float* dt_bias,
                       bf16_t* BM, bf16_t* CM, bf16_t* XSN, float* DT, bf16_t* XST, bf16_t* BMT, float* pout, float* sout) {
    for (int row = c.bid * 8 + c.wave; row < NR; row += c.G * 8) {
        const int t = row < NP ? (row & (SEQL - 1)) : -1; const float* sp = t < 0 ? st + (size_t)(row - NP) * 3 * 3072 : nullptr;
        const bool need_all = (t < 0) || (t >= SEQL - 3);
#pragma unroll 1
        for (int pass = 0; pass < 6; ++pass) {
            if (pass < 4 && !need_all) continue;
            const int ch = pass * 512 + c.lane * 8; float f[8], cur[8];
            conv8(P + ch, 3072, row, t, sp, 3072, cw, cb, ch, f, cur);
            conv_state8(row, t, cur, sp, 3072, ch, pout, sout);
#pragma unroll
            for (int e = 0; e < 8; ++e) f[e] = siluf_(f[e]);
            if (pass < 4) { if (t < 0) *(u32x4*)(XSN + (size_t)(row - NP) * 2048 + ch) = pack8(f); }
            else if (pass == 4) *(u32x4*)(BM + (size_t)row * 512 + c.lane * 8) = pack8(f);
            else *(u32x4*)(CM + (size_t)row * 512 + c.lane * 8) = pack8(f);
        }
        if (c.lane < 32) DT[(size_t)row * 32 + c.lane] = softplusf_(DTR[(size_t)row * 32 + c.lane] + dt_bias[c.lane]);
    }
    for (int i = c.bid * 512 + c.tid; i < 8 * 32 * 8 * 2560; i += c.G * 512) {
        const int ch = i % 2560, r = i / 2560, s8 = r & 7, bn = r >> 3, b = bn >> 5, n = bn & 31, t0 = n * 64 + s8 * 8, row0 = b * SEQL + t0;
        float x[11];
#pragma unroll
        for (int k = 0; k < 11; ++k) x[k] = (t0 - 3 + k >= 0) ? bf2f(P[(size_t)(row0 - 3 + k) * 3072 + ch]) : 0.f;
        const float w0 = cw[ch], w1 = cw[3072 + ch], w2 = cw[2 * 3072 + ch], w3 = cw[3 * 3072 + ch], bb = cb[ch]; float f[8];
#pragma unroll
        for (int e = 0; e < 8; ++e) f[e] = siluf_(bb + w0 * x[e] + w1 * x[e + 1] + w2 * x[e + 2] + w3 * x[e + 3]);
        if (ch < 2048) *(u32x4*)(XST + ((size_t)bn * 2048 + ch) * 64 + s8 * 8) = pack8(f);
        else *(u32x4*)(BMT + ((size_t)bn * 512 + ch - 2048) * 64 + s8 * 8) = pack8(f);
    }
}
DI void ssd_seq_phase(const Ctx& c, const bf16_t* XST, const bf16_t* BM, const bf16_t* CM, const bf16_t* BMT, const float* DT, const float* A_log, const float* Dsk, bf16_t* Y, float* pH,
                      const bf16_t* XSN, const float* H0, float* sH) {
    const int lr = c.lane & 15, quad = c.lane >> 4, w = c.wave;
    ldsp Cs = c.lds, Bs = c.lds + 17408, BTs = c.lds + 34816, XTs = c.lds + 53248, XDs = c.lds + 62464, XRs = c.lds + 71680, Ms = c.lds + 80896, Hs = c.lds + 90112;
    LAS float* DTs = (LAS float*)(c.lds + 107520); LAS float* ACs = DTs + 64;
    for (int item = c.bid; item < 256; item += c.G) {
        const int b = item >> 5, hd = item & 31, g = hd >> 3; const float A = -__expf(A_log[hd]), Dk = Dsk[hd];
        f32x4 hacc[4];
#pragma unroll
        for (int i = 0; i < 4; ++i) hacc[i] = (f32x4){0.f, 0.f, 0.f, 0.f};
        __syncthreads();
        for (int i = c.tid; i < 17408 / 4; i += 512) ((LAS unsigned*)Hs)[i] = 0u;
#pragma unroll 1
        for (int n = 0; n < 32; ++n) {
            const int bn = b * 32 + n, r0 = b * SEQL + n * 64;
            if (c.tid < 64) { const float dt = DT[(size_t)(r0 + c.tid) * 32 + hd]; float ac = dt * A;
#pragma unroll
                for (int o = 1; o < 64; o <<= 1) { const float v = __shfl_up(ac, o); if (c.lane >= o) ac += v; }
                DTs[c.tid] = dt; ACs[c.tid] = ac; }
#pragma unroll
            for (int i = 0; i < 2; ++i) { const int ci = c.tid + i * 512, row = ci >> 4, cc = ci & 15; const size_t go = (size_t)(r0 + row) * 512 + g * 128 + cc * 8;
                *(LAS u32x4*)(Cs + row * 272 + cc * 16) = *(const u32x4*)(CM + go); *(LAS u32x4*)(Bs + row * 272 + cc * 16) = *(const u32x4*)(BM + go); }
#pragma unroll
            for (int i = 0; i < 2; ++i) { const int ci = c.tid + i * 512, row = ci >> 3, cc = ci & 7; *(LAS u32x4*)(BTs + row * 144 + cc * 16) = *(const u32x4*)(BMT + ((size_t)bn * 512 + g * 128 + row) * 64 + cc * 8); }
            const int xrow = c.tid >> 3, xcc = c.tid & 7; const u32x4 xraw = *(const u32x4*)(XST + ((size_t)bn * 2048 + hd * 64 + xrow) * 64 + xcc * 8);
            __syncthreads();
            { float f[8], fd[8]; unpack8(xraw, f); const float al = ACs[63];
#pragma unroll
                for (int e = 0; e < 8; ++e) { const int s = xcc * 8 + e; f[e] *= DTs[s]; fd[e] = f[e] * __expf(al - ACs[s]); }
                *(LAS u32x4*)(XRs + xrow * 144 + xcc * 16) = xraw; *(LAS u32x4*)(XTs + xrow * 144 + xcc * 16) = pack8(f); *(LAS u32x4*)(XDs + xrow * 144 + xcc * 16) = pack8(fd); }
            __syncthreads();
            const int li = w >> 1; float acl[4];
#pragma unroll
            for (int jj = 0; jj < 4; ++jj) acl[jj] = ACs[li * 16 + quad * 4 + jj];
            f32x4 aoff[2];
#pragma unroll
            for (int q2 = 0; q2 < 2; ++q2) { const int sj = 2 * (w & 1) + q2;
                if (sj <= li) { f32x4 a = {0.f, 0.f, 0.f, 0.f};
#pragma unroll
                    for (int ks = 0; ks < 4; ++ks) a = MFMA16(*(const LAS bf16x8*)(Cs + (li * 16 + lr) * 272 + ks * 64 + quad * 16), *(const LAS bf16x8*)(Bs + (sj * 16 + lr) * 272 + ks * 64 + quad * 16), a);
                    const int s = sj * 16 + lr; const float as = ACs[s];
#pragma unroll
                    for (int jj = 0; jj < 4; ++jj) { const int l = li * 16 + quad * 4 + jj; *(LAS bf16_t*)(Ms + l * 144 + s * 2) = (bf16_t)f2bf(l >= s ? a[jj] * __expf(acl[jj] - as) : 0.f); }
                } else {
#pragma unroll
                    for (int jj = 0; jj < 4; ++jj) *(LAS bf16_t*)(Ms + (li * 16 + quad * 4 + jj) * 144 + (sj * 16 + lr) * 2) = 0;
                }
                const int pj = 2 * (w & 1) + q2; f32x4 a2 = {0.f, 0.f, 0.f, 0.f};
#pragma unroll
                for (int ks = 0; ks < 4; ++ks) a2 = MFMA16(*(const LAS bf16x8*)(Cs + (li * 16 + lr) * 272 + ks * 64 + quad * 16), *(const LAS bf16x8*)(Hs + (pj * 16 + lr) * 272 + ks * 64 + quad * 16), a2);
                aoff[q2] = a2; }
            __syncthreads();
#pragma unroll
            for (int q2 = 0; q2 < 2; ++q2) { const int pj = 2 * (w & 1) + q2; f32x4 a = {0.f, 0.f, 0.f, 0.f};
#pragma unroll
                for (int ks = 0; ks < 2; ++ks) a = MFMA16(*(const LAS bf16x8*)(Ms + (li * 16 + lr) * 144 + ks * 64 + quad * 16), *(const LAS bf16x8*)(XTs + (pj * 16 + lr) * 144 + ks * 64 + quad * 16), a);
                const u32x2 xr = *(const LAS u32x2*)(XRs + (pj * 16 + lr) * 144 + (li * 16 + quad * 4) * 2); const float xv[4] = {lo16(xr.x), hi16(xr.x), lo16(xr.y), hi16(xr.y)};
#pragma unroll
                for (int jj = 0; jj < 4; ++jj) { const float yv = a[jj] + __expf(acl[jj]) * aoff[q2][jj] + Dk * xv[jj];
                    Y[(size_t)(r0 + li * 16 + quad * 4 + jj) * 2048 + hd * 64 + pj * 16 + lr] = (bf16_t)f2bf(yv); } }
            { const float cd = __expf(ACs[63]);
#pragma unroll
                for (int pj = 0; pj < 4; ++pj) { hacc[pj] = hacc[pj] * cd;
#pragma unroll
                    for (int ks = 0; ks < 2; ++ks) hacc[pj] = MFMA16(*(const LAS bf16x8*)(BTs + (w * 16 + lr) * 144 + ks * 64 + quad * 16), *(const LAS bf16x8*)(XDs + (pj * 16 + lr) * 144 + ks * 64 + quad * 16), hacc[pj]); } }
            __syncthreads();
#pragma unroll
            for (int pj = 0; pj < 4; ++pj) { u32x2 wv; wv.x = pk2(hacc[pj][0], hacc[pj][1]); wv.y = pk2(hacc[pj][2], hacc[pj][3]); *(LAS u32x2*)(Hs + (pj * 16 + lr) * 272 + (w * 16 + quad * 4) * 2) = wv; }
        }
#pragma unroll
        for (int pj = 0; pj < 4; ++pj) *(f32x4*)(pH + ((size_t)item * 64 + pj * 16 + lr) * 128 + w * 16 + quad * 4) = hacc[pj];
    }
    LAS float* Bf = (LAS float*)c.lds; LAS float* Cf = Bf + 128;
    for (int it = c.bid; it < NS * 32; it += c.G) {
        const int s = it >> 5, hd = it & 31, g = hd >> 3, row = NP + s;
        __syncthreads();
        if (c.tid < 128) Bf[c.tid] = bf2f(BM[(size_t)row * 512 + g * 128 + c.tid]); else if (c.tid < 256) Cf[c.tid - 128] = bf2f(CM[(size_t)row * 512 + g * 128 + c.tid - 128]);
        __syncthreads();
        const float dt = DT[(size_t)row * 32 + hd], ea = __expf(-dt * __expf(A_log[hd])), Dk = Dsk[hd];
        const int p = c.tid >> 3, np = c.tid & 7; const float xv = bf2f(XSN[(size_t)s * 2048 + hd * 64 + p]), xdt = xv * dt;
        const float* hp = H0 + ((size_t)(s * 32 + hd) * 64 + p) * 128 + np * 16; float* ho = sH + ((size_t)(s * 32 + hd) * 64 + p) * 128 + np * 16;
        float yo = 0.f, cbp = 0.f;
#pragma unroll
        for (int i = 0; i < 4; ++i) { const f32x4 h4 = *(const f32x4*)(hp + 4 * i); f32x4 o4;
#pragma unroll
            for (int e = 0; e < 4; ++e) { const int nn = np * 16 + 4 * i + e; const float bv = Bf[nn], cv = Cf[nn]; yo += cv * h4[e]; cbp += cv * bv; o4[e] = ea * h4[e] + xdt * bv; }
            *(f32x4*)(ho + 4 * i) = o4; }
        yo += __shfl_xor(yo, 1); yo += __shfl_xor(yo, 2); yo += __shfl_xor(yo, 4); cbp += __shfl_xor(cbp, 1); cbp += __shfl_xor(cbp, 2); cbp += __shfl_xor(cbp, 4);
        if (np == 0) Y[(size_t)row * 2048 + hd * 64 + p] = (bf16_t)f2bf(cbp * xdt + ea * yo + Dk * xv);
    }
}
DI void ssd_post_phase(const Ctx& c, const bf16_t* Y, const bf16_t* ZB, const float* ng, bf16_t* YN) {
    for (int row = c.bid * 8 + c.wave; row < NR; row += c.G * 8) {
#pragma unroll
        for (int gi = 0; gi < 4; ++gi) { const int col = gi * 512 + c.lane * 8; float y[8], z[8];
            unpack8(*(const u32x4*)(Y + (size_t)row * 2048 + col), y); unpack8(*(const u32x4*)(ZB + (size_t)row * 2048 + col), z);
            float ss = 0.f;
#pragma unroll
            for (int e = 0; e < 8; ++e) { y[e] *= siluf_(z[e]); ss += y[e] * y[e]; }
            const float rstd = rsqrtf(wave_sum(ss) * (1.0f / 512.0f) + EPS);
#pragma unroll
            for (int e = 0; e < 8; ++e) y[e] = y[e] * rstd * ng[col + e];
            *(u32x4*)(YN + (size_t)row * 2048 + col) = pack8(y); }
    }
}
template <class Epi> DI void run_gemm(const Ctx& c, const bf16_t* A, int lda, const bf16_t* Bt, int ldb, int M, int N, int K, int ksh, int kmul, const Epi& E) {
    pg8::Gemm g{A, Bt, M, N, K, lda, ldb, ksh, kmul}; pg8::StaticOrder S; S.init(M, N, c.G, c.bid);
    pg8::gemm_phase<Epi, pg8::StaticOrder>(c.lds, g, S, E, c.tid);
}
#define B_X ((float*)(ws + WS_X))
#define B_UB ((bf16_t*)(ws + WS_UB))
#define B_P ((bf16_t*)(ws + WS_P))
#define B_S (ws + WS_S)
#define B_MOD ((float*)(ws + WS_MOD))
#define B_MODL (B_MOD + (size_t)L * NSEQ * MODW)
#define B_XP (L == 0 ? a.in[0] : (const float*)B_X)
#define B_XS (L == 0 ? a.in[1] : (const float*)(B_X + (size_t)NP * D))
#define B_XB ((bf16_t*)B_S)
#define B_LA ((float*)(B_S + (size_t)RP * 1024 * 2))
#define B_BX ((float*)(B_S + (size_t)RP * 1024 * 6))
#define B_Q ((bf16_t*)B_S)
#define B_K (B_Q + (size_t)RP * D)
#define B_V (B_Q + (size_t)2 * RP * D)
#define B_GATE (B_Q + (size_t)3 * RP * D)
#define B_QKG (B_Q + (size_t)4 * RP * D)
#define B_AB ((float*)(ws + WS_AB))
#define B_GB ((float*)(ws + WS_GB))
#define B_GL ((float*)(ws + WS_GL))
#define B_QKVS ((bf16_t*)(ws + WS_QKVS))
#define B_UT ((float*)B_P)
#define B_NW ((bf16_t*)(ws + WS_P + (size_t)NP * D * 4))
#define B_QD (B_NW + (size_t)NP * D)
#define B_KDT (B_NW + (size_t)2 * NP * D)
#define B_OF ((float*)B_S)
#define B_XST ((bf16_t*)B_S)
#define B_BM (B_XST + (size_t)NP * 2048)
#define B_CM (B_BM + (size_t)RP * 512)
#define B_BMT (B_CM + (size_t)RP * 512)
#define B_ZB (B_P + (size_t)RP * 3072)
#define B_YN ((bf16_t*)B_S)
#define B_DTR ((float*)(ws + WS_DTR))
#define B_DT ((float*)(ws + WS_DT))
#define B_XSN ((bf16_t*)(ws + WS_XSN))
__global__ void __launch_bounds__(512, 2) mega(Args a) {
    extern __shared__ __attribute__((aligned(16))) unsigned char lds_raw[];
    cg::grid_group grid = cg::this_grid();
    Ctx c0; c0.lds = (ldsp)lds_raw; c0.tid = threadIdx.x; c0.lane = c0.tid & 63; c0.wave = __builtin_amdgcn_readfirstlane(c0.tid >> 6); c0.bid = blockIdx.x; c0.G = gridDim.x;
    int ph = 0; const int lo = a.lo, hi = a.hi;
#define PH_BEGIN if (ph >= lo && ph < hi) { Ctx c = c0; unsigned char* ws = a.ws; float* out = a.out; { int t_ = c0.tid; asm volatile("" : "+v"(t_)); asm volatile("" : "+s"(ws)); asm volatile("" : "+s"(out)); c.tid = t_; c.lane = t_ & 63; c.wave = __builtin_amdgcn_readfirstlane(t_ >> 6); } (void)out;
#define PH_END if (ph + 1 < hi) grid.sync(); } ++ph;

    PH_BEGIN prep_phase(c, a); PH_END
    PH_BEGIN { EpiMod E{B_MOD, a.in[11]}; run_gemm(c, (const bf16_t*)(ws + WS_SC), 1024, B_P, 1024, 256, 4 * MODW, 1024, 0, 0, E); } PH_END
#pragma unroll 1
    for (int L = 0; L < 4; ++L) {
        const int kind = L % 3, j = L / 3;
        PH_BEGIN norm_mod_phase(c, B_XP, B_XS, B_MODL + 1024, B_MODL, B_UB); PH_END
        PH_BEGIN {
            EpiSplit E; const bf16_t* Bt; int N;
            if (kind == 0) { E = EpiSplit{1, B_P, 2048, 1024, B_P + 1024, 2048, 2048, nullptr, 0, 0}; Bt = (const bf16_t*)(ws + WS_RGIN) + (size_t)j * 2048 * 1024; N = 2048; }
            else if (kind == 1) { E = EpiSplit{0, B_P, 3072, 3072, B_GATE, 1024, 4096, B_AB, 16, 16}; Bt = (const bf16_t*)(ws + WS_GDNIN); N = GDN_NP; }
            else { E = EpiSplit{0, B_ZB, 2048, 2048, B_P, 3072, 5120, B_DTR, 32, 32}; Bt = (const bf16_t*)(ws + WS_SSDIN); N = SSD_NP; }
            run_gemm(c, B_UB, 1024, Bt, 1024, RP, N, 1024, 0, 0, E); } PH_END
        if (kind == 0) {
            PH_BEGIN rg_conv_phase(c, B_P, a.in[16] + j * 4 * D, a.in[17] + j * D, a.in[2] + (size_t)j * NS * 3 * D, B_XB, out + O_PRGC + j * 8 * 3 * D, out + O_SRGC + j * NS * 3 * D); PH_END
            PH_BEGIN { EpiGate E{B_XB, a.in[19] + j * 2 * D, (const float*)(ws + WS_LS8) + j * D, B_LA, B_BX}; run_gemm(c, B_XB, 1024, (const bf16_t*)(ws + WS_RGGATE) + (size_t)j * 2048 * 256, 256, RP, 2048, 256, 1, 256, E); } PH_END
            PH_BEGIN rg_scan_phase(c, B_LA, B_BX, B_P, a.in[3] + (size_t)j * NS * D, B_UB, out + O_PRGH + j * 8 * D, out + O_SRGH + j * NS * D); PH_END
        } else if (kind == 1) {
            PH_BEGIN gdn_conv_phase(c, B_P, a.in[23], a.in[4], B_AB, a.in[24], a.in[25], B_Q, B_K, B_V, B_QKVS, B_GB, out + O_PGDC, out + O_SGDC); PH_END
            PH_BEGIN gdn_prep_phase(c, B_Q, B_K, B_V, B_GB, B_UT, B_NW, B_QD, B_KDT, B_QKG, B_GL); PH_END
            PH_BEGIN gdn_seq_phase(c, B_UT, B_NW, B_QD, B_KDT, B_QKG, B_GL, B_OF, out + O_PGDS, B_QKVS, B_GB, a.in[5], out + O_SGDS); PH_END
            PH_BEGIN gdn_post_phase(c, B_OF, B_GATE, a.in[26], B_UB); PH_END
        } else {
            PH_BEGIN ssd_conv_phase(c, B_P, a.in[29], a.in[30], a.in[6], B_DTR, a.in[32], B_BM, B_CM, B_XSN, B_DT, B_XST, B_BMT, out + O_PSSC, out + O_SSSC); PH_END
            PH_BEGIN ssd_seq_phase(c, B_XST, B_BM, B_CM, B_BMT, B_DT, a.in[31], a.in[33], B_P, out + O_PSSH, B_XSN, a.in[7], out + O_SSSH); PH_END
            PH_BEGIN ssd_post_phase(c, B_P, B_ZB, a.in[34], B_YN); PH_END
        }
        PH_BEGIN { EpiRes E{B_XP, B_XS, B_X, B_MODL + 2048};
            const bf16_t* oA = kind == 2 ? B_YN : B_UB; const int oK = kind == 2 ? 2048 : 1024;
            const bf16_t* oB = kind == 0 ? (const bf16_t*)(ws + WS_RGOUT) + (size_t)j * 1024 * 1024 : (kind == 1 ? (const bf16_t*)(ws + WS_GDNOUT) : (const bf16_t*)(ws + WS_SSDOUT));
            run_gemm(c, oA, oK, oB, oK, RP, 1024, oK, 0, 0, E); } PH_END
        PH_BEGIN norm_mod_phase(c, B_X, B_X + (size_t)NP * D, B_MODL + 4 * 1024, B_MODL + 3 * 1024, B_UB); PH_END
        PH_BEGIN { EpiSplit E{2, B_P, 4096, 4096, nullptr, 0, 4096, nullptr, 0, 0}; run_gemm(c, B_UB, 1024, (const bf16_t*)(ws + WS_WUP) + (size_t)L * 4096 * 1024, 1024, RP, 4096, 1024, 0, 0, E); } PH_END
        PH_BEGIN { EpiRes E{B_X, B_X + (size_t)NP * D, B_X, B_MODL + 5 * 1024}; run_gemm(c, B_P, 4096, (const bf16_t*)(ws + WS_WDN) + (size_t)L * 4096 * 1024, 4096, RP, 1024, 4096, 0, 0, E); } PH_END
    }
    PH_BEGIN final_norm_phase(c, B_X, a.in[14], out + O_Y); PH_END
}
constexpr int N_PHASES = 40;

extern "C" void kernel_launch(void* const* d_in, const int* in_sizes, int n_in, void* d_out, int out_size, void* d_ws, size_t ws_size, hipStream_t stream) {
    static int grid = 0;
    if (grid == 0) {
        int dev = 0, cus = 0, per_cu = 0;
        (void)hipGetDevice(&dev);
        (void)hipDeviceGetAttribute(&cus, hipDeviceAttributeMultiprocessorCount, dev);
        (void)hipFuncSetAttribute((const void*)mega, hipFuncAttributeMaxDynamicSharedMemorySize, LDS_BYTES);
        (void)hipOccupancyMaxActiveBlocksPerMultiprocessor(&per_cu, (const void*)mega, 512, LDS_BYTES);
        if (per_cu < 1) { fprintf(stderr, "kernel_launch: occupancy query reports %d blocks/CU\n", per_cu); }
        grid = cus > 0 ? cus : 256;
        if (ws_size < WS_END) { fprintf(stderr, "kernel_launch: workspace too small: need %zu, have %zu\n", (size_t)WS_END, ws_size); grid = -1; }
        if (n_in != 36) { fprintf(stderr, "kernel_launch: expected 36 inputs, got %d\n", n_in); grid = -1; }
    }
    if (grid < 0) return;
    Args a{};
    for (int i = 0; i < 36; ++i) a.in[i] = (const float*)d_in[i];
    a.out = (float*)d_out; a.ws = (unsigned char*)d_ws; a.lo = 0; a.hi = N_PHASES;
    void* args[] = {&a};
    hipError_t e = hipLaunchCooperativeKernel((const void*)mega, dim3(grid), dim3(512), args, LDS_BYTES, stream);
    if (e != hipSuccess) fprintf(stderr, "kernel_launch: cooperative launch failed: %s (grid %d)\n", hipGetErrorString(e), grid);
}
```

```cpp
#include <hip/hip_runtime.h>
#include <hip/hip_cooperative_groups.h>
#include <cstdio>
#include <type_traits>
namespace cg = cooperative_groups;

namespace pg8 {
#define PG8_LAS __attribute__((address_space(3)))
typedef unsigned short bf16_t;
typedef short bf16x8 __attribute__((ext_vector_type(8)));
typedef float f32x4 __attribute__((ext_vector_type(4)));
typedef unsigned u32x4 __attribute__((ext_vector_type(4)));
constexpr int BM = 256, BK = 64, HALF = 128, HTB = HALF * BK * 2  , STAGE_BYTES = 8 * HTB, NXCD = 8, WGM = 8;

__host__ __device__ __forceinline__ int lds_byte(int r, int c) { const int st = (r >> 4) * 2 + (c >> 5), rr = r & 15, cc = c & 31, ob = rr * 64 + cc * 2; return st * 1024 + (ob ^ (((ob >> 9) & 1) << 5)); }
__host__ __device__ __forceinline__ void stage_rc(int b, int& R, int& C) { const int st = b / 1024, sb = b % 1024, swz = sb ^ (((sb >> 9) & 1) << 5); R = (st >> 1) * 16 + swz / 64; C = (st & 1) * 32 + (swz % 64) / 2; }
__host__ __device__ __forceinline__ int perm32(int rho) { const int n = rho >> 4, i = rho & 15; return 8 * (i >> 2) + 4 * n + (i & 3); }

struct Unit { int pm, pn; };
struct Gemm { const bf16_t* A; const bf16_t* Bt; int M, N, K, lda, ldb, ksh, kmul, kmulb, bmask; };

struct StaticOrder {
    int nM, nN, nwg, G, c;
    __host__ __device__ void init(int M, int N, int G_, int c_) { nM = M / BM; nN = N / BM; nwg = nM * nN; G = G_; c = c_; }
    __host__ __device__ bool next(int i, Unit& u) const {
        const long L = (long)i * G + c; if (L >= nwg) return false;
        int wgid = (int)L; { const int q = nwg / NXCD, r = nwg % NXCD, xcd = wgid % NXCD, off = wgid / NXCD; wgid = (xcd < r ? xcd * (q + 1) : r * (q + 1) + (xcd - r) * q) + off; }
        const int nig = WGM * nN, gid = wgid / nig, fm = gid * WGM, gsz = (nM - fm) < WGM ? (nM - fm) : WGM;
        u.pm = fm + ((wgid % nig) % gsz); u.pn = (wgid % nig) / gsz; return true;
    }
    __device__ __forceinline__ void a_ready(const Unit&) const {}
    __device__ __forceinline__ void done(const Unit&) const {}
};
__device__ __forceinline__ unsigned cvt_pk_bf16(float lo, float hi) { unsigned r; asm volatile("v_cvt_pk_bf16_f32 %0, %1, %2" : "=v"(r) : "v"(lo), "v"(hi)); return r; }
typedef float f32x2 __attribute__((ext_vector_type(2)));
template <class Epi, class Sched>
__device__ __forceinline__ void gemm_phase(PG8_LAS unsigned char* lds, const Gemm g, const Sched& S, const Epi& E, const int tid_in) {
    const int tid = tid_in, wid = __builtin_amdgcn_readfirstlane(tid >> 6), lane = tid & 63, wr = wid >> 2, wc = wid & 3, fr = lane & 15, fq = lane >> 4;
    const int K = g.K, nt = K / BK;

    unsigned voffA[2], voffB[2];
#pragma unroll
    for (int i = 0; i < 2; ++i) { int R, C; stage_rc(tid * 16 + i * 8192, R, C); const int Rb = Epi::PERM ? ((R & ~31) + perm32(R & 31)) : R;
        voffA[i] = (unsigned)(R * g.lda + C) * 2u; voffB[i] = (unsigned)(Rb * g.ldb + C) * 2u; }
    const size_t kstep = (size_t)(BK * 2);
    const size_t hstepA = (size_t)HALF * g.lda * 2, hstepB = (size_t)HALF * g.ldb * 2;
    const size_t tstepA = 2 * hstepA, tstepB = 2 * hstepB;
    const unsigned ldsw = (unsigned)wid * 1024u;
    const int aoff = lds_byte(wr * 64 + fr, fq * 8), boff = lds_byte(wc * 32 + fr, fq * 8);
#define PG8_SA(b, h) (((b) * 2 + (h)) * HTB)
#define PG8_SB(b, h) ((4 + (b) * 2 + (h)) * HTB)
#define PG8_STAGE(bufoff, gbase, voff) do { _Pragma("unroll") for (int _i = 0; _i < 2; ++_i) \
        __builtin_amdgcn_global_load_lds((const unsigned*)((const char*)(gbase) + (voff)[_i]), (PG8_LAS unsigned*)(lds + (bufoff) + ldsw + _i * 8192), 16, 0, 0); } while (0)
#define PG8_LDA(dst, b, h) do { _Pragma("unroll") for (int m = 0; m < 4; ++m) _Pragma("unroll") for (int k = 0; k < 2; ++k) dst[m][k] = *(const PG8_LAS bf16x8*)(lds + PG8_SA(b, h) + aoff + m * 2048 + k * 1024); } while (0)
#define PG8_LDB(dst, b, h) do { _Pragma("unroll") for (int n = 0; n < 2; ++n) _Pragma("unroll") for (int k = 0; k < 2; ++k) dst[n][k] = *(const PG8_LAS bf16x8*)(lds + PG8_SB(b, h) + boff + n * 2048 + k * 1024); } while (0)
#define PG8_MMA(ai, bj, At, Bt) do { __builtin_amdgcn_s_setprio(1); _Pragma("unroll") for (int m = 0; m < 4; ++m) _Pragma("unroll") for (int n = 0; n < 2; ++n) _Pragma("unroll") for (int k = 0; k < 2; ++k) \
        acc[ai][bj][m][n] = __builtin_amdgcn_mfma_f32_16x16x32_bf16(Bt[n][k], At[m][k], acc[ai][bj][m][n], 0, 0, 0); __builtin_amdgcn_s_setprio(0); } while (0)
#define PG8_WAIT_V(n) asm volatile("s_waitcnt vmcnt(" #n ")" ::: "memory")
#define PG8_WAIT_L(n) asm volatile("s_waitcnt lgkmcnt(" #n ")" ::: "memory")
#define PG8_BAR __builtin_amdgcn_s_barrier()
#define PG8_SCHED __builtin_amdgcn_sched_barrier(0)
    Unit cur, nxt; int ui = 0;
    if (!S.next(0, cur)) return;
    f32x4 acc[2][2][4][2];
#pragma unroll
    for (int a = 0; a < 2; ++a)
#pragma unroll
        for (int b = 0; b < 2; ++b)
#pragma unroll
            for (int m = 0; m < 4; ++m)
#pragma unroll
                for (int n = 0; n < 2; ++n) acc[a][b][m][n] = (f32x4){0.f, 0.f, 0.f, 0.f};
    bf16x8 At[4][2], B0[2][2], B1[2][2];
    const char* cA = (const char*)g.A + (size_t)cur.pm * tstepA + (size_t)((cur.pn >> g.ksh) * g.kmul) * 2; const char* cB = (const char*)g.Bt + (size_t)(cur.pn & g.bmask) * tstepB + (size_t)((cur.pn >> g.ksh) * g.kmulb) * 2;
    S.a_ready(cur);
    PG8_STAGE(PG8_SB(0, 0), cB, voffB); PG8_STAGE(PG8_SA(0, 0), cA, voffA); PG8_STAGE(PG8_SB(0, 1), cB + hstepB, voffB); PG8_STAGE(PG8_SA(0, 1), cA + hstepA, voffA);
    if (wr == 1) PG8_BAR;
    PG8_WAIT_V(4); PG8_BAR;
    PG8_STAGE(PG8_SB(1, 0), cB + kstep, voffB); PG8_STAGE(PG8_SA(1, 0), cA + kstep, voffA); PG8_STAGE(PG8_SB(1, 1), cB + hstepB + kstep, voffB);
    PG8_WAIT_V(6); PG8_BAR;

    for (;;) {
        const bool has_next = S.next(ui + 1, nxt);
        const char* nA = has_next ? (const char*)g.A + (size_t)nxt.pm * tstepA + (size_t)((nxt.pn >> g.ksh) * g.kmul) * 2 : cA; const char* nB = has_next ? (const char*)g.Bt + (size_t)(nxt.pn & g.bmask) * tstepB + (size_t)((nxt.pn >> g.ksh) * g.kmulb) * 2 : cB;
        for (int t = 0; t < nt; t += 2) {
            const bool last = (t == nt - 2);
            const char* a1 = cA + (size_t)(t + 1) * kstep;
            const char* a2 = last ? nA : cA + (size_t)(t + 2) * kstep; const char* b2 = last ? nB : cB + (size_t)(t + 2) * kstep;
            const char* a3 = a2 + kstep; const char* b3 = b2 + kstep;
            if (last && has_next) S.a_ready(nxt);
            PG8_LDB(B0, 0, 0); PG8_SCHED; PG8_LDA(At, 0, 0); PG8_STAGE(PG8_SA(1, 1), a1 + hstepA, voffA);
            PG8_WAIT_L(8); PG8_BAR; PG8_WAIT_L(0); PG8_MMA(0, 0, At, B0); PG8_BAR; PG8_SCHED;
            PG8_LDB(B1, 0, 1); PG8_STAGE(PG8_SB(0, 0), b2, voffB);
            PG8_BAR; PG8_WAIT_L(0); PG8_MMA(0, 1, At, B1); PG8_BAR;
            PG8_LDA(At, 0, 1); PG8_STAGE(PG8_SA(0, 0), a2, voffA);
            PG8_BAR; PG8_WAIT_L(0); PG8_MMA(1, 0, At, B0); PG8_BAR; PG8_SCHED;
            PG8_STAGE(PG8_SB(0, 1), b2 + hstepB, voffB);
            PG8_WAIT_V(6); PG8_BAR; PG8_MMA(1, 1, At, B1); PG8_BAR;
            PG8_LDB(B0, 1, 0); PG8_SCHED; PG8_LDA(At, 1, 0); PG8_STAGE(PG8_SA(0, 1), a2 + hstepA, voffA);
            PG8_WAIT_L(8); PG8_BAR; PG8_WAIT_L(0); PG8_MMA(0, 0, At, B0); PG8_BAR; PG8_SCHED;
            PG8_LDB(B1, 1, 1); PG8_STAGE(PG8_SB(1, 0), b3, voffB);
            PG8_BAR; PG8_WAIT_L(0); PG8_MMA(0, 1, At, B1); PG8_BAR;
            PG8_LDA(At, 1, 1); PG8_STAGE(PG8_SA(1, 0), a3, voffA);
            PG8_BAR; PG8_WAIT_L(0); PG8_MMA(1, 0, At, B0); PG8_BAR; PG8_SCHED;
            PG8_STAGE(PG8_SB(1, 1), b3 + hstepB, voffB);
            PG8_WAIT_V(6); PG8_BAR; PG8_MMA(1, 1, At, B1); PG8_BAR;
        }

        if constexpr (!Epi::AFTER_DRAIN) { E(acc, cur, wr, wc, fr, fq); S.done(cur); }

        if (!has_next) break;
#pragma unroll
        for (int a = 0; a < 2; ++a)
#pragma unroll
            for (int b = 0; b < 2; ++b)
#pragma unroll
                for (int m = 0; m < 4; ++m)
#pragma unroll
                    for (int n = 0; n < 2; ++n) acc[a][b][m][n] = (f32x4){0.f, 0.f, 0.f, 0.f};
        cur = nxt; cA = nA; cB = nB; ++ui;
    }
    PG8_WAIT_V(0);
    if (wr == 0) PG8_BAR;
    PG8_BAR;
    if constexpr (Epi::AFTER_DRAIN) { E.fused(acc, cur, wr, wc, fr, fq, lds, wid, lane); S.done(cur); }

#undef PG8_SA
#undef PG8_SB
#undef PG8_STAGE
#undef PG8_LDA
#undef PG8_LDB
#undef PG8_MMA
#undef PG8_WAIT_V
#undef PG8_WAIT_L
#undef PG8_BAR
#undef PG8_SCHED
}
}
using pg8::bf16_t; using pg8::bf16x8; using pg8::f32x4; using pg8::u32x4; using pg8::f32x2;
typedef unsigned u32x2 __attribute__((ext_vector_type(2)));
#define LAS __attribute__((address_space(3)))
#define GAS __attribute__((address_space(1)))
#define GIN(k) ((const float*)(const GAS float*)a.in[k])
typedef LAS unsigned char* ldsp;
#define DI __device__ __forceinline__
#define LDS_BAR() do { asm volatile("s_waitcnt lgkmcnt(0)" ::: "memory"); __builtin_amdgcn_s_barrier(); asm volatile("" ::: "memory"); } while (0)
#define MFMA16(a, b, c) __builtin_amdgcn_mfma_f32_16x16x32_bf16((a), (b), (c), 0, 0, 0)

constexpr int D = 1024, NP = 16384, NS = 128, NR = NP + NS, RP = 16640, SEQL = 2048, NSEQ = 136, MODW = 6144;
constexpr int GDN_N = 4112, GDN_NP = 4352, SSD_N = 5152, SSD_NP = 5376;
constexpr float EPS = 1e-6f;
constexpr int LDS_BYTES = 132096;
constexpr size_t al256(size_t x) { return (x + 255) & ~(size_t)255; }
constexpr size_t WS_WUP = 0;
constexpr size_t WS_WDN = WS_WUP + (size_t)4 * 4096 * 1024 * 2;
constexpr size_t WS_RGIN = WS_WDN + (size_t)4 * 4096 * 1024 * 2;
constexpr size_t WS_RGGATE = WS_RGIN + (size_t)2 * 2048 * 1024 * 2;
constexpr size_t WS_RGOUT = WS_RGGATE + (size_t)2 * 2048 * 256 * 2;
constexpr size_t WS_GDNIN = WS_RGOUT + (size_t)2 * 1024 * 1024 * 2;
constexpr size_t WS_GDNOUT = WS_GDNIN + (size_t)GDN_NP * 1024 * 2;
constexpr size_t WS_SSDIN = WS_GDNOUT + (size_t)1024 * 1024 * 2;
constexpr size_t WS_SSDOUT = WS_SSDIN + (size_t)SSD_NP * 1024 * 2;
constexpr size_t WS_SC = WS_SSDOUT + (size_t)1024 * 2048 * 2;
constexpr size_t WS_MOD = WS_SC + (size_t)256 * 1024 * 2;
constexpr size_t WS_AB = al256(WS_MOD + (size_t)4 * NSEQ * MODW * 4);
constexpr size_t WS_GB = WS_AB + (size_t)RP * 16 * 4;
constexpr size_t WS_DTR = WS_GB + (size_t)RP * 16 * 4;
constexpr size_t WS_DT = WS_DTR + (size_t)RP * 32 * 4;
constexpr size_t WS_GL = WS_DT + (size_t)RP * 32 * 4;
constexpr size_t WS_XSN = WS_GL + 2048 * 4;
constexpr size_t WS_QKVS = WS_XSN + (size_t)128 * 2048 * 2;
constexpr size_t WS_LS8 = WS_QKVS + (size_t)3 * 128 * 1024 * 2;
constexpr size_t WS_BAR = al256(WS_LS8 + 2 * 1024 * 4);
constexpr size_t WS_XS = al256(WS_BAR + 16384);
constexpr size_t WS_CNT = WS_XS + (size_t)NP * 4 * 4;
constexpr size_t WS_X = al256(WS_CNT + (size_t)8 * 64 * 64 * 4);
constexpr size_t WS_UB = WS_X + (size_t)RP * 1024 * 4;
constexpr size_t WS_P = WS_UB + (size_t)RP * 1024 * 2;
constexpr size_t P_BYTES = (size_t)RP * 5120 * 2;
constexpr size_t WS_S = WS_P + P_BYTES;
constexpr size_t S_BYTES = (size_t)RP * 1024 * 10;
constexpr size_t WS_END = WS_S + S_BYTES;
constexpr int O_Y = 0, O_PRGC = 16908288, O_PRGH = O_PRGC + 49152, O_PGDC = O_PRGH + 16384, O_PGDS = O_PGDC + 73728, O_PSSC = O_PGDS + 1048576, O_PSSH = O_PSSC + 73728,
              O_SRGC = O_PSSH + 2097152, O_SRGH = O_SRGC + 786432, O_SGDC = O_SRGH + 262144, O_SGDS = O_SGDC + 1179648, O_SSSC = O_SGDS + 16777216, O_SSSH = O_SSSC + 1179648;

struct Args { const float* in[36]; float* out; unsigned char* ws; int lo, hi; };
struct Ctx { ldsp lds; int tid, lane, wave, bid, G; };

DI float bf2f(unsigned short b) { return __uint_as_float(((unsigned)b) << 16); }
DI unsigned pk2(float lo, float hi) { typedef float f2_ __attribute__((ext_vector_type(2))); typedef __bf16 b2_ __attribute__((ext_vector_type(2))); const b2_ r = __builtin_convertvector((f2_){lo, hi}, b2_); return __builtin_bit_cast(unsigned, r); }
DI unsigned f2bf(float f) { return pk2(f, f) & 0xffffu; }
DI float lo16(unsigned w) { return __uint_as_float(w << 16); }
DI float hi16(unsigned w) { return __uint_as_float(w & 0xffff0000u); }
DI void unpack8(u32x4 w, float* f) { f[0] = lo16(w.x); f[1] = hi16(w.x); f[2] = lo16(w.y); f[3] = hi16(w.y); f[4] = lo16(w.z); f[5] = hi16(w.z); f[6] = lo16(w.w); f[7] = hi16(w.w); }
DI u32x4 pack8(const float* f) { u32x4 w; w.x = pk2(f[0], f[1]); w.y = pk2(f[2], f[3]); w.z = pk2(f[4], f[5]); w.w = pk2(f[6], f[7]); return w; }
DI float sigmoidf_(float x) { return __builtin_amdgcn_rcpf(1.0f + __expf(-x)); }
DI float siluf_(float x) { return x * __builtin_amdgcn_rcpf(1.0f + __expf(-x)); }
DI float softplusf_(float x) { return x > 20.f ? x : log1pf(__expf(x)); }
DI float gelu_tanh(float x) { const float y = 1.5957691216f * (x + 0.044715f * x * x * x); return x * __builtin_amdgcn_rcpf(1.0f + __expf(-y)); }
DI float wave_sum(float v) {
#pragma unroll
    for (int o = 1; o < 64; o <<= 1) v += __shfl_xor(v, o);
    return v;
}
DI int seq_of(int row) { int q = row < NP ? (row >> 11) : 8 + row - NP; return q > NSEQ - 1 ? NSEQ - 1 : q; }

#define XB_TMO      128
#define XB_XCNT(j)  (256  + 64 * (j))
#define XB_XSUB(j)  (1280 + 64 * (j))
#define XB_XGEN(j)  (2304 + 64 * (j))
#define XB_TOP      3328
#define XB_TOPGEN   3392
#define XCD_BAR_WORDS 3456
#define XB_SPIN_CAP (1u << 18)

__device__ __forceinline__ unsigned xb_ld(unsigned* p)              { return __hip_atomic_load(p, __ATOMIC_RELAXED, __HIP_MEMORY_SCOPE_AGENT); }
__device__ __forceinline__ unsigned xb_add(unsigned* p, unsigned v) { return __hip_atomic_fetch_add(p, v, __ATOMIC_RELAXED, __HIP_MEMORY_SCOPE_AGENT); }
__device__ __forceinline__ unsigned xb_xcc_id() { return (unsigned)__builtin_amdgcn_s_getreg((3 << 11) | 20) & 0xFu; }
#define XB_SPIN(cond, bar) do { unsigned _sp = 0; while (cond) { __builtin_amdgcn_s_sleep(1); \
    if ((++_sp & 255u) == 0u) { if (xb_ld(&(bar)[XB_TMO])) break; if (_sp > XB_SPIN_CAP) { atomicAdd(&(bar)[XB_TMO], 1u); break; } } } } while (0)

struct XcdBarrier {
    unsigned* bar; unsigned x;
    volatile LAS unsigned* st;
};

__device__ __forceinline__ XcdBarrier xcd_barrier_post(unsigned* bar, volatile LAS unsigned* st) {
    XcdBarrier b; b.bar = bar; b.x = xb_xcc_id(); b.st = st;
    if (threadIdx.x == 0) (void)xb_add(&bar[XB_XCNT(b.x)], 1u);
    return b;
}
__device__ __forceinline__ void xcd_barrier_complete(unsigned* bar, unsigned x, unsigned& nloc, unsigned& nx) {
    const unsigned G = gridDim.x * gridDim.y * gridDim.z;
    unsigned sum, cnt, mine, sp = 0u;
    for (;;) {
        sum = 0u; cnt = 0u; mine = 0u;
#pragma unroll
        for (unsigned j = 0; j < 16; ++j) { const unsigned c = xb_ld(&bar[XB_XCNT(j)]); sum += c; cnt += (c > 0u) ? 1u : 0u; mine = (j == x) ? c : mine; }
        if (sum == G) break;
        __builtin_amdgcn_s_sleep(1);
        if ((++sp & 255u) == 0u) { if (xb_ld(&bar[XB_TMO])) break; if (sp > XB_SPIN_CAP) { atomicAdd(&bar[XB_TMO], 1u); break; } }
    }
    nloc = mine > 0u ? mine : 1u; nx = cnt > 0u ? cnt : 1u;
}

__device__ __forceinline__ void xcd_barrier(const XcdBarrier& b) {
    asm volatile("s_waitcnt vmcnt(0)" ::: "memory");
    __syncthreads();
    if (threadIdx.x == 0) {
        unsigned* bar = b.bar;
        __builtin_amdgcn_s_waitcnt(0);
        unsigned nloc = b.st[0], nx = b.st[1];
        if (nloc == 0u) { xcd_barrier_complete(bar, b.x, nloc, nx); b.st[0] = nloc; b.st[1] = nx; }
        const unsigned old = xb_add(&bar[XB_XSUB(b.x)], 1u);
        const unsigned gen = old / nloc;
        if (old + 1u == (gen + 1u) * nloc) {
            __builtin_amdgcn_fence(__ATOMIC_RELEASE, "agent");
            asm volatile("s_waitcnt vmcnt(0)" ::: "memory");
            const unsigned og = xb_add(&bar[XB_TOP], 1u);
            const unsigned tg = og / nx;
            if (og + 1u == (tg + 1u) * nx) xb_add(&bar[XB_TOPGEN], 1u);
            else XB_SPIN(xb_ld(&bar[XB_TOPGEN]) == tg, bar);
            __builtin_amdgcn_fence(__ATOMIC_ACQUIRE, "agent");
            xb_add(&bar[XB_XGEN(b.x)], 1u);
            asm volatile("s_waitcnt vmcnt(0)" ::: "memory");
        } else {
            XB_SPIN(xb_ld(&bar[XB_XGEN(b.x)]) == gen, bar);
            __builtin_amdgcn_fence(__ATOMIC_ACQUIRE, "agent");
            asm volatile("s_waitcnt vmcnt(0)" ::: "memory");
        }
    }
    __syncthreads();
}

struct EpiMod {
    static constexpr bool PERM = false, AFTER_DRAIN = false;
    float* MOD; const float* bias;
    DI void operator()(const f32x4 (&acc)[2][2][4][2], const pg8::Unit& u, int wr, int wc, int fr, int fq) const {
        const int row0 = u.pm * 256 + wr * 64 + fr, col0 = u.pn * 256 + wc * 32 + 4 * fq;
#pragma unroll
        for (int ai = 0; ai < 2; ++ai)
#pragma unroll
            for (int m = 0; m < 4; ++m) { const int row = row0 + ai * 128 + m * 16;
                if (row < NSEQ) {
#pragma unroll
                    for (int bj = 0; bj < 2; ++bj)
#pragma unroll
                        for (int n = 0; n < 2; ++n) { const int col = col0 + bj * 128 + n * 16, layer = col / MODW, c = col - layer * MODW;
                            *(f32x4*)(MOD + ((size_t)layer * NSEQ + row) * MODW + c) = acc[ai][bj][m][n] + *(const f32x4*)(bias + col); } } }
    }
};
struct EpiRes {
    static constexpr bool PERM = false, AFTER_DRAIN = false;
    const float* bp; const float* bs; float* X; const float* gate;
    DI void operator()(const f32x4 (&acc)[2][2][4][2], const pg8::Unit& u, int wr, int wc, int fr, int fq) const {
        const int row0 = u.pm * 256 + wr * 64 + fr, col0 = u.pn * 256 + wc * 32 + 4 * fq;
#pragma unroll
        for (int ai = 0; ai < 2; ++ai)
#pragma unroll
            for (int m = 0; m < 4; ++m) { const int row = row0 + ai * 128 + m * 16;
                if (row < NR) { const float* base = row < NP ? bp + (size_t)row * D : bs + (size_t)(row - NP) * D; const float* gp = gate + (size_t)seq_of(row) * MODW; float* o = X + (size_t)row * D;
#pragma unroll
                    for (int bj = 0; bj < 2; ++bj)
#pragma unroll
                        for (int n = 0; n < 2; ++n) { const int col = col0 + bj * 128 + n * 16;
                            *(f32x4*)(o + col) = *(const f32x4*)(base + col) + *(const f32x4*)(gp + col) * acc[ai][bj][m][n]; } }
                asm volatile("" ::: "memory"); }
    }
};
struct EpiResNorm {
    static constexpr bool PERM = false, AFTER_DRAIN = true;
    const float* bp; float* X; const float* gate; const float* sc; const float* sh; bf16_t* UB; float* xs; unsigned* cnt;
    DI void operator()(const f32x4 (&)[2][2][4][2], const pg8::Unit&, int, int, int, int) const {}
    DI void fused(f32x4 (&acc)[2][2][4][2], const pg8::Unit& u, int wr, int wc, int fr, int fq, PG8_LAS unsigned char* lds, int wid, int lane) const {
        LAS float* Pp = (LAS float*)lds; LAS float* Sr = (LAS float*)(lds + 8192);
        const int row0 = u.pm * 256 + wr * 64 + fr, col0 = u.pn * 256 + wc * 32 + 4 * fq; const int q = (u.pm * 256) >> 11;
        const float* gp = gate + (size_t)q * MODW + col0;
#pragma unroll
        for (int ai = 0; ai < 2; ++ai)
#pragma unroll
            for (int m = 0; m < 4; ++m) { int row = row0 + ai * 128 + m * 16; asm volatile("" : "+v"(row)); const float* base = bp + (size_t)row * D + col0; float* o = X + (size_t)row * D + col0; float s = 0.f;
#pragma unroll
                for (int bj = 0; bj < 2; ++bj)
#pragma unroll
                    for (int n = 0; n < 2; ++n) { const int co = bj * 128 + n * 16; const f32x4 v = *(const f32x4*)(base + co) + *(const f32x4*)(gp + co) * acc[ai][bj][m][n];
                        acc[ai][bj][m][n] = v; *(f32x4*)(o + co) = v; s += (v.x * v.x + v.y * v.y) + (v.z * v.z + v.w * v.w); }
                s += __shfl_xor(s, 16); s += __shfl_xor(s, 32);
                if (fq == 0) Pp[(ai * 128 + wr * 64 + m * 16 + fr) * 4 + wc] = s;
                asm volatile("" ::: "memory"); }
        asm volatile("s_waitcnt lgkmcnt(0)" ::: "memory"); __builtin_amdgcn_s_barrier(); asm volatile("" ::: "memory");
        const int prow = wid * 32 + (lane & 31);
        if (lane < 32) { const float t = (Pp[prow * 4 + 0] + Pp[prow * 4 + 1]) + (Pp[prow * 4 + 2] + Pp[prow * 4 + 3]);
            __hip_atomic_store(xs + ((size_t)(u.pm * 256 + prow) * 4 + u.pn), t, __ATOMIC_RELAXED, __HIP_MEMORY_SCOPE_AGENT); }
        asm volatile("s_waitcnt vmcnt(0)" ::: "memory");
        if (lane == 0) __hip_atomic_fetch_add(cnt + 64 * u.pm, 1u, __ATOMIC_RELAXED, __HIP_MEMORY_SCOPE_AGENT);
        if (wid == 0) { unsigned spins = 0;
            while ((unsigned)__builtin_amdgcn_readfirstlane(__hip_atomic_load(cnt + 64 * u.pm, __ATOMIC_RELAXED, __HIP_MEMORY_SCOPE_AGENT)) < 32u) { __builtin_amdgcn_s_sleep(2); if (++spins > (1u << 22)) break; }
            __builtin_amdgcn_fence(__ATOMIC_ACQUIRE, "agent"); }
        asm volatile("s_waitcnt vmcnt(0) lgkmcnt(0)" ::: "memory"); __builtin_amdgcn_s_barrier(); asm volatile("" ::: "memory");
        if (lane < 32) { const float* sl = xs + (size_t)(u.pm * 256 + prow) * 4; float t = 0.f;
#pragma unroll
            for (int k = 0; k < 4; ++k) t += __hip_atomic_load(sl + k, __ATOMIC_RELAXED, __HIP_MEMORY_SCOPE_AGENT);
            Sr[prow] = rsqrtf(t * (1.0f / D) + EPS); }
        asm volatile("s_waitcnt lgkmcnt(0)" ::: "memory"); __builtin_amdgcn_s_barrier(); asm volatile("" ::: "memory");
        const float* scp = sc + (size_t)q * MODW + col0; const float* shp = sh + (size_t)q * MODW + col0;
#pragma unroll
        for (int ai = 0; ai < 2; ++ai)
#pragma unroll
            for (int m = 0; m < 4; ++m) { int lrow = ai * 128 + wr * 64 + m * 16 + fr; asm volatile("" : "+v"(lrow)); const float rstd = Sr[lrow]; bf16_t* o = UB + (size_t)(u.pm * 256 + lrow) * D + col0;
#pragma unroll
                for (int bj = 0; bj < 2; ++bj)
#pragma unroll
                    for (int n = 0; n < 2; ++n) { const int co = bj * 128 + n * 16; const f32x4 v = acc[ai][bj][m][n] * rstd * (*(const f32x4*)(scp + co) + 1.0f) + *(const f32x4*)(shp + co);
                        u32x2 w; w.x = pk2(v.x, v.y); w.y = pk2(v.z, v.w); *(u32x2*)(o + co) = w; }
                asm volatile("" ::: "memory"); }
    }
};
struct EpiResAtomic {
    static constexpr bool PERM = false, AFTER_DRAIN = false;
    float* X; const float* gate;
    DI void operator()(const f32x4 (&acc)[2][2][4][2], const pg8::Unit& u, int wr, int wc, int fr, int fq) const {
        const int row0 = NP + wr * 64 + fr, col0 = (u.pn & 3) * 256 + wc * 32 + 4 * fq;
#pragma unroll
        for (int ai = 0; ai < 2; ++ai)
#pragma unroll
            for (int m = 0; m < 4; ++m) { int row = row0 + ai * 128 + m * 16; asm volatile("" : "+v"(row));
                if (row < NR) { const float* gp = gate + (size_t)seq_of(row) * MODW + col0; float* o = X + (size_t)row * D + col0;
#pragma unroll
                    for (int bj = 0; bj < 2; ++bj)
#pragma unroll
                        for (int n = 0; n < 2; ++n) { const f32x4 gv = *(const f32x4*)(gp + bj * 128 + n * 16) * acc[ai][bj][m][n];
#pragma unroll
                            for (int e = 0; e < 4; ++e) __hip_atomic_fetch_add(o + bj * 128 + n * 16 + e, gv[e], __ATOMIC_RELAXED, __HIP_MEMORY_SCOPE_AGENT); } }
                asm volatile("" ::: "memory"); }
    }
};
struct EpiSplit {
    static constexpr bool PERM = true, AFTER_DRAIN = false;
    int act; bf16_t* O0; int ld0, b1; bf16_t* O1; int ld1, b2; float* F; int ldf, ntail;
    DI void operator()(const f32x4 (&acc)[2][2][4][2], const pg8::Unit& u, int wr, int wc, int fr, int fq) const {
        const int row0 = u.pm * 256 + wr * 64 + fr; const int colt = u.pn * 256;
        if (colt >= b2) {
            const int c0 = colt - b2 + wc * 32 + 8 * fq;
#pragma unroll
            for (int ai = 0; ai < 2; ++ai)
#pragma unroll
                for (int m = 0; m < 4; ++m) { const int row = row0 + ai * 128 + m * 16;
#pragma unroll
                    for (int bj = 0; bj < 2; ++bj)
#pragma unroll
                        for (int n = 0; n < 2; ++n) { const int c = c0 + bj * 128 + 4 * n; if (c < ntail) *(f32x4*)(F + (size_t)row * ldf + c) = acc[ai][bj][m][n]; } }
            return;
        }
        const bool s0 = colt < b1; bf16_t* base = s0 ? O0 : O1; const int ld = s0 ? ld0 : ld1; const int col0 = (s0 ? colt : colt - b1) + wc * 32 + 8 * fq;
#pragma unroll
        for (int ai = 0; ai < 2; ++ai)
#pragma unroll
            for (int m = 0; m < 4; ++m) { bf16_t* rowp = base + (size_t)(row0 + ai * 128 + m * 16) * ld + col0;
#pragma unroll
                for (int bj = 0; bj < 2; ++bj) { f32x4 v0 = acc[ai][bj][m][0], v1 = acc[ai][bj][m][1];
                    if (act == 1 && s0) {
#pragma unroll
                        for (int j = 0; j < 4; ++j) { v0[j] = gelu_tanh(v0[j]); v1[j] = gelu_tanh(v1[j]); } }
                    if (act == 2) {
#pragma unroll
                        for (int j = 0; j < 4; ++j) { const float a = fmaxf(v0[j], 0.f), b = fmaxf(v1[j], 0.f); v0[j] = a * a; v1[j] = b * b; } }
                    u32x4 w; w.x = pg8::cvt_pk_bf16(v0[0], v0[1]); w.y = pg8::cvt_pk_bf16(v0[2], v0[3]); w.z = pg8::cvt_pk_bf16(v1[0], v1[1]); w.w = pg8::cvt_pk_bf16(v1[2], v1[3]);
                    *(u32x4*)(rowp + bj * 128) = w; } }
    }
};
struct EpiGate {
    static constexpr bool PERM = false, AFTER_DRAIN = false;
    const bf16_t* XB; const float* gb; const float* ls8; float* LA; float* BX;
    DI void operator()(const f32x4 (&acc)[2][2][4][2], const pg8::Unit& u, int wr, int wc, int fr, int fq) const {
        const int row0 = u.pm * 256 + wr * 64 + fr, ch0 = u.pn * 128 + wc * 32 + 4 * fq;
#pragma unroll
        for (int n = 0; n < 2; ++n) { const int ch = ch0 + n * 16; const f32x4 br = *(const f32x4*)(gb + ch), bi = *(const f32x4*)(gb + D + ch), ls = *(const f32x4*)(ls8 + ch);
#pragma unroll
            for (int ai = 0; ai < 2; ++ai)
#pragma unroll
                for (int m = 0; m < 4; ++m) { const int row = row0 + ai * 128 + m * 16; int o = row * D + ch; asm volatile("" : "+v"(o));
                    if (row < NR) { const u32x2 xw = *(const u32x2*)(XB + o);
                        const float xb[4] = {lo16(xw.x), hi16(xw.x), lo16(xw.y), hi16(xw.y)}; f32x4 la, bx;
#pragma unroll
                        for (int j = 0; j < 4; ++j) { const float r = sigmoidf_(acc[ai][0][m][n][j] + br[j]), ig = sigmoidf_(acc[ai][1][m][n][j] + bi[j]);
                            const float l = r * ls[j], a = __expf(l); la[j] = l; bx[j] = __builtin_amdgcn_sqrtf(fmaxf(1.0f - a * a, 0.f)) * ig * xb[j]; }
                        *(f32x4*)(LA + o) = la; *(f32x4*)(BX + o) = bx; }
                    asm volatile("" ::: "memory"); } }
    }
};
DI void transpose_item(const float* W, int K, int N, bf16_t* WT, int row_off, LAS float* scr, int kb, int nb, int lane) {
    const int k0 = 64 * kb, n0 = 32 * nb; const int n4 = (lane & 7) * 4, kr = lane >> 3;
    const GAS float* Wg = (const GAS float*)W; GAS bf16_t* WTg = (GAS bf16_t*)WT;
    f32x4 v[8];
    if (n0 + 32 <= N) {
#pragma unroll
        for (int i = 0; i < 8; ++i) v[i] = *(const GAS f32x4*)(Wg + (size_t)(k0 + i * 8 + kr) * N + n0 + n4);
    } else {
#pragma unroll
        for (int i = 0; i < 8; ++i) { const GAS float* src = Wg + (size_t)(k0 + i * 8 + kr) * N + n0 + n4;
#pragma unroll
            for (int e = 0; e < 4; ++e) v[i][e] = (n0 + n4 + e < N) ? src[e] : 0.f; }
    }
#pragma unroll
    for (int i = 0; i < 8; ++i) { LAS float* d = scr + (i * 8 + kr) * 33 + n4; d[0] = v[i].x; d[1] = v[i].y; d[2] = v[i].z; d[3] = v[i].w; }
    asm volatile("s_waitcnt lgkmcnt(0)" ::: "memory");
    const int c = lane & 7;
#pragma unroll
    for (int j = 0; j < 4; ++j) { const int n = (lane >> 3) + 8 * j; const LAS float* s = scr + (8 * c) * 33 + n;
        u32x4 o; o.x = pk2(s[0 * 33], s[1 * 33]); o.y = pk2(s[2 * 33], s[3 * 33]); o.z = pk2(s[4 * 33], s[5 * 33]); o.w = pk2(s[6 * 33], s[7 * 33]);
        if (n0 + n < N) *(GAS u32x4*)(WTg + (size_t)(row_off + n0 + n) * K + k0 + 8 * c) = o; }
    asm volatile("s_waitcnt lgkmcnt(0)" ::: "memory");
}
struct TJob { const float* W; bf16_t* WT; int K, N, mode, aux; };
template <class ArgsRef> DI void prep_phase(const Ctx& c, const ArgsRef& a, bool first) {
    unsigned char* ws = a.ws;
    LAS TJob* jobs = (LAS TJob*)(c.lds + 131072 - 4096); LAS int* cum = (LAS int*)(c.lds + 131072 - 512);
    constexpr int NJ = 40;
    if (c.tid == 0) {
        int j = 0;
        auto add = [&](const float* W, bf16_t* WT, int K, int N, int mode, int aux) { jobs[j].W = W; jobs[j].WT = WT; jobs[j].K = K; jobs[j].N = N; jobs[j].mode = mode; jobs[j].aux = aux; ++j; };
        for (int i = 0; i < 4; ++i) add(GIN(10) + (size_t)i * 1024 * MODW, (bf16_t*)(ws + WS_P) + (size_t)i * MODW * 1024, 1024, MODW, 0, 0);
        for (int i = 0; i < 4; ++i) add(GIN(12) + (size_t)i * 1024 * 4096, (bf16_t*)(ws + WS_WUP) + (size_t)i * 4096 * 1024, 1024, 4096, 0, 0);
        for (int i = 0; i < 4; ++i) add(GIN(13) + (size_t)i * 1024 * 4096, (bf16_t*)(ws + WS_WDN) + (size_t)i * 4096 * 1024, 4096, 1024, 0, 0);
        for (int i = 0; i < 2; ++i) add(GIN(15) + (size_t)i * 1024 * 2048, (bf16_t*)(ws + WS_RGIN) + (size_t)i * 2048 * 1024, 1024, 2048, 0, 0);
        for (int i = 0; i < 16; ++i) add(GIN(18) + (size_t)i * 65536, (bf16_t*)(ws + WS_RGGATE) + (size_t)(i >> 3) * 2048 * 256, 256, 256, 1, i & 7);
        for (int i = 0; i < 2; ++i) add(GIN(21) + (size_t)i * 1024 * 1024, (bf16_t*)(ws + WS_RGOUT) + (size_t)i * 1024 * 1024, 1024, 1024, 0, 0);
        add(GIN(22), (bf16_t*)(ws + WS_GDNIN), 1024, GDN_N, 0, 0);
        add(GIN(27), (bf16_t*)(ws + WS_GDNOUT), 1024, 1024, 0, 0);
        add(GIN(28), (bf16_t*)(ws + WS_SSDIN), 1024, SSD_N, 0, 0);
        add(GIN(35), (bf16_t*)(ws + WS_SSDOUT), 2048, 1024, 0, 0);
        int s = 0; for (int i = 0; i < NJ; ++i) { if (i < j) s += (jobs[i].K / 64) * ((jobs[i].N + 31) / 32); cum[i] = s; }
    }
    __syncthreads();
    const int total = cum[NJ - 1]; const int gw = c.bid * 8 + c.wave, NGW = c.G * 8;
    LAS float* scr = (LAS float*)(c.lds + c.wave * 8704);
    for (int it = gw; it < total; it += NGW) {
        int j = 0; while (cum[j] <= it) ++j;
        const int r = it - (j ? cum[j - 1] : 0); const int K = jobs[j].K, N = jobs[j].N, nblk = (N + 31) / 32, kb = r / nblk, nb = r % nblk;
        int row_off = 0;
        if (jobs[j].mode == 1) { const int g = jobs[j].aux >> 2, blk = jobs[j].aux & 3, n0 = nb * 32; row_off = 256 * (2 * blk + (n0 >> 7)) + 128 * g + (n0 & 127) - n0; }
        transpose_item(jobs[j].W, K, N, jobs[j].WT, row_off, scr, kb, nb, c.lane);
    }
    const int gt = c.bid * 512 + c.tid, NT = c.G * 512;
    bf16_t* SC = (bf16_t*)(ws + WS_SC);
    for (int i = gt; i < 256 * 128; i += NT) { const int row = i >> 7, c8 = (i & 127) * 8; float f[8];
        if (row < NSEQ) { const float* src = row < 8 ? GIN(8) + row * D + c8 : GIN(9) + (row - 8) * D + c8;
#pragma unroll
            for (int e = 0; e < 8; ++e) f[e] = siluf_(src[e]); }
        else {
#pragma unroll
            for (int e = 0; e < 8; ++e) f[e] = 0.f; }
        *(u32x4*)(SC + (size_t)row * D + c8) = pack8(f); }
    for (int i = gt; i < 2 * D; i += NT) ((float*)(ws + WS_LS8))[i] = -8.0f * log1pf(__expf(-GIN(20)[i]));
    if (c.bid == 0 && first) for (int i = c.tid; i < 4096; i += 512) ((unsigned*)(ws + WS_BAR))[i] = 0u;
    for (int i = gt; i < 8 * 64 * 64; i += NT) ((unsigned*)(ws + WS_CNT))[i] = 0u;
    for (int i = gt; i < NS * D / 4; i += NT) ((f32x4*)(ws + WS_X + (size_t)NP * D * 4))[i] = ((const f32x4*)GIN(1))[i];
    const u32x4 z4 = {0u, 0u, 0u, 0u};
    for (int i = gt; i < (GDN_NP - GDN_N) * 128; i += NT) *(u32x4*)((bf16_t*)(ws + WS_GDNIN) + (size_t)GDN_N * 1024 + (size_t)i * 8) = z4;
    for (int i = gt; i < (SSD_NP - SSD_N) * 128; i += NT) *(u32x4*)((bf16_t*)(ws + WS_SSDIN) + (size_t)SSD_N * 1024 + (size_t)i * 8) = z4;
}

DI void norm_mod_phase(const Ctx& c, const float* __restrict__ xp, const float* __restrict__ xs, const float* __restrict__ sc, const float* __restrict__ sh, bf16_t* __restrict__ out, int r_begin) {
    const int stride = c.G * 8;
    for (int r = r_begin + c.bid * 8 + c.wave; r < NR; r += 2 * stride) {
        const int r2 = r + stride; const bool two = r2 < NR; const int rb = two ? r2 : r;
        const float* xa = r < NP ? xp + (size_t)r * D : xs + (size_t)(r - NP) * D; const float* xb = rb < NP ? xp + (size_t)rb * D : xs + (size_t)(rb - NP) * D;
        f32x4 va[4], vb[4]; float sa = 0.f, sb = 0.f;
#pragma unroll
        for (int j = 0; j < 4; ++j) { va[j] = *(const f32x4*)(xa + c.lane * 4 + 256 * j); vb[j] = *(const f32x4*)(xb + c.lane * 4 + 256 * j); }
#pragma unroll
        for (int j = 0; j < 4; ++j) { sa += (va[j].x * va[j].x + va[j].y * va[j].y) + (va[j].z * va[j].z + va[j].w * va[j].w); sb += (vb[j].x * vb[j].x + vb[j].y * vb[j].y) + (vb[j].z * vb[j].z + vb[j].w * vb[j].w); }
        const float ra = rsqrtf(wave_sum(sa) * (1.0f / D) + EPS), rbs = rsqrtf(wave_sum(sb) * (1.0f / D) + EPS);
        const int qa = seq_of(r), qb = seq_of(rb);
#pragma unroll
        for (int j = 0; j < 4; ++j) { const int col = c.lane * 4 + 256 * j;
            { const f32x4 s1 = *(const f32x4*)(sc + (size_t)qa * MODW + col), s2 = *(const f32x4*)(sh + (size_t)qa * MODW + col);
              const f32x4 o = va[j] * ra * (s1 + 1.0f) + s2; u32x2 w; w.x = pk2(o.x, o.y); w.y = pk2(o.z, o.w); *(u32x2*)(out + (size_t)r * D + col) = w; }
            if (two) { const f32x4 s1 = *(const f32x4*)(sc + (size_t)qb * MODW + col), s2 = *(const f32x4*)(sh + (size_t)qb * MODW + col);
              const f32x4 o = vb[j] * rbs * (s1 + 1.0f) + s2; u32x2 w; w.x = pk2(o.x, o.y); w.y = pk2(o.z, o.w); *(u32x2*)(out + (size_t)r2 * D + col) = w; } }
    }
}
DI void final_norm_phase(const Ctx& c, const float* X, const float* g, float* out) {
    for (int r = c.bid * 8 + c.wave; r < NR; r += c.G * 8) {
        const float* xr = X + (size_t)r * D; f32x4 v[4]; float ss = 0.f;
#pragma unroll
        for (int j = 0; j < 4; ++j) { v[j] = *(const f32x4*)(xr + c.lane * 4 + 256 * j); ss += (v[j].x * v[j].x + v[j].y * v[j].y) + (v[j].z * v[j].z + v[j].w * v[j].w); }
        const float rstd = rsqrtf(wave_sum(ss) * (1.0f / D) + EPS);
#pragma unroll
        for (int j = 0; j < 4; ++j) { const int col = c.lane * 4 + 256 * j; *(f32x4*)(out + (size_t)r * D + col) = v[j] * rstd * *(const f32x4*)(g + col); }
    }
}

DI void conv8(const bf16_t* P, int ld, int row, int t, const float* st, int nch, const float* w, const float* b, int ch, float* f, float* cur) {
    float x[4][8];
    unpack8(*(const u32x4*)(P + (size_t)row * ld), x[3]);
#pragma unroll
    for (int k = 0; k < 3; ++k) {
        if (t < 0) { const f32x4 a0 = *(const f32x4*)(st + k * nch + ch), a1 = *(const f32x4*)(st + k * nch + ch + 4); x[k][0] = a0.x; x[k][1] = a0.y; x[k][2] = a0.z; x[k][3] = a0.w; x[k][4] = a1.x; x[k][5] = a1.y; x[k][6] = a1.z; x[k][7] = a1.w; }
        else if (t - 3 + k >= 0) unpack8(*(const u32x4*)(P + (size_t)(row - 3 + k) * ld), x[k]);
        else {
#pragma unroll
            for (int e = 0; e < 8; ++e) x[k][e] = 0.f; }
    }
#pragma unroll
    for (int e = 0; e < 8; ++e) { f[e] = b ? b[ch + e] : 0.f; cur[e] = x[3][e]; }
#pragma unroll
    for (int k = 0; k < 4; ++k) { const f32x4 w0 = *(const f32x4*)(w + k * nch + ch), w1 = *(const f32x4*)(w + k * nch + ch + 4);
        f[0] += x[k][0] * w0.x; f[1] += x[k][1] * w0.y; f[2] += x[k][2] * w0.z; f[3] += x[k][3] * w0.w; f[4] += x[k][4] * w1.x; f[5] += x[k][5] * w1.y; f[6] += x[k][6] * w1.z; f[7] += x[k][7] * w1.w; }
}
DI void conv_state8(int row, int t, const float* cur, const float* st, int nch, int ch, float* pout  , float* sout  ) {
    if (t >= 0) { if (t >= SEQL - 3) { float* o = pout + ((size_t)(row >> 11) * 3 + (t - (SEQL - 3))) * nch + ch; *(f32x4*)o = (f32x4){cur[0], cur[1], cur[2], cur[3]}; *(f32x4*)(o + 4) = (f32x4){cur[4], cur[5], cur[6], cur[7]}; } }
    else { const int s = row - NP; float* o = sout + (size_t)s * 3 * nch + ch;
        *(f32x4*)o = *(const f32x4*)(st + nch + ch); *(f32x4*)(o + 4) = *(const f32x4*)(st + nch + ch + 4);
        *(f32x4*)(o + nch) = *(const f32x4*)(st + 2 * nch + ch); *(f32x4*)(o + nch + 4) = *(const f32x4*)(st + 2 * nch + ch + 4);
        *(f32x4*)(o + 2 * nch) = (f32x4){cur[0], cur[1], cur[2], cur[3]}; *(f32x4*)(o + 2 * nch + 4) = (f32x4){cur[4], cur[5], cur[6], cur[7]}; }
}

DI void conv8_slide(const bf16_t* Pc  , int ld, int r0, const float* w, const float* b, int nch, int ch, float (&out)[8][8], u32x4 (&raw)[11]) {
    const bool head = (r0 & (SEQL - 1)) == 0; const u32x4 z = {0u, 0u, 0u, 0u};
#pragma unroll
    for (int k = 0; k < 11; ++k) raw[k] = (k < 3 && head) ? z : *(const u32x4*)(Pc + (size_t)(r0 - 3 + k) * ld);
    float wk[4][8], bb[8];
#pragma unroll
    for (int k = 0; k < 4; ++k) { const f32x4 w0 = *(const f32x4*)(w + k * nch + ch), w1 = *(const f32x4*)(w + k * nch + ch + 4); wk[k][0] = w0.x; wk[k][1] = w0.y; wk[k][2] = w0.z; wk[k][3] = w0.w; wk[k][4] = w1.x; wk[k][5] = w1.y; wk[k][6] = w1.z; wk[k][7] = w1.w; }
#pragma unroll
    for (int e = 0; e < 8; ++e) bb[e] = b ? b[ch + e] : 0.f;
#pragma unroll
    for (int t = 0; t < 8; ++t)
#pragma unroll
        for (int e = 0; e < 8; ++e) out[t][e] = bb[e];
#pragma unroll
    for (int k = 0; k < 11; ++k) { float x[8]; unpack8(raw[k], x);
#pragma unroll
        for (int t = 0; t < 8; ++t) { const int tap = k - t; if (tap >= 0 && tap < 4) {
#pragma unroll
            for (int e = 0; e < 8; ++e) out[t][e] += x[e] * wk[tap][e]; } } }
}
DI void prompt_conv_state(const Ctx& c, const bf16_t* P, int ld, int nch, float* pout) {
    for (int i = c.bid * 512 + c.tid; i < 8 * 3 * nch; i += c.G * 512) { const int ch = i % nch, r = i / nch, k = r % 3, b = r / 3;
        pout[i] = bf2f(P[(size_t)(b * SEQL + SEQL - 3 + k) * ld + ch]); }
}
DI void rg_conv_phase(const Ctx& c, const bf16_t* P  , const float* cw, const float* cb, const float* st  , bf16_t* XB, float* pout, float* sout) {
    for (int i = c.bid * 512 + c.tid; i < (NP / 8) * 128; i += c.G * 512) {
        const int r0 = (i >> 7) * 8, ch = (i & 127) * 8; float o[8][8]; u32x4 raw[11];
        conv8_slide(P + 1024 + ch, 2048, r0, cw, cb, D, ch, o, raw);
#pragma unroll
        for (int t = 0; t < 8; ++t) *(u32x4*)(XB + (size_t)(r0 + t) * D + ch) = pack8(o[t]);
    }
    for (int i = c.bid * 512 + c.tid; i < NS * 128; i += c.G * 512) {
        const int row = NP + (i >> 7), ch = (i & 127) * 8; const float* sp = st + (size_t)(row - NP) * 3 * D;
        float f[8], cur[8]; conv8(P + 1024 + ch, 2048, row, -1, sp, D, cw, cb, ch, f, cur);
        *(u32x4*)(XB + (size_t)row * D + ch) = pack8(f);
        conv_state8(row, -1, cur, sp, D, ch, pout, sout);
    }
    prompt_conv_state(c, P + 1024, 2048, D, pout);
}
DI void rg_scan_phase(const Ctx& c, const float* __restrict__ LA, const float* __restrict__ BX, const bf16_t* __restrict__ P  , const float* h0  , bf16_t* __restrict__ HY, float* ph  , float* sh  ) {
    LAS float* sA = (LAS float*)c.lds; LAS float* sB = sA + 512;
    for (int it = c.bid; it < 256; it += c.G) {
        const int b = it >> 5, ch = (it & 31) * 32 + (c.tid & 31), seg = c.tid >> 5; const int r0 = b * SEQL + seg * 128;
        const float* lap = LA + (size_t)r0 * D + ch; const float* bxp = BX + (size_t)r0 * D + ch; const bf16_t* yp = P + (size_t)r0 * 2048 + ch; bf16_t* op = HY + (size_t)r0 * D + ch;
        float h = 0.f, ap = 0.f; unsigned pk[64];
#pragma unroll
        for (int t0 = 0; t0 < 128; t0 += 16) { float la[16], bx[16];
#pragma unroll
            for (int u = 0; u < 16; ++u) { la[u] = lap[(size_t)(t0 + u) * D]; bx[u] = bxp[(size_t)(t0 + u) * D]; }
#pragma unroll
            for (int u = 0; u < 16; ++u) { h = __expf(la[u]) * h + bx[u]; ap += la[u]; if (t0 >= 64) pk[t0 - 64 + u] = pk2(la[u], bx[u]); }
            asm volatile("" ::: "memory"); }
        sA[c.tid] = __expf(ap); sB[c.tid] = h;
        __syncthreads();
        float hin = 0.f;
        for (int s = 0; s < seg; ++s) hin = sA[s * 32 + (c.tid & 31)] * hin + sB[s * 32 + (c.tid & 31)];
        h = hin;
#pragma unroll 1
        for (int t0 = 0; t0 < 64; t0 += 16) { float la[16], bx[16]; bf16_t yv[16];
#pragma unroll
            for (int u = 0; u < 16; ++u) { la[u] = lap[(size_t)(t0 + u) * D]; bx[u] = bxp[(size_t)(t0 + u) * D]; yv[u] = yp[(size_t)(t0 + u) * 2048]; }
#pragma unroll
            for (int u = 0; u < 16; ++u) { h = __expf(la[u]) * h + bx[u]; op[(size_t)(t0 + u) * D] = (bf16_t)f2bf(h * bf2f(yv[u])); } }
#pragma unroll
        for (int t0 = 64; t0 < 128; t0 += 16) { bf16_t yv[16];
#pragma unroll
            for (int u = 0; u < 16; ++u) yv[u] = yp[(size_t)(t0 + u) * 2048];
#pragma unroll
            for (int u = 0; u < 16; ++u) { h = __expf(lo16(pk[t0 - 64 + u])) * h + hi16(pk[t0 - 64 + u]); op[(size_t)(t0 + u) * D] = (bf16_t)f2bf(h * bf2f(yv[u])); }
            asm volatile("" ::: "memory"); }
        if (seg == 15) ph[b * D + ch] = h;
        __syncthreads();
    }
    for (int i = c.bid * 512 + c.tid; i < NS * D; i += c.G * 512) { const int s = i >> 10, ch = i & 1023; const size_t o = (size_t)(NP + s) * D + ch;
        const float h = __expf(LA[o]) * h0[i] + BX[o]; sh[i] = h; HY[o] = (bf16_t)f2bf(h * bf2f(P[(size_t)(NP + s) * 2048 + ch])); }
}
DI void gdn_conv_phase(const Ctx& c, const bf16_t* P, const float* cw  , const float* st  , const float* AB, const float* A_log, const float* dt_bias,
                       bf16_t* Q, bf16_t* K, bf16_t* V, bf16_t* QKVS, float* GB, float* pout, float* sout) {
    for (int wt = c.bid * 8 + c.wave; wt < (NP / 8) * 6; wt += c.G * 8) {
        const int seg = wt % 6, r0 = (wt / 6) * 8, ch = seg * 512 + c.lane * 8; float o[8][8]; u32x4 raw[11];
        conv8_slide(P + ch, 3072, r0, cw, nullptr, 3072, ch, o, raw);
        bf16_t* dst = (seg < 2 ? Q : (seg < 4 ? K : V)) + (seg & 1) * 512 + c.lane * 8;
#pragma unroll
        for (int t = 0; t < 8; ++t) { float ss = 0.f;
#pragma unroll
            for (int e = 0; e < 8; ++e) { o[t][e] = siluf_(o[t][e]); ss += o[t][e] * o[t][e]; }
            if (seg < 4) { ss += __shfl_xor(ss, 1); ss += __shfl_xor(ss, 2); ss += __shfl_xor(ss, 4); ss += __shfl_xor(ss, 8);
                const float sc = rsqrtf(ss + EPS) * (seg < 2 ? 0.08838834764831845f : 1.0f);
#pragma unroll
                for (int e = 0; e < 8; ++e) o[t][e] *= sc; }
            *(u32x4*)(dst + (size_t)(r0 + t) * D) = pack8(o[t]); }
    }
    for (int row = NP + c.bid * 8 + c.wave; row < NR; row += c.G * 8) {
        const float* sp = st + (size_t)(row - NP) * 3 * 3072;
#pragma unroll 1
        for (int pass = 0; pass < 6; ++pass) {
            const int ch = pass * 512 + c.lane * 8; float f[8], cur[8];
            conv8(P + ch, 3072, row, -1, sp, 3072, cw, nullptr, ch, f, cur);
            conv_state8(row, -1, cur, sp, 3072, ch, pout, sout);
            float ss = 0.f;
#pragma unroll
            for (int e = 0; e < 8; ++e) { f[e] = siluf_(f[e]); ss += f[e] * f[e]; }
            if (pass < 4) { ss += __shfl_xor(ss, 1); ss += __shfl_xor(ss, 2); ss += __shfl_xor(ss, 4); ss += __shfl_xor(ss, 8);
                const float sc = rsqrtf(ss + EPS) * (pass < 2 ? 0.08838834764831845f : 1.0f);
#pragma unroll
                for (int e = 0; e < 8; ++e) f[e] *= sc; }
            *(u32x4*)(QKVS + ((size_t)(pass >> 1) * NS + (row - NP)) * D + (pass & 1) * 512 + c.lane * 8) = pack8(f);
        }
    }
    for (int i = c.bid * 512 + c.tid; i < NR * 8; i += c.G * 512) { const int row = i >> 3, h = i & 7; const float a_in = AB[(size_t)row * 16 + h], b_in = AB[(size_t)row * 16 + 8 + h];
        GB[(size_t)row * 16 + h] = -__expf(A_log[h]) * softplusf_(a_in + dt_bias[h]); GB[(size_t)row * 16 + 8 + h] = sigmoidf_(b_in); }
    prompt_conv_state(c, P, 3072, 3072, pout);
}
DI void gdn_prep_phase(const Ctx& c, const bf16_t* Q, const bf16_t* K, const bf16_t* V, const float* GB, float* UT, bf16_t* NW, bf16_t* QD, bf16_t* KDT, bf16_t* QKG, float* GL) {
    const int half = c.tid >> 8, t = c.tid & 255, w4 = c.wave & 3, lr = c.lane & 15, quad = c.lane >> 4;
    ldsp L = c.lds + half * 65536; ldsp kS = L, qS = L + 17408; LAS float* AT = (LAS float*)(L + 34816); LAS float* Gs = (LAS float*)(L + 51200); LAS float* Bs = Gs + 64; LAS float* EGs = Gs + 128;
    for (int pair = c.bid; pair < 1024; pair += c.G) {
        const int item = pair * 2 + half, n = item & 31, h = (item >> 5) & 7, b = item >> 8, r0 = b * SEQL + n * 64;
        if (t < 64) { float G = GB[(size_t)(r0 + t) * 16 + h]; const float be = GB[(size_t)(r0 + t) * 16 + 8 + h];
#pragma unroll
            for (int o = 1; o < 64; o <<= 1) { const float v = __shfl_up(G, o); if (c.lane >= o) G += v; }
            Gs[t] = G; Bs[t] = be; EGs[t] = __expf(G); }
#pragma unroll
        for (int i = 0; i < 4; ++i) { const int ci = t + i * 256, row = ci >> 4, cc = ci & 15; const size_t go = (size_t)(r0 + row) * D + h * 128 + cc * 8;
            *(LAS u32x4*)(kS + row * 272 + cc * 16) = *(const u32x4*)(K + go); *(LAS u32x4*)(qS + row * 272 + cc * 16) = *(const u32x4*)(Q + go); }
        __syncthreads();
        {
            const int ib = w4; float Gi[4], bi[4];
#pragma unroll
            for (int jj = 0; jj < 4; ++jj) { Gi[jj] = Gs[ib * 16 + quad * 4 + jj]; bi[jj] = Bs[ib * 16 + quad * 4 + jj]; }
            bf16_t* qkg = QKG + (size_t)item * 4096;
#pragma unroll 1
            for (int jb = 0; jb < 4; ++jb) {
                if (jb <= ib) {
                    f32x4 akk = {0.f, 0.f, 0.f, 0.f}, aqk = {0.f, 0.f, 0.f, 0.f};
#pragma unroll
                    for (int ks = 0; ks < 4; ++ks) { const bf16x8 ak = *(const LAS bf16x8*)(kS + (ib * 16 + lr) * 272 + ks * 64 + quad * 16), aq = *(const LAS bf16x8*)(qS + (ib * 16 + lr) * 272 + ks * 64 + quad * 16),
                                                                  bk = *(const LAS bf16x8*)(kS + (jb * 16 + lr) * 272 + ks * 64 + quad * 16);
                        akk = MFMA16(ak, bk, akk); aqk = MFMA16(aq, bk, aqk); }
                    const int j = jb * 16 + lr; const float Gj = Gs[j]; f32x4 av;
#pragma unroll
                    for (int jj = 0; jj < 4; ++jj) { const int i = ib * 16 + quad * 4 + jj; const float dec = i >= j ? __expf(Gi[jj] - Gj) : 0.f;
                        av[jj] = i > j ? bi[jj] * akk[jj] * dec : 0.f; qkg[i * 64 + j] = (bf16_t)f2bf(aqk[jj] * dec); }
                    *(LAS f32x4*)(AT + j * 64 + ib * 16 + quad * 4) = av;
                } else {
#pragma unroll
                    for (int jj = 0; jj < 4; ++jj) qkg[(ib * 16 + quad * 4 + jj) * 64 + jb * 16 + lr] = 0;
                }
            }
        }
#pragma unroll
        for (int i = 0; i < 4; ++i) { const int ci = t + i * 256, row = ci >> 4, cc = ci & 15; float f[8]; unpack8(*(const LAS u32x4*)(qS + row * 272 + cc * 16), f); const float eg = EGs[row];
#pragma unroll
            for (int e = 0; e < 8; ++e) f[e] *= eg;
            *(u32x4*)(QD + (size_t)(r0 + row) * D + h * 128 + cc * 8) = pack8(f); }
        { const int dk = t & 127, chf = t >> 7; const float Gl = Gs[63];
#pragma unroll
            for (int c8 = 0; c8 < 4; ++c8) { const int c0 = chf * 32 + c8 * 8; float f[8];
#pragma unroll
                for (int e = 0; e < 8; ++e) f[e] = bf2f(*(const LAS bf16_t*)(kS + (c0 + e) * 272 + dk * 2)) * __expf(Gl - Gs[c0 + e]);
                *(u32x4*)(KDT + ((size_t)item * 128 + dk) * 64 + c0) = pack8(f); }
            if (t == 0) GL[item] = __expf(Gl); }
        __syncthreads();
#pragma unroll
        for (int i = 0; i < 4; ++i) { const int ci = t + i * 256, row = ci >> 4, cc = ci & 15; *(LAS u32x4*)(qS + row * 272 + cc * 16) = *(const u32x4*)(V + (size_t)(r0 + row) * D + h * 128 + cc * 8); }
        __syncthreads();
        {
            float x[64];
            if (t < 128) {
#pragma unroll
                for (int i = 0; i < 64; ++i) x[i] = bf2f(*(const LAS bf16_t*)(qS + i * 272 + t * 2)) * Bs[i];
            } else {
#pragma unroll
                for (int i = 0; i < 64; ++i) x[i] = bf2f(*(const LAS bf16_t*)(kS + i * 272 + (t - 128) * 2)) * Bs[i] * EGs[i];
            }
#pragma unroll
            for (int j = 0; j < 63; ++j) {
#pragma unroll
                for (int i4 = ((j + 1) & ~3); i4 < 64; i4 += 4) { const f32x4 av = *(const LAS f32x4*)(AT + j * 64 + i4);
                    if (i4 + 0 > j) x[i4 + 0] -= av.x * x[j];
                    if (i4 + 1 > j) x[i4 + 1] -= av.y * x[j];
                    if (i4 + 2 > j) x[i4 + 2] -= av.z * x[j];
                    if (i4 + 3 > j) x[i4 + 3] -= av.w * x[j]; }
            }
            __syncthreads();
            if (t < 128) { float* o = UT + ((size_t)item * 128 + t) * 64;
#pragma unroll
                for (int i = 0; i < 16; ++i) *(f32x4*)(o + 4 * i) = (f32x4){x[4 * i], x[4 * i + 1], x[4 * i + 2], x[4 * i + 3]};
            } else {
#pragma unroll
                for (int i = 0; i < 64; ++i) *(LAS bf16_t*)(kS + i * 272 + (t - 128) * 2) = (bf16_t)f2bf(-x[i]);
            }
        }
        __syncthreads();
#pragma unroll
        for (int i = 0; i < 4; ++i) { const int ci = t + i * 256, row = ci >> 4, cc = ci & 15; *(u32x4*)(NW + (size_t)(r0 + row) * D + h * 128 + cc * 8) = *(const LAS u32x4*)(kS + row * 272 + cc * 16); }
        __syncthreads();
    }
}
DI void gdn_seq_phase(const Ctx& c, const float* UT, const bf16_t* NW, const bf16_t* QD, const bf16_t* KDT, const bf16_t* QKG, const float* GL, float* O, float* pS,
                      const bf16_t* QKVS, const float* GB, const float* S0, float* sS) {
    const int lr = c.lane & 15, quad = c.lane >> 4, w = c.wave;
    ldsp Ws = c.lds, Qs = c.lds + 17408, KTs = c.lds + 34816, QKs = c.lds + 53248, Sts = c.lds + 62464, VTs = c.lds + 71168;
    for (int it0 = c.bid; it0 < 256; it0 += c.G) {
        const int cb = (it0 >> 3) & 3, bh = (it0 & 7) * 8 + (it0 >> 5), b = bh >> 3, h = bh & 7, ci = w >> 1, vi = w & 1;
        f32x4 Sacc[2] = {{0.f, 0.f, 0.f, 0.f}, {0.f, 0.f, 0.f, 0.f}};
        for (int i = c.tid; i < 8704 / 4; i += 512) ((LAS unsigned*)Sts)[i] = 0u;
        u32x4 pf[2][7]; f32x4 put[2]; float pgl[2];
        typedef std::integral_constant<int, 0> I0; typedef std::integral_constant<int, 1> I1;
        auto fetch = [&](int n, auto SL) { constexpr int sl = decltype(SL)::value; const int pit = bh * 32 + n, r0 = b * SEQL + n * 64;
            put[sl] = *(const f32x4*)(UT + ((size_t)pit * 128 + cb * 32 + vi * 16 + lr) * 64 + ci * 16 + quad * 4); pgl[sl] = GL[pit];
#pragma unroll
            for (int i = 0; i < 2; ++i) { const int cidx = c.tid + i * 512, row = cidx >> 4, cc = cidx & 15; const size_t go = (size_t)(r0 + row) * D + h * 128 + cc * 8; pf[sl][i] = *(const u32x4*)(NW + go); pf[sl][2 + i] = *(const u32x4*)(QD + go); }
#pragma unroll
            for (int i = 0; i < 2; ++i) { const int cidx = c.tid + i * 512; pf[sl][4 + i] = *(const u32x4*)(KDT + (size_t)pit * 8192 + cidx * 8); }
            pf[sl][6] = *(const u32x4*)(QKG + (size_t)pit * 4096 + c.tid * 8); };
        auto stash = [&](auto SL) { constexpr int sl = decltype(SL)::value;
#pragma unroll
            for (int i = 0; i < 2; ++i) { const int cidx = c.tid + i * 512, row = cidx >> 4, cc = cidx & 15; *(LAS u32x4*)(Ws + row * 272 + cc * 16) = pf[sl][i]; *(LAS u32x4*)(Qs + row * 272 + cc * 16) = pf[sl][2 + i]; }
#pragma unroll
            for (int i = 0; i < 2; ++i) { const int cidx = c.tid + i * 512, row = cidx >> 3, cc = cidx & 7; *(LAS u32x4*)(KTs + row * 144 + cc * 16) = pf[sl][4 + i]; }
            { const int row = c.tid >> 3, cc = c.tid & 7; *(LAS u32x4*)(QKs + row * 144 + cc * 16) = pf[sl][6]; } };
        fetch(0, I0{}); stash(I0{}); fetch(1, I1{});
        __syncthreads();
        const int sv = c.tid & 127, spart = c.tid >> 7; LAS float* sqf = (LAS float*)(c.lds + 80000); LAS float* skf = sqf + 128; LAS float* sred = sqf + 256;
        float s0[32]; bf16_t sqk = 0, svv = 0; float seg = 0.f, sbeta = 0.f; int sit = NS * 8;
#pragma unroll
        for (int i = 0; i < 32; ++i) s0[i] = 0.f;
        auto chunk = [&](int n, auto PAR) { constexpr int par = decltype(PAR)::value;
            const int r0 = b * SEQL + n * 64;
            f32x4 acc = put[par]; const float gl = pgl[par];
            if (n + 2 < 32) fetch(n + 2, PAR);
#pragma unroll
            for (int ks = 0; ks < 4; ++ks) acc = MFMA16(*(const LAS bf16x8*)(Ws + (ci * 16 + lr) * 272 + ks * 64 + quad * 16), *(const LAS bf16x8*)(Sts + (vi * 16 + lr) * 272 + ks * 64 + quad * 16), acc);
            { u32x2 wv; wv.x = pk2(acc[0], acc[1]); wv.y = pk2(acc[2], acc[3]); *(LAS u32x2*)(VTs + (vi * 16 + lr) * 144 + (ci * 16 + quad * 4) * 2) = wv; }
            LDS_BAR();
            { const int st3 = n & 7;
                if (st3 == 0) { sit = (it0 == c.bid) ? c.bid + (n >> 3) * c.G : NS * 8;
                    if (sit < NS * 8) { const int s2 = sit >> 3, h2 = sit & 7, row2 = NP + s2;
                        const float* sp = S0 + ((size_t)(s2 * 8 + h2) * 128 + spart * 32) * 128 + sv;
#pragma unroll
                        for (int i = 0; i < 32; ++i) s0[i] = sp[(size_t)i * 128];
                        if (c.tid < 128) sqk = QKVS[(size_t)s2 * D + h2 * 128 + c.tid]; else if (c.tid < 256) sqk = QKVS[(size_t)(NS + s2) * D + h2 * 128 + c.tid - 128];
                        svv = QKVS[(size_t)(2 * NS + s2) * D + h2 * 128 + sv]; seg = __expf(GB[(size_t)row2 * 16 + h2]); sbeta = GB[(size_t)row2 * 16 + 8 + h2]; } }
                else if (st3 == 1 && sit < NS * 8) { float ksum = 0.f, qsum = 0.f, qk = 0.f;
#pragma unroll
                    for (int i = 0; i < 32; ++i) { const float kk = skf[spart * 32 + i], qq = sqf[spart * 32 + i]; ksum += kk * s0[i]; qsum += qq * s0[i]; qk += qq * kk; }
                    sred[spart * 128 + sv] = ksum; sred[512 + spart * 128 + sv] = qsum; sred[1024 + spart * 128 + sv] = qk; }
                else if (st3 == 2 && sit < NS * 8) { const int s2 = sit >> 3, h2 = sit & 7, row2 = NP + s2;
                    const float ksum = sred[sv] + sred[128 + sv] + sred[256 + sv] + sred[384 + sv], qsum = sred[512 + sv] + sred[640 + sv] + sred[768 + sv] + sred[896 + sv], qk = sred[1024 + sv] + sred[1152 + sv] + sred[1280 + sv] + sred[1408 + sv];
                    const float vn = sbeta * (bf2f(svv) - seg * ksum);
                    if (spart == 0) O[(size_t)row2 * D + h2 * 128 + sv] = seg * qsum + qk * vn;
                    float* so = sS + ((size_t)(s2 * 8 + h2) * 128 + spart * 32) * 128 + sv;
#pragma unroll
                    for (int i = 0; i < 32; ++i) so[(size_t)i * 128] = seg * s0[i] + skf[spart * 32 + i] * vn; } }
            f32x4 ao = {0.f, 0.f, 0.f, 0.f};
#pragma unroll
            for (int ks = 0; ks < 4; ++ks) ao = MFMA16(*(const LAS bf16x8*)(Qs + (ci * 16 + lr) * 272 + ks * 64 + quad * 16), *(const LAS bf16x8*)(Sts + (vi * 16 + lr) * 272 + ks * 64 + quad * 16), ao);
#pragma unroll
            for (int ks = 0; ks < 2; ++ks) ao = MFMA16(*(const LAS bf16x8*)(QKs + (ci * 16 + lr) * 144 + ks * 64 + quad * 16), *(const LAS bf16x8*)(VTs + (vi * 16 + lr) * 144 + ks * 64 + quad * 16), ao);
#pragma unroll
            for (int jj = 0; jj < 4; ++jj) O[(size_t)(r0 + ci * 16 + quad * 4 + jj) * D + h * 128 + cb * 32 + vi * 16 + lr] = ao[jj];
#pragma unroll
            for (int v2 = 0; v2 < 2; ++v2) { Sacc[v2] = Sacc[v2] * gl;
#pragma unroll
                for (int ks = 0; ks < 2; ++ks) Sacc[v2] = MFMA16(*(const LAS bf16x8*)(KTs + (w * 16 + lr) * 144 + ks * 64 + quad * 16), *(const LAS bf16x8*)(VTs + (v2 * 16 + lr) * 144 + ks * 64 + quad * 16), Sacc[v2]); }
            LDS_BAR();
            if ((n & 7) == 0 && sit < NS * 8 && c.tid < 256) sqf[c.tid] = bf2f(sqk);
#pragma unroll
            for (int v2 = 0; v2 < 2; ++v2) { u32x2 wv; wv.x = pk2(Sacc[v2][0], Sacc[v2][1]); wv.y = pk2(Sacc[v2][2], Sacc[v2][3]); *(LAS u32x2*)(Sts + (v2 * 16 + lr) * 272 + (w * 16 + quad * 4) * 2) = wv; }
            if (n + 1 < 32) stash(std::integral_constant<int, par ^ 1>{});
            LDS_BAR();
        };
#pragma unroll 1
        for (int n = 0; n < 32; n += 2) { chunk(n, I0{}); chunk(n + 1, I1{}); }
#pragma unroll
        for (int v2 = 0; v2 < 2; ++v2)
#pragma unroll
            for (int jj = 0; jj < 4; ++jj) pS[((size_t)bh * 128 + w * 16 + quad * 4 + jj) * 128 + cb * 32 + v2 * 16 + lr] = Sacc[v2][jj];
        __syncthreads();
    }
    LAS float* qf = (LAS float*)c.lds; LAS float* kf = qf + 128; LAS float* red = qf + 256;
    for (int it = (c.bid < 256 ? c.bid + 4 * c.G : c.bid); it < NS * 8; it += c.G) {
        const int s = it >> 3, h = it & 7, row = NP + s, v = c.tid & 127, part = c.tid >> 7;
        __syncthreads();
        if (c.tid < 128) qf[c.tid] = bf2f(QKVS[(size_t)s * D + h * 128 + c.tid]); else if (c.tid < 256) kf[c.tid - 128] = bf2f(QKVS[(size_t)(NS + s) * D + h * 128 + c.tid - 128]);
        __syncthreads();
        const float eg = __expf(GB[(size_t)row * 16 + h]), beta = GB[(size_t)row * 16 + 8 + h];
        const float* sp = S0 + ((size_t)(s * 8 + h) * 128 + part * 32) * 128 + v;
        float s0[32], ksum = 0.f, qsum = 0.f, qk = 0.f;
#pragma unroll
        for (int i = 0; i < 32; ++i) { s0[i] = sp[(size_t)i * 128]; const float kk = kf[part * 32 + i], qq = qf[part * 32 + i]; ksum += kk * s0[i]; qsum += qq * s0[i]; qk += qq * kk; }
        red[part * 128 + v] = ksum; red[512 + part * 128 + v] = qsum; red[1024 + part * 128 + v] = qk;
        __syncthreads();
        ksum = red[v] + red[128 + v] + red[256 + v] + red[384 + v]; qsum = red[512 + v] + red[640 + v] + red[768 + v] + red[896 + v]; qk = red[1024 + v] + red[1152 + v] + red[1280 + v] + red[1408 + v];
        const float vv = bf2f(QKVS[(size_t)(2 * NS + s) * D + h * 128 + v]); const float vn = beta * (vv - eg * ksum);
        if (part == 0) O[(size_t)row * D + h * 128 + v] = eg * qsum + qk * vn;
        float* so = sS + ((size_t)(s * 8 + h) * 128 + part * 32) * 128 + v;
#pragma unroll
        for (int i = 0; i < 32; ++i) so[(size_t)i * 128] = eg * s0[i] + kf[part * 32 + i] * vn;
    }
}
DI void gdn_post_phase(const Ctx& c, const float* O, const bf16_t* GATE, const float* ng, bf16_t* OG) {
    for (int row = c.bid * 8 + c.wave; row < NR; row += c.G * 8) {
#pragma unroll
        for (int pass = 0; pass < 2; ++pass) { const int col = pass * 512 + c.lane * 8, dv = (c.lane & 15) * 8;
            const f32x4 a = *(const f32x4*)(O + (size_t)row * D + col), b2 = *(const f32x4*)(O + (size_t)row * D + col + 4); float f[8] = {a.x, a.y, a.z, a.w, b2.x, b2.y, b2.z, b2.w}, g[8];
            float ss = 0.f;
#pragma unroll
            for (int e = 0; e < 8; ++e) ss += f[e] * f[e];
            ss += __shfl_xor(ss, 1); ss += __shfl_xor(ss, 2); ss += __shfl_xor(ss, 4); ss += __shfl_xor(ss, 8);
            const float rstd = rsqrtf(ss * (1.0f / 128.0f) + EPS);
            unpack8(*(const u32x4*)(GATE + (size_t)row * D + col), g);
#pragma unroll
            for (int e = 0; e < 8; ++e) f[e] = f[e] * rstd * ng[dv + e] * siluf_(g[e]);
            *(u32x4*)(OG + (size_t)row * D + col) = pack8(f); }
    }
}
DI void ssd_conv_phase(const Ctx& c, const bf16_t* P, const float* cw, const float* cb, const float* st  , const float* DTR, const float* dt_bias,
                       bf16_t* BM, bf16_t* CM, bf16_t* XSN, float* DT, bf16_t* XST, bf16_t* BMT, float* pout, float* sout) {
    for (int wt = c.bid * 8 + c.wave; wt < (NP / 8) * 6; wt += c.G * 8) {
        const int seg = wt % 6, rb = wt / 6, r0 = rb * 8, ch = seg * 512 + c.lane * 8, bn = rb >> 3, s8 = rb & 7; float o[8][8]; u32x4 raw[11];
        conv8_slide(P + ch, 3072, r0, cw, cb, 3072, ch, o, raw);
#pragma unroll
        for (int t = 0; t < 8; ++t)
#pragma unroll
            for (int e = 0; e < 8; ++e) o[t][e] = siluf_(o[t][e]);
        if (seg >= 4) { bf16_t* dst = (seg == 4 ? BM : CM) + c.lane * 8;
#pragma unroll
            for (int t = 0; t < 8; ++t) *(u32x4*)(dst + (size_t)(r0 + t) * 512) = pack8(o[t]); }
        if (seg <= 4) { bf16_t* dst = seg < 4 ? XST + ((size_t)bn * 2048 + ch) * 64 + s8 * 8 : BMT + ((size_t)bn * 512 + c.lane * 8) * 64 + s8 * 8;
#pragma unroll
            for (int e = 0; e < 8; ++e) { const float col[8] = {o[0][e], o[1][e], o[2][e], o[3][e], o[4][e], o[5][e], o[6][e], o[7][e]}; *(u32x4*)(dst + (size_t)e * 64) = pack8(col); } }
    }
    for (int row = NP + c.bid * 8 + c.wave; row < NR; row += c.G * 8) {
        const float* sp = st + (size_t)(row - NP) * 3 * 3072;
#pragma unroll 1
        for (int pass = 0; pass < 6; ++pass) {
            const int ch = pass * 512 + c.lane * 8; float f[8], cur[8];
            conv8(P + ch, 3072, row, -1, sp, 3072, cw, cb, ch, f, cur);
            conv_state8(row, -1, cur, sp, 3072, ch, pout, sout);
#pragma unroll
            for (int e = 0; e < 8; ++e) f[e] = siluf_(f[e]);
            if (pass < 4) *(u32x4*)(XSN + (size_t)(row - NP) * 2048 + ch) = pack8(f);
            else if (pass == 4) *(u32x4*)(BM + (size_t)row * 512 + c.lane * 8) = pack8(f);
            else *(u32x4*)(CM + (size_t)row * 512 + c.lane * 8) = pack8(f);
        }
    }
    for (int i = c.bid * 512 + c.tid; i < NR * 32; i += c.G * 512) DT[i] = softplusf_(DTR[i] + dt_bias[i & 31]);
    prompt_conv_state(c, P, 3072, 3072, pout);
}
DI void ssd_seq_phase(const Ctx& c, const bf16_t* XST, const bf16_t* BM, const bf16_t* CM, const bf16_t* BMT, const float* DT, const float* A_log, const float* Dsk, bf16_t* Y, float* pH,
                      const bf16_t* XSN, const float* H0, float* sH) {
    const int lr = c.lane & 15, quad = c.lane >> 4, w = c.wave;
    ldsp Cs = c.lds, Bs = c.lds + 17408, BTs = c.lds + 34816, XTs = c.lds + 53248, XDs = c.lds + 62464, XRs = c.lds + 71680, Ms = c.lds + 80896, Hs = c.lds + 90112;
    LAS float* DTs = (LAS float*)(c.lds + 107520); LAS float* ACs = DTs + 64;
    for (int it0 = c.bid; it0 < 256; it0 += c.G) {
        const int pr = (it0 & 7) * 4 + (it0 >> 6), b = pr >> 2, g = pr & 3, hd = g * 8 + ((it0 >> 3) & 7), item = b * 32 + hd; const float A = -__expf(A_log[hd]), Dk = Dsk[hd];
        f32x4 hacc[4];
#pragma unroll
        for (int i = 0; i < 4; ++i) hacc[i] = (f32x4){0.f, 0.f, 0.f, 0.f};
        __syncthreads();
        for (int i = c.tid; i < 17408 / 4; i += 512) ((LAS unsigned*)Hs)[i] = 0u;
        u32x4 pC[2], pB[2], pT[2], pX; float pdt = 0.f;
        auto fetch = [&](int n) { const int bn = b * 32 + n, r0 = b * SEQL + n * 64;
            if (c.tid < 64) pdt = DT[(size_t)(r0 + c.tid) * 32 + hd];
#pragma unroll
            for (int i = 0; i < 2; ++i) { const int ci = c.tid + i * 512, row = ci >> 4, cc = ci & 15; const size_t go = (size_t)(r0 + row) * 512 + g * 128 + cc * 8; pC[i] = *(const u32x4*)(CM + go); pB[i] = *(const u32x4*)(BM + go); }
#pragma unroll
            for (int i = 0; i < 2; ++i) { const int ci = c.tid + i * 512, row = ci >> 3, cc = ci & 7; pT[i] = *(const u32x4*)(BMT + ((size_t)bn * 512 + g * 128 + row) * 64 + cc * 8); }
            pX = *(const u32x4*)(XST + ((size_t)bn * 2048 + hd * 64 + (c.tid >> 3)) * 64 + (c.tid & 7) * 8); };
        fetch(0);
        const int sp_ = c.tid >> 3, snp = c.tid & 7; LAS float* SBf = (LAS float*)(c.lds + 108032);
        f32x4 shc[4]; bf16_t sbc = 0; float sdt = 0.f, sxv = 0.f; int sit = NS * 32;
#pragma unroll
        for (int i = 0; i < 4; ++i) shc[i] = (f32x4){0.f, 0.f, 0.f, 0.f};
#pragma unroll 1
        for (int n = 0; n < 32; ++n) {
            const int r0 = b * SEQL + n * 64;
            if (c.tid < 64) { const float dt = pdt; float ac = dt * A;
#pragma unroll
                for (int o = 1; o < 64; o <<= 1) { const float v = __shfl_up(ac, o); if (c.lane >= o) ac += v; }
                DTs[c.tid] = dt; ACs[c.tid] = ac; }
#pragma unroll
            for (int i = 0; i < 2; ++i) { const int ci = c.tid + i * 512, row = ci >> 4, cc = ci & 15; *(LAS u32x4*)(Cs + row * 272 + cc * 16) = pC[i]; *(LAS u32x4*)(Bs + row * 272 + cc * 16) = pB[i]; }
#pragma unroll
            for (int i = 0; i < 2; ++i) { const int ci = c.tid + i * 512, row = ci >> 3, cc = ci & 7; *(LAS u32x4*)(BTs + row * 144 + cc * 16) = pT[i]; }
            const int xrow = c.tid >> 3, xcc = c.tid & 7; const u32x4 xraw = pX;
            LDS_BAR();
            if ((n & 1) == 0) {
                sit = (it0 == c.bid) ? c.bid + (n >> 1) * c.G : NS * 32;
                if (sit < NS * 32) { const int s2 = sit >> 5, hd2 = sit & 31, g2 = hd2 >> 3, row2 = NP + s2;
                    if (c.tid < 128) sbc = BM[(size_t)row2 * 512 + g2 * 128 + c.tid]; else if (c.tid < 256) sbc = CM[(size_t)row2 * 512 + g2 * 128 + c.tid - 128];
                    const float* hp = H0 + ((size_t)sit * 64 + sp_) * 128 + snp * 16;
#pragma unroll
                    for (int i = 0; i < 4; ++i) shc[i] = *(const f32x4*)(hp + 4 * i);
                    sdt = DT[(size_t)row2 * 32 + hd2]; sxv = bf2f(XSN[(size_t)s2 * 2048 + hd2 * 64 + sp_]); }
            } else if (sit < NS * 32) { const int s2 = sit >> 5, hd2 = sit & 31, row2 = NP + s2;
                const float ea = __expf(-sdt * __expf(A_log[hd2])), Dk2 = Dsk[hd2], xdt = sxv * sdt;
                float* ho = sH + ((size_t)sit * 64 + sp_) * 128 + snp * 16; float yo = 0.f, cbp = 0.f;
#pragma unroll
                for (int i = 0; i < 4; ++i) { f32x4 o4;
#pragma unroll
                    for (int e = 0; e < 4; ++e) { const int nn = snp * 16 + 4 * i + e; const float bv = SBf[nn], cv = SBf[128 + nn]; yo += cv * shc[i][e]; cbp += cv * bv; o4[e] = ea * shc[i][e] + xdt * bv; }
                    *(f32x4*)(ho + 4 * i) = o4; }
                yo += __shfl_xor(yo, 1); yo += __shfl_xor(yo, 2); yo += __shfl_xor(yo, 4); cbp += __shfl_xor(cbp, 1); cbp += __shfl_xor(cbp, 2); cbp += __shfl_xor(cbp, 4);
                if (snp == 0) Y[(size_t)row2 * 2048 + hd2 * 64 + sp_] = (bf16_t)f2bf(cbp * xdt + ea * yo + Dk2 * sxv);
            }
            if (n + 1 < 32) fetch(n + 1);
            { float f[8], fd[8]; unpack8(xraw, f); const float al = ACs[63];
#pragma unroll
                for (int e = 0; e < 8; ++e) { const int s = xcc * 8 + e; f[e] *= DTs[s]; fd[e] = f[e] * __expf(al - ACs[s]); }
                *(LAS u32x4*)(XRs + xrow * 144 + xcc * 16) = xraw; *(LAS u32x4*)(XTs + xrow * 144 + xcc * 16) = pack8(f); *(LAS u32x4*)(XDs + xrow * 144 + xcc * 16) = pack8(fd); }
            LDS_BAR();
            const int li = w >> 1; float acl[4];
#pragma unroll
            for (int jj = 0; jj < 4; ++jj) acl[jj] = ACs[li * 16 + quad * 4 + jj];
            f32x4 aoff[2];
#pragma unroll
            for (int q2 = 0; q2 < 2; ++q2) { const int sj = 2 * (w & 1) + q2;
                if (sj <= li) { f32x4 a = {0.f, 0.f, 0.f, 0.f};
#pragma unroll
                    for (int ks = 0; ks < 4; ++ks) a = MFMA16(*(const LAS bf16x8*)(Cs + (li * 16 + lr) * 272 + ks * 64 + quad * 16), *(const LAS bf16x8*)(Bs + (sj * 16 + lr) * 272 + ks * 64 + quad * 16), a);
                    const int s = sj * 16 + lr; const float as = ACs[s];
#pragma unroll
                    for (int jj = 0; jj < 4; ++jj) { const int l = li * 16 + quad * 4 + jj; *(LAS bf16_t*)(Ms + l * 144 + s * 2) = (bf16_t)f2bf(l >= s ? a[jj] * __expf(acl[jj] - as) : 0.f); }
                } else {
#pragma unroll
                    for (int jj = 0; jj < 4; ++jj) *(LAS bf16_t*)(Ms + (li * 16 + quad * 4 + jj) * 144 + (sj * 16 + lr) * 2) = 0;
                }
                const int pj = 2 * (w & 1) + q2; f32x4 a2 = {0.f, 0.f, 0.f, 0.f};
#pragma unroll
                for (int ks = 0; ks < 4; ++ks) a2 = MFMA16(*(const LAS bf16x8*)(Cs + (li * 16 + lr) * 272 + ks * 64 + quad * 16), *(const LAS bf16x8*)(Hs + (pj * 16 + lr) * 272 + ks * 64 + quad * 16), a2);
                aoff[q2] = a2; }
            LDS_BAR();
#pragma unroll
            for (int q2 = 0; q2 < 2; ++q2) { const int pj = 2 * (w & 1) + q2; f32x4 a = {0.f, 0.f, 0.f, 0.f};
#pragma unroll
                for (int ks = 0; ks < 2; ++ks) a = MFMA16(*(const LAS bf16x8*)(Ms + (li * 16 + lr) * 144 + ks * 64 + quad * 16), *(const LAS bf16x8*)(XTs + (pj * 16 + lr) * 144 + ks * 64 + quad * 16), a);
                const u32x2 xr = *(const LAS u32x2*)(XRs + (pj * 16 + lr) * 144 + (li * 16 + quad * 4) * 2); const float xv[4] = {lo16(xr.x), hi16(xr.x), lo16(xr.y), hi16(xr.y)};
#pragma unroll
                for (int jj = 0; jj < 4; ++jj) { const float yv = a[jj] + __expf(acl[jj]) * aoff[q2][jj] + Dk * xv[jj];
                    Y[(size_t)(r0 + li * 16 + quad * 4 + jj) * 2048 + hd * 64 + pj * 16 + lr] = (bf16_t)f2bf(yv); } }
            { const float cd = __expf(ACs[63]);
#pragma unroll
                for (int pj = 0; pj < 4; ++pj) { hacc[pj] = hacc[pj] * cd;
#pragma unroll
                    for (int ks = 0; ks < 2; ++ks) hacc[pj] = MFMA16(*(const LAS bf16x8*)(BTs + (w * 16 + lr) * 144 + ks * 64 + quad * 16), *(const LAS bf16x8*)(XDs + (pj * 16 + lr) * 144 + ks * 64 + quad * 16), hacc[pj]); } }
            LDS_BAR();
#pragma unroll
            for (int pj = 0; pj < 4; ++pj) { u32x2 wv; wv.x = pk2(hacc[pj][0], hacc[pj][1]); wv.y = pk2(hacc[pj][2], hacc[pj][3]); *(LAS u32x2*)(Hs + (pj * 16 + lr) * 272 + (w * 16 + quad * 4) * 2) = wv; }
            if ((n & 1) == 0 && sit < NS * 32 && c.tid < 256) SBf[c.tid] = bf2f(sbc);
        }
#pragma unroll
        for (int pj = 0; pj < 4; ++pj) *(f32x4*)(pH + ((size_t)item * 64 + pj * 16 + lr) * 128 + w * 16 + quad * 4) = hacc[pj];
    }
    LAS float* Bf = (LAS float*)c.lds; LAS float* Cf = Bf + 128;
    {
        const int p = c.tid >> 3, np = c.tid & 7;
        f32x4 hn[4];
        const int it0 = c.bid < 256 ? c.bid + 16 * c.G : c.bid;
        if (it0 < NS * 32) { const float* hp = H0 + ((size_t)it0 * 64 + p) * 128 + np * 16;
#pragma unroll
            for (int i = 0; i < 4; ++i) hn[i] = *(const f32x4*)(hp + 4 * i); }
#pragma unroll 1
        for (int it = it0; it < NS * 32; it += c.G) {
            const int s = it >> 5, hd = it & 31, g = hd >> 3, row = NP + s;
            f32x4 hc[4];
#pragma unroll
            for (int i = 0; i < 4; ++i) hc[i] = hn[i];
            if (it + c.G < NS * 32) { const float* hp = H0 + ((size_t)(it + c.G) * 64 + p) * 128 + np * 16;
#pragma unroll
                for (int i = 0; i < 4; ++i) hn[i] = *(const f32x4*)(hp + 4 * i); }
            __syncthreads();
            if (c.tid < 128) Bf[c.tid] = bf2f(BM[(size_t)row * 512 + g * 128 + c.tid]); else if (c.tid < 256) Cf[c.tid - 128] = bf2f(CM[(size_t)row * 512 + g * 128 + c.tid - 128]);
            const float dt = DT[(size_t)row * 32 + hd], ea = __expf(-dt * __expf(A_log[hd])), Dk = Dsk[hd];
            const float xv = bf2f(XSN[(size_t)s * 2048 + hd * 64 + p]), xdt = xv * dt;
            __syncthreads();
            float* ho = sH + ((size_t)it * 64 + p) * 128 + np * 16;
            float yo = 0.f, cbp = 0.f;
#pragma unroll
            for (int i = 0; i < 4; ++i) { f32x4 o4;
#pragma unroll
                for (int e = 0; e < 4; ++e) { const int nn = np * 16 + 4 * i + e; const float bv = Bf[nn], cv = Cf[nn]; yo += cv * hc[i][e]; cbp += cv * bv; o4[e] = ea * hc[i][e] + xdt * bv; }
                *(f32x4*)(ho + 4 * i) = o4; }
            yo += __shfl_xor(yo, 1); yo += __shfl_xor(yo, 2); yo += __shfl_xor(yo, 4); cbp += __shfl_xor(cbp, 1); cbp += __shfl_xor(cbp, 2); cbp += __shfl_xor(cbp, 4);
            if (np == 0) Y[(size_t)row * 2048 + hd * 64 + p] = (bf16_t)f2bf(cbp * xdt + ea * yo + Dk * xv);
        }
    }
}
DI void ssd_post_phase(const Ctx& c, const bf16_t* Y, const bf16_t* ZB, const float* ng, bf16_t* YN) {
    for (int row = c.bid * 8 + c.wave; row < NR; row += c.G * 8) {
#pragma unroll
        for (int gi = 0; gi < 4; ++gi) { const int col = gi * 512 + c.lane * 8; float y[8], z[8];
            unpack8(*(const u32x4*)(Y + (size_t)row * 2048 + col), y); unpack8(*(const u32x4*)(ZB + (size_t)row * 2048 + col), z);
            float ss = 0.f;
#pragma unroll
            for (int e = 0; e < 8; ++e) { y[e] *= siluf_(z[e]); ss += y[e] * y[e]; }
            const float rstd = rsqrtf(wave_sum(ss) * (1.0f / 512.0f) + EPS);
#pragma unroll
            for (int e = 0; e < 8; ++e) y[e] = y[e] * rstd * ng[col + e];
            *(u32x4*)(YN + (size_t)row * 2048 + col) = pack8(y); }
    }
}
template <class Epi> DI void run_gemm(const Ctx& c, const bf16_t* A, int lda, const bf16_t* Bt, int ldb, int M, int N, int K, int ksh, int kmul, const Epi& E, int kmulb = 0, int bmask = 0x7fffffff) {
    asm volatile("" : "+s"(K));
    pg8::Gemm g{A, Bt, M, N, K, lda, ldb, ksh, kmul, kmulb, bmask}; pg8::StaticOrder S; S.init(M, N, c.G, c.bid);
    pg8::gemm_phase<Epi, pg8::StaticOrder>(c.lds, g, S, E, c.tid);
}
DI void res_gemm(const Ctx& c, const bf16_t* A, const bf16_t* Bt, int K, const float* bp, float* X, const float* gate, const float* nsc, const float* nsh, bf16_t* UB, float* xs, unsigned* cnt) {
    if (nsc != nullptr) { EpiResNorm E{bp, X, gate, nsc, nsh, UB, xs, cnt}; run_gemm(c, A, K, Bt, K, NP, 1024, K, 0, 0, E); }
    else { EpiRes E{bp, X + (size_t)NP * D, X, gate}; run_gemm(c, A, K, Bt, K, NP, 1024, K, 0, 0, E); }
    { EpiResAtomic E{X, gate}; run_gemm(c, A + (size_t)NP * K, K, Bt, K, 256, 4 * K, 256, 2, 256, E, 256, 3); }
}
#define B_X ((float*)(ws + WS_X))
#define B_UB ((bf16_t*)(ws + WS_UB))
#define B_P ((bf16_t*)(ws + WS_P))
#define B_S (ws + WS_S)
#define B_MOD ((float*)(ws + WS_MOD))
#define B_MODL (B_MOD + (size_t)L * NSEQ * MODW)
#define B_XP (L == 0 ? GIN(0) : (const float*)B_X)
#define B_XS (L == 0 ? GIN(1) : (const float*)(B_X + (size_t)NP * D))
#define B_XB ((bf16_t*)B_S)
#define B_LA ((float*)(B_S + (size_t)RP * 1024 * 2))
#define B_BX ((float*)(B_S + (size_t)RP * 1024 * 6))
#define B_Q ((bf16_t*)B_S)
#define B_K (B_Q + (size_t)RP * D)
#define B_V (B_Q + (size_t)2 * RP * D)
#define B_GATE (B_Q + (size_t)3 * RP * D)
#define B_QKG (B_Q + (size_t)4 * RP * D)
#define B_AB ((float*)(ws + WS_AB))
#define B_GB ((float*)(ws + WS_GB))
#define B_GL ((float*)(ws + WS_GL))
#define B_QKVS ((bf16_t*)(ws + WS_QKVS))
#define B_UT ((float*)B_P)
#define B_NW ((bf16_t*)(ws + WS_P + (size_t)NP * D * 4))
#define B_QD (B_NW + (size_t)NP * D)
#define B_KDT (B_NW + (size_t)2 * NP * D)
#define B_OF ((float*)B_S)
#define B_XST ((bf16_t*)B_S)
#define B_BM (B_XST + (size_t)NP * 2048)
#define B_CM (B_BM + (size_t)RP * 512)
#define B_BMT (B_CM + (size_t)RP * 512)
#define B_ZB (B_P + (size_t)RP * 3072)
#define B_YN ((bf16_t*)B_S)
#define B_DTR ((float*)(ws + WS_DTR))
#define B_DT ((float*)(ws + WS_DT))
#define B_XSN ((bf16_t*)(ws + WS_XSN))
__global__ void __launch_bounds__(512, 2) mega(Args a) {
    extern __shared__ __attribute__((aligned(16))) unsigned char lds_raw[];
    cg::grid_group grid = cg::this_grid();
    Ctx c0; c0.lds = (ldsp)lds_raw; c0.tid = threadIdx.x; c0.lane = c0.tid & 63; c0.wave = __builtin_amdgcn_readfirstlane(c0.tid >> 6); c0.bid = blockIdx.x; c0.G = gridDim.x;
    int ph = 0; const int lo = a.lo, hi = a.hi;
    volatile LAS unsigned* bst = (volatile LAS unsigned*)(c0.lds + 131072);
    if (c0.tid < 2) bst[c0.tid] = 0u;
    __syncthreads();
    XcdBarrier xbar; xbar.bar = (unsigned*)(a.ws + WS_BAR); xbar.x = 0; xbar.st = bst;
#ifndef REPMASK
#define REPMASK 0ull
#endif
#ifndef SYNCREP
#define SYNCREP 1
#endif
#define PH_BEGIN if (ph >= lo && ph < hi) { const int nrep_ = ((REPMASK >> ph) & 1ull) ? 2 : 1; for (int rep_ = 0; rep_ < nrep_; ++rep_) { if (rep_) xcd_barrier(xbar); const __attribute__((address_space(4))) Args* ap_ = (const __attribute__((address_space(4))) Args*)__builtin_amdgcn_kernarg_segment_ptr(); asm volatile("" : "+s"(ap_)); const __attribute__((address_space(4))) Args& a = *ap_; Ctx c = c0; GAS unsigned char* wsg_ = (GAS unsigned char*)a.ws; GAS float* outg_ = (GAS float*)a.out; asm volatile("" : "+s"(wsg_)); asm volatile("" : "+s"(outg_)); unsigned char* ws = (unsigned char*)wsg_; float* out = (float*)outg_; { int t_ = c0.tid; asm volatile("" : "+v"(t_)); asm volatile("" : "+s"(c.G)); asm volatile("" : "+s"(c.bid)); c.tid = t_; c.lane = t_ & 63; c.wave = __builtin_amdgcn_readfirstlane(t_ >> 6); } (void)out;
#define PH_END } if (ph + 1 < hi) { for (int s_ = 0; s_ < SYNCREP; ++s_) { if (ph == 0) { if (s_ == 0) { grid.sync(); xbar = xcd_barrier_post((unsigned*)(a.ws + WS_BAR), bst); } } else xcd_barrier(xbar); } } } ++ph;

    PH_BEGIN prep_phase(c, a, true);
#ifdef PREP2
    __syncthreads(); prep_phase(c, a, false);
#endif
    PH_END
    PH_BEGIN { EpiMod E{B_MOD, GIN(11)}; run_gemm(c, (const bf16_t*)(ws + WS_SC), 1024, B_P, 1024, 256, 4 * MODW, 1024, 0, 0, E); } PH_END
#pragma unroll 1
    for (int L = 0; L < 4; ++L) {
        const int kind = L % 3, j = L / 3;
        PH_BEGIN norm_mod_phase(c, B_XP, B_XS, B_MODL + 1024, B_MODL, B_UB, (L > 0 && c.G == 256) ? NP : 0); PH_END
        PH_BEGIN {
            EpiSplit E; const bf16_t* Bt; int N;
            if (kind == 0) { E = EpiSplit{1, B_P, 2048, 1024, B_P + 1024, 2048, 2048, nullptr, 0, 0}; Bt = (const bf16_t*)(ws + WS_RGIN) + (size_t)j * 2048 * 1024; N = 2048; }
            else if (kind == 1) { E = EpiSplit{0, B_P, 3072, 3072, B_GATE, 1024, 4096, B_AB, 16, 16}; Bt = (const bf16_t*)(ws + WS_GDNIN); N = GDN_NP; }
            else { E = EpiSplit{0, B_ZB, 2048, 2048, B_P, 3072, 5120, B_DTR, 32, 32}; Bt = (const bf16_t*)(ws + WS_SSDIN); N = SSD_NP; }
            run_gemm(c, B_UB, 1024, Bt, 1024, RP, N, 1024, 0, 0, E); } PH_END
        if (kind == 0) {
            PH_BEGIN rg_conv_phase(c, B_P, GIN(16) + j * 4 * D, GIN(17) + j * D, GIN(2) + (size_t)j * NS * 3 * D, B_XB, out + O_PRGC + j * 8 * 3 * D, out + O_SRGC + j * NS * 3 * D); PH_END
            PH_BEGIN { EpiGate E{B_XB, GIN(19) + j * 2 * D, (const float*)(ws + WS_LS8) + j * D, B_LA, B_BX}; run_gemm(c, B_XB, 1024, (const bf16_t*)(ws + WS_RGGATE) + (size_t)j * 2048 * 256, 256, RP, 2048, 256, 1, 256, E); } PH_END
            PH_BEGIN rg_scan_phase(c, B_LA, B_BX, B_P, GIN(3) + (size_t)j * NS * D, B_UB, out + O_PRGH + j * 8 * D, out + O_SRGH + j * NS * D); PH_END
        } else if (kind == 1) {
            PH_BEGIN gdn_conv_phase(c, B_P, GIN(23), GIN(4), B_AB, GIN(24), GIN(25), B_Q, B_K, B_V, B_QKVS, B_GB, out + O_PGDC, out + O_SGDC); PH_END
            PH_BEGIN gdn_prep_phase(c, B_Q, B_K, B_V, B_GB, B_UT, B_NW, B_QD, B_KDT, B_QKG, B_GL); PH_END
            PH_BEGIN gdn_seq_phase(c, B_UT, B_NW, B_QD, B_KDT, B_QKG, B_GL, B_OF, out + O_PGDS, B_QKVS, B_GB, GIN(5), out + O_SGDS); PH_END
            PH_BEGIN gdn_post_phase(c, B_OF, B_GATE, GIN(26), B_UB); PH_END
        } else {
            PH_BEGIN ssd_conv_phase(c, B_P, GIN(29), GIN(30), GIN(6), B_DTR, GIN(32), B_BM, B_CM, B_XSN, B_DT, B_XST, B_BMT, out + O_PSSC, out + O_SSSC); PH_END
            PH_BEGIN ssd_seq_phase(c, B_XST, B_BM, B_CM, B_BMT, B_DT, GIN(31), GIN(33), B_P, out + O_PSSH, B_XSN, GIN(7), out + O_SSSH); PH_END
            PH_BEGIN ssd_post_phase(c, B_P, B_ZB, GIN(34), B_YN); PH_END
        }
        PH_BEGIN {
            const bf16_t* oA = kind == 2 ? B_YN : B_UB; const int oK = kind == 2 ? 2048 : 1024;
            const bf16_t* oB = kind == 0 ? (const bf16_t*)(ws + WS_RGOUT) + (size_t)j * 1024 * 1024 : (kind == 1 ? (const bf16_t*)(ws + WS_GDNOUT) : (const bf16_t*)(ws + WS_SSDOUT));
            const bool fuse = c.G == 256;
            res_gemm(c, oA, oB, oK, B_XP, B_X, B_MODL + 2048, fuse ? B_MODL + 4 * 1024 : nullptr, B_MODL + 3 * 1024, B_UB, (float*)(ws + WS_XS), (unsigned*)(ws + WS_CNT) + (size_t)(2 * L) * 4096); } PH_END
        PH_BEGIN norm_mod_phase(c, B_X, B_X + (size_t)NP * D, B_MODL + 4 * 1024, B_MODL + 3 * 1024, B_UB, c.G == 256 ? NP : 0); PH_END
        PH_BEGIN { EpiSplit E{2, B_P, 4096, 4096, nullptr, 0, 4096, nullptr, 0, 0}; run_gemm(c, B_UB, 1024, (const bf16_t*)(ws + WS_WUP) + (size_t)L * 4096 * 1024, 1024, RP, 4096, 1024, 0, 0, E); } PH_END
        PH_BEGIN { const bool fuse = c.G == 256 && L < 3; const float* modN = B_MOD + (size_t)(L + 1) * NSEQ * MODW;
            res_gemm(c, B_P, (const bf16_t*)(ws + WS_WDN) + (size_t)L * 4096 * 1024, 4096, B_X, B_X, B_MODL + 5 * 1024, fuse ? modN + 1024 : nullptr, modN, B_UB, (float*)(ws + WS_XS), (unsigned*)(ws + WS_CNT) + (size_t)(2 * L + 1) * 4096); } PH_END
    }
    PH_BEGIN final_norm_phase(c, B_X, GIN(14), out + O_Y); PH_END
}
constexpr int N_PHASES = 40;

extern "C" void kernel_launch(void* const* d_in, const int* in_sizes, int n_in, void* d_out, int out_size, void* d_ws, size_t ws_size, hipStream_t stream) {
    static int grid = 0;
    if (grid == 0) {
        int dev = 0, cus = 0, per_cu = 0;
        (void)hipGetDevice(&dev);
        (void)hipDeviceGetAttribute(&cus, hipDeviceAttributeMultiprocessorCount, dev);
        (void)hipFuncSetAttribute((const void*)mega, hipFuncAttributeMaxDynamicSharedMemorySize, LDS_BYTES);
        (void)hipOccupancyMaxActiveBlocksPerMultiprocessor(&per_cu, (const void*)mega, 512, LDS_BYTES);
        if (per_cu < 1) { fprintf(stderr, "kernel_launch: occupancy query reports %d blocks/CU\n", per_cu); }
        grid = cus > 0 ? cus : 256;
        if (ws_size < WS_END) { fprintf(stderr, "kernel_launch: workspace too small: need %zu, have %zu\n", (size_t)WS_END, ws_size); grid = -1; }
        if (n_in != 36) { fprintf(stderr, "kernel_launch: expected 36 inputs, got %d\n", n_in); grid = -1; }
    }
    if (grid < 0) return;
    Args a{};
    for (int i = 0; i < 36; ++i) a.in[i] = (const float*)d_in[i];
    a.out = (float*)d_out; a.ws = (unsigned char*)d_ws; a.lo = 0; a.hi = N_PHASES;
    void* args[] = {&a};
    hipError_t e = hipLaunchCooperativeKernel((const void*)mega, dim3(grid), dim3(512), args, LDS_BYTES, stream);
    if (e != hipSuccess) fprintf(stderr, "kernel_launch: cooperative launch failed: %s (grid %d)\n", hipGetErrorString(e), grid);
}
```

```cpp
#include <hip/hip_runtime.h>
#include <hip/hip_cooperative_groups.h>
#include <cstdio>
#include <type_traits>
namespace cg = cooperative_groups;

namespace pg8 {
#define PG8_LAS __attribute__((address_space(3)))
typedef unsigned short bf16_t;
typedef short bf16x8 __attribute__((ext_vector_type(8)));
typedef float f32x4 __attribute__((ext_vector_type(4)));
typedef unsigned u32x4 __attribute__((ext_vector_type(4)));
constexpr int BM = 256, BK = 64, HALF = 128, HTB = HALF * BK * 2  , STAGE_BYTES = 8 * HTB, NXCD = 8, WGM = 8;

__host__ __device__ __forceinline__ int lds_byte(int r, int c) { const int st = (r >> 4) * 2 + (c >> 5), rr = r & 15, cc = c & 31, ob = rr * 64 + cc * 2; return st * 1024 + (ob ^ (((ob >> 9) & 1) << 5)); }
__host__ __device__ __forceinline__ void stage_rc(int b, int& R, int& C) { const int st = b / 1024, sb = b % 1024, swz = sb ^ (((sb >> 9) & 1) << 5); R = (st >> 1) * 16 + swz / 64; C = (st & 1) * 32 + (swz % 64) / 2; }
__host__ __device__ __forceinline__ int perm32(int rho) { const int n = rho >> 4, i = rho & 15; return 8 * (i >> 2) + 4 * n + (i & 3); }

struct Unit { int pm, pn; };
struct Gemm { const bf16_t* A; const bf16_t* Bt; int M, N, K, lda, ldb, ksh, kmul, kmulb, bmask, full_pm; };

struct StaticOrder {
    int nM, nN, nwg, G, c;
    __host__ __device__ void init(int M, int N, int G_, int c_) { nM = M / BM; nN = N / BM; nwg = nM * nN; G = G_; c = c_; }
    __host__ __device__ bool next(int i, Unit& u) const {
        const long L = (long)i * G + c; if (L >= nwg) return false;
        int wgid = (int)L; { const int q = nwg / NXCD, r = nwg % NXCD, xcd = wgid % NXCD, off = wgid / NXCD; wgid = (xcd < r ? xcd * (q + 1) : r * (q + 1) + (xcd - r) * q) + off; }
        const int nig = WGM * nN, gid = wgid / nig, fm = gid * WGM, gsz = (nM - fm) < WGM ? (nM - fm) : WGM;
        u.pm = fm + ((wgid % nig) % gsz); u.pn = (wgid % nig) / gsz; return true;
    }
    __device__ __forceinline__ void a_ready(const Unit&) const {}
    __device__ __forceinline__ void done(const Unit&) const {}
};
__device__ __forceinline__ unsigned cvt_pk_bf16(float lo, float hi) { unsigned r; asm volatile("v_cvt_pk_bf16_f32 %0, %1, %2" : "=v"(r) : "v"(lo), "v"(hi)); return r; }
typedef float f32x2 __attribute__((ext_vector_type(2)));
template <class Epi, class Sched>
__device__ __forceinline__ void gemm_phase(PG8_LAS unsigned char* lds, const Gemm g, const Sched& S, const Epi& E, const int tid_in) {
    const int tid = tid_in, wid = __builtin_amdgcn_readfirstlane(tid >> 6), lane = tid & 63, wr = wid >> 2, wc = wid & 3, fr = lane & 15, fq = lane >> 4;
    const int K = g.K, nt = K / BK;

    unsigned voffA[2], voffB[2];
#pragma unroll
    for (int i = 0; i < 2; ++i) { int R, C; stage_rc(tid * 16 + i * 8192, R, C); const int Rb = Epi::PERM ? ((R & ~31) + perm32(R & 31)) : R;
        voffA[i] = (unsigned)(R * g.lda + C) * 2u; voffB[i] = (unsigned)(Rb * g.ldb + C) * 2u; }
    const size_t kstep = (size_t)(BK * 2);
    const size_t hstepA = (size_t)HALF * g.lda * 2, hstepB = (size_t)HALF * g.ldb * 2;
    const size_t tstepA = 2 * hstepA, tstepB = 2 * hstepB;
    const unsigned ldsw = (unsigned)wid * 1024u;
    const int aoff = lds_byte(wr * 64 + fr, fq * 8), boff = lds_byte(wc * 32 + fr, fq * 8);
#define PG8_SA(b, h) (((b) * 2 + (h)) * HTB)
#define PG8_SB(b, h) ((4 + (b) * 2 + (h)) * HTB)
#define PG8_STAGE(bufoff, gbase, voff) do { _Pragma("unroll") for (int _i = 0; _i < 2; ++_i) \
        __builtin_amdgcn_global_load_lds((const unsigned*)((const char*)(gbase) + (voff)[_i]), (PG8_LAS unsigned*)(lds + (bufoff) + ldsw + _i * 8192), 16, 0, 0); } while (0)
#define PG8_LDA(dst, b, h) do { _Pragma("unroll") for (int m = 0; m < 4; ++m) _Pragma("unroll") for (int k = 0; k < 2; ++k) dst[m][k] = *(const PG8_LAS bf16x8*)(lds + PG8_SA(b, h) + aoff + m * 2048 + k * 1024); } while (0)
#define PG8_LDB(dst, b, h) do { _Pragma("unroll") for (int n = 0; n < 2; ++n) _Pragma("unroll") for (int k = 0; k < 2; ++k) dst[n][k] = *(const PG8_LAS bf16x8*)(lds + PG8_SB(b, h) + boff + n * 2048 + k * 1024); } while (0)
#define PG8_MMA(ai, bj, At, Bt) do { if ((ai) == 1 && halfu) break; __builtin_amdgcn_s_setprio(1); _Pragma("unroll") for (int m = 0; m < 4; ++m) _Pragma("unroll") for (int n = 0; n < 2; ++n) _Pragma("unroll") for (int k = 0; k < 2; ++k) \
        acc[ai][bj][m][n] = __builtin_amdgcn_mfma_f32_16x16x32_bf16(Bt[n][k], At[m][k], acc[ai][bj][m][n], 0, 0, 0); __builtin_amdgcn_s_setprio(0); } while (0)
#define PG8_WAIT_V(n) asm volatile("s_waitcnt vmcnt(" #n ")" ::: "memory")
#define PG8_WAIT_L(n) asm volatile("s_waitcnt lgkmcnt(" #n ")" ::: "memory")
#define PG8_BAR __builtin_amdgcn_s_barrier()
#define PG8_SCHED __builtin_amdgcn_sched_barrier(0)
    Unit cur, nxt; int ui = 0;
    if (!S.next(0, cur)) return;
    f32x4 acc[2][2][4][2];
#pragma unroll
    for (int a = 0; a < 2; ++a)
#pragma unroll
        for (int b = 0; b < 2; ++b)
#pragma unroll
            for (int m = 0; m < 4; ++m)
#pragma unroll
                for (int n = 0; n < 2; ++n) acc[a][b][m][n] = (f32x4){0.f, 0.f, 0.f, 0.f};
    bf16x8 At[4][2], B0[2][2], B1[2][2];
    const char* cA = (const char*)g.A + (size_t)cur.pm * tstepA + (size_t)((cur.pn >> g.ksh) * g.kmul) * 2; const char* cB = (const char*)g.Bt + (size_t)(cur.pn & g.bmask) * tstepB + (size_t)((cur.pn >> g.ksh) * g.kmulb) * 2;
    S.a_ready(cur);
    PG8_STAGE(PG8_SB(0, 0), cB, voffB); PG8_STAGE(PG8_SA(0, 0), cA, voffA); PG8_STAGE(PG8_SB(0, 1), cB + hstepB, voffB); PG8_STAGE(PG8_SA(0, 1), cA + hstepA, voffA);
    if (wr == 1) PG8_BAR;
    PG8_WAIT_V(4); PG8_BAR;
    PG8_STAGE(PG8_SB(1, 0), cB + kstep, voffB); PG8_STAGE(PG8_SA(1, 0), cA + kstep, voffA); PG8_STAGE(PG8_SB(1, 1), cB + hstepB + kstep, voffB);
    PG8_WAIT_V(6); PG8_BAR;

    for (;;) {
        const bool halfu = cur.pm >= g.full_pm;
        const bool has_next = S.next(ui + 1, nxt);
        const char* nA = has_next ? (const char*)g.A + (size_t)nxt.pm * tstepA + (size_t)((nxt.pn >> g.ksh) * g.kmul) * 2 : cA; const char* nB = has_next ? (const char*)g.Bt + (size_t)(nxt.pn & g.bmask) * tstepB + (size_t)((nxt.pn >> g.ksh) * g.kmulb) * 2 : cB;
        for (int t = 0; t < nt; t += 2) {
            const bool last = (t == nt - 2);
            const char* a1 = cA + (size_t)(t + 1) * kstep;
            const char* a2 = last ? nA : cA + (size_t)(t + 2) * kstep; const char* b2 = last ? nB : cB + (size_t)(t + 2) * kstep;
            const char* a3 = a2 + kstep; const char* b3 = b2 + kstep;
            if (last && has_next) S.a_ready(nxt);
            PG8_LDB(B0, 0, 0); PG8_SCHED; PG8_LDA(At, 0, 0); PG8_STAGE(PG8_SA(1, 1), a1 + hstepA, voffA);
            PG8_WAIT_L(8); PG8_BAR; PG8_WAIT_L(0); PG8_MMA(0, 0, At, B0); PG8_BAR; PG8_SCHED;
            PG8_LDB(B1, 0, 1); PG8_STAGE(PG8_SB(0, 0), b2, voffB);
            PG8_BAR; PG8_WAIT_L(0); PG8_MMA(0, 1, At, B1); PG8_BAR;
            PG8_LDA(At, 0, 1); PG8_STAGE(PG8_SA(0, 0), a2, voffA);
            PG8_BAR; PG8_WAIT_L(0); PG8_MMA(1, 0, At, B0); PG8_BAR; PG8_SCHED;
            PG8_STAGE(PG8_SB(0, 1), b2 + hstepB, voffB);
            PG8_WAIT_V(6); PG8_BAR; PG8_MMA(1, 1, At, B1); PG8_BAR;
            PG8_LDB(B0, 1, 0); PG8_SCHED; PG8_LDA(At, 1, 0); PG8_STAGE(PG8_SA(0, 1), a2 + hstepA, voffA);
            PG8_WAIT_L(8); PG8_BAR; PG8_WAIT_L(0); PG8_MMA(0, 0, At, B0); PG8_BAR; PG8_SCHED;
            PG8_LDB(B1, 1, 1); PG8_STAGE(PG8_SB(1, 0), b3, voffB);
            PG8_BAR; PG8_WAIT_L(0); PG8_MMA(0, 1, At, B1); PG8_BAR;
            PG8_LDA(At, 1, 1); PG8_STAGE(PG8_SA(1, 0), a3, voffA);
            PG8_BAR; PG8_WAIT_L(0); PG8_MMA(1, 0, At, B0); PG8_BAR; PG8_SCHED;
            PG8_STAGE(PG8_SB(1, 1), b3 + hstepB, voffB);
            PG8_WAIT_V(6); PG8_BAR; PG8_MMA(1, 1, At, B1); PG8_BAR;
        }

        if constexpr (!Epi::AFTER_DRAIN) { E(acc, cur, wr, wc, fr, fq); S.done(cur); }

        if (!has_next) break;
#pragma unroll
        for (int a = 0; a < 2; ++a)
#pragma unroll
            for (int b = 0; b < 2; ++b)
#pragma unroll
                for (int m = 0; m < 4; ++m)
#pragma unroll
                    for (int n = 0; n < 2; ++n) acc[a][b][m][n] = (f32x4){0.f, 0.f, 0.f, 0.f};
        cur = nxt; cA = nA; cB = nB; ++ui;
    }
    PG8_WAIT_V(0);
    if (wr == 0) PG8_BAR;
    PG8_BAR;
    if constexpr (Epi::AFTER_DRAIN) { E.fused(acc, cur, wr, wc, fr, fq, lds, wid, lane); S.done(cur); }

#undef PG8_SA
#undef PG8_SB
#undef PG8_STAGE
#undef PG8_LDA
#undef PG8_LDB
#undef PG8_MMA
#undef PG8_WAIT_V
#undef PG8_WAIT_L
#undef PG8_BAR
#undef PG8_SCHED
}
}
using pg8::bf16_t; using pg8::bf16x8; using pg8::f32x4; using pg8::u32x4; using pg8::f32x2;
typedef unsigned u32x2 __attribute__((ext_vector_type(2)));
#define LAS __attribute__((address_space(3)))
#define GAS __attribute__((address_space(1)))
#define GIN(k) ((const float*)(const GAS float*)a.in[k])
typedef LAS unsigned char* ldsp;
#define DI __device__ __forceinline__
#define LDS_BAR() do { asm volatile("s_waitcnt lgkmcnt(0)" ::: "memory"); __builtin_amdgcn_s_barrier(); asm volatile("" ::: "memory"); } while (0)
#define MFMA16(a, b, c) __builtin_amdgcn_mfma_f32_16x16x32_bf16((a), (b), (c), 0, 0, 0)

constexpr int D = 1024, NP = 16384, NS = 128, NR = NP + NS, RP = 16640, SEQL = 2048, NSEQ = 136, MODW = 6144;
constexpr int GDN_N = 4112, GDN_NP = 4352, SSD_N = 5152, SSD_NP = 5376;
constexpr float EPS = 1e-6f;
constexpr int LDS_BYTES = 132096;
constexpr size_t al256(size_t x) { return (x + 255) & ~(size_t)255; }
constexpr size_t WS_WUP = 0;
constexpr size_t WS_WDN = WS_WUP + (size_t)4 * 4096 * 1024 * 2;
constexpr size_t WS_RGIN = WS_WDN + (size_t)4 * 4096 * 1024 * 2;
constexpr size_t WS_RGGATE = WS_RGIN + (size_t)2 * 2048 * 1024 * 2;
constexpr size_t WS_RGOUT = WS_RGGATE + (size_t)2 * 2048 * 256 * 2;
constexpr size_t WS_GDNIN = WS_RGOUT + (size_t)2 * 1024 * 1024 * 2;
constexpr size_t WS_GDNOUT = WS_GDNIN + (size_t)GDN_NP * 1024 * 2;
constexpr size_t WS_SSDIN = WS_GDNOUT + (size_t)1024 * 1024 * 2;
constexpr size_t WS_SSDOUT = WS_SSDIN + (size_t)SSD_NP * 1024 * 2;
constexpr size_t WS_SC = WS_SSDOUT + (size_t)1024 * 2048 * 2;
constexpr size_t WS_MOD = WS_SC + (size_t)256 * 1024 * 2;
constexpr size_t WS_AB = al256(WS_MOD + (size_t)4 * NSEQ * MODW * 4);
constexpr size_t WS_GB = WS_AB + (size_t)RP * 16 * 4;
constexpr size_t WS_DTR = WS_GB + (size_t)RP * 16 * 4;
constexpr size_t WS_DT = WS_DTR + (size_t)RP * 32 * 4;
constexpr size_t WS_GL = WS_DT + (size_t)RP * 32 * 4;
constexpr size_t WS_XSN = WS_GL + 2048 * 4;
constexpr size_t WS_QKVS = WS_XSN + (size_t)128 * 2048 * 2;
constexpr size_t WS_LS8 = WS_QKVS + (size_t)3 * 128 * 1024 * 2;
constexpr size_t WS_BAR = al256(WS_LS8 + 2 * 1024 * 4);
constexpr size_t WS_XS = al256(WS_BAR + 16384);
constexpr size_t WS_CNT = WS_XS + (size_t)NP * 4 * 4;
constexpr size_t WS_X = al256(WS_CNT + (size_t)8 * 64 * 64 * 4);
constexpr size_t WS_UB = WS_X + (size_t)RP * 1024 * 4;
constexpr size_t WS_P = WS_UB + (size_t)RP * 1024 * 2;
constexpr size_t P_BYTES = (size_t)RP * 5120 * 2;
constexpr size_t WS_S = WS_P + P_BYTES;
constexpr size_t S_BYTES = (size_t)RP * 1024 * 10;
constexpr size_t WS_END = WS_S + S_BYTES;
constexpr int O_Y = 0, O_PRGC = 16908288, O_PRGH = O_PRGC + 49152, O_PGDC = O_PRGH + 16384, O_PGDS = O_PGDC + 73728, O_PSSC = O_PGDS + 1048576, O_PSSH = O_PSSC + 73728,
              O_SRGC = O_PSSH + 2097152, O_SRGH = O_SRGC + 786432, O_SGDC = O_SRGH + 262144, O_SGDS = O_SGDC + 1179648, O_SSSC = O_SGDS + 16777216, O_SSSH = O_SSSC + 1179648;

struct Args { const float* in[36]; float* out; unsigned char* ws; int lo, hi; };
struct Ctx { ldsp lds; int tid, lane, wave, bid, G; };

DI float bf2f(unsigned short b) { return __uint_as_float(((unsigned)b) << 16); }
DI unsigned pk2(float lo, float hi) { typedef float f2_ __attribute__((ext_vector_type(2))); typedef __bf16 b2_ __attribute__((ext_vector_type(2))); const b2_ r = __builtin_convertvector((f2_){lo, hi}, b2_); return __builtin_bit_cast(unsigned, r); }
DI unsigned f2bf(float f) { return pk2(f, f) & 0xffffu; }
DI float lo16(unsigned w) { return __uint_as_float(w << 16); }
DI float hi16(unsigned w) { return __uint_as_float(w & 0xffff0000u); }
DI void unpack8(u32x4 w, float* f) { f[0] = lo16(w.x); f[1] = hi16(w.x); f[2] = lo16(w.y); f[3] = hi16(w.y); f[4] = lo16(w.z); f[5] = hi16(w.z); f[6] = lo16(w.w); f[7] = hi16(w.w); }
DI u32x4 pack8(const float* f) { u32x4 w; w.x = pk2(f[0], f[1]); w.y = pk2(f[2], f[3]); w.z = pk2(f[4], f[5]); w.w = pk2(f[6], f[7]); return w; }
DI float sigmoidf_(float x) { return __builtin_amdgcn_rcpf(1.0f + __expf(-x)); }
DI float siluf_(float x) { return x * __builtin_amdgcn_rcpf(1.0f + __expf(-x)); }
DI float softplusf_(float x) { return x > 20.f ? x : log1pf(__expf(x)); }
DI float gelu_tanh(float x) { const float y = 1.5957691216f * (x + 0.044715f * x * x * x); return x * __builtin_amdgcn_rcpf(1.0f + __expf(-y)); }
DI float wave_sum(float v) {
#pragma unroll
    for (int o = 1; o < 64; o <<= 1) v += __shfl_xor(v, o);
    return v;
}
DI int seq_of(int row) { int q = row < NP ? (row >> 11) : 8 + row - NP; return q > NSEQ - 1 ? NSEQ - 1 : q; }

#define XB_TMO      128
#define XB_XCNT(j)  (256  + 64 * (j))
#define XB_XSUB(j)  (1280 + 64 * (j))
#define XB_XGEN(j)  (2304 + 64 * (j))
#define XB_TOP      3328
#define XB_TOPGEN   3392
#define XCD_BAR_WORDS 3456
#define XB_SPIN_CAP (1u << 18)

__device__ __forceinline__ unsigned xb_ld(unsigned* p)              { return __hip_atomic_load(p, __ATOMIC_RELAXED, __HIP_MEMORY_SCOPE_AGENT); }
__device__ __forceinline__ unsigned xb_add(unsigned* p, unsigned v) { return __hip_atomic_fetch_add(p, v, __ATOMIC_RELAXED, __HIP_MEMORY_SCOPE_AGENT); }
__device__ __forceinline__ unsigned xb_xcc_id() { return (unsigned)__builtin_amdgcn_s_getreg((3 << 11) | 20) & 0xFu; }
#define XB_SPIN(cond, bar) do { unsigned _sp = 0; while (cond) { __builtin_amdgcn_s_sleep(1); \
    if ((++_sp & 255u) == 0u) { if (xb_ld(&(bar)[XB_TMO])) break; if (_sp > XB_SPIN_CAP) { atomicAdd(&(bar)[XB_TMO], 1u); break; } } } } while (0)

struct XcdBarrier {
    unsigned* bar; unsigned x;
    volatile LAS unsigned* st;
};

__device__ __forceinline__ XcdBarrier xcd_barrier_post(unsigned* bar, volatile LAS unsigned* st) {
    XcdBarrier b; b.bar = bar; b.x = xb_xcc_id(); b.st = st;
    if (threadIdx.x == 0) (void)xb_add(&bar[XB_XCNT(b.x)], 1u);
    return b;
}
__device__ __forceinline__ void xcd_barrier_complete(unsigned* bar, unsigned x, unsigned& nloc, unsigned& nx) {
    const unsigned G = gridDim.x * gridDim.y * gridDim.z;
    unsigned sum, cnt, mine, sp = 0u;
    for (;;) {
        sum = 0u; cnt = 0u; mine = 0u;
#pragma unroll
        for (unsigned j = 0; j < 16; ++j) { const unsigned c = xb_ld(&bar[XB_XCNT(j)]); sum += c; cnt += (c > 0u) ? 1u : 0u; mine = (j == x) ? c : mine; }
        if (sum == G) break;
        __builtin_amdgcn_s_sleep(1);
        if ((++sp & 255u) == 0u) { if (xb_ld(&bar[XB_TMO])) break; if (sp > XB_SPIN_CAP) { atomicAdd(&bar[XB_TMO], 1u); break; } }
    }
    nloc = mine > 0u ? mine : 1u; nx = cnt > 0u ? cnt : 1u;
}

__device__ __forceinline__ void xcd_barrier(const XcdBarrier& b) {
    asm volatile("s_waitcnt vmcnt(0)" ::: "memory");
    __syncthreads();
    if (threadIdx.x == 0) {
        unsigned* bar = b.bar;
        __builtin_amdgcn_s_waitcnt(0);
        unsigned nloc = b.st[0], nx = b.st[1];
        if (nloc == 0u) { xcd_barrier_complete(bar, b.x, nloc, nx); b.st[0] = nloc; b.st[1] = nx; }
        const unsigned old = xb_add(&bar[XB_XSUB(b.x)], 1u);
        const unsigned gen = old / nloc;
        if (old + 1u == (gen + 1u) * nloc) {
            __builtin_amdgcn_fence(__ATOMIC_RELEASE, "agent");
            asm volatile("s_waitcnt vmcnt(0)" ::: "memory");
            const unsigned og = xb_add(&bar[XB_TOP], 1u);
            const unsigned tg = og / nx;
            if (og + 1u == (tg + 1u) * nx) xb_add(&bar[XB_TOPGEN], 1u);
            else XB_SPIN(xb_ld(&bar[XB_TOPGEN]) == tg, bar);
            __builtin_amdgcn_fence(__ATOMIC_ACQUIRE, "agent");
            xb_add(&bar[XB_XGEN(b.x)], 1u);
            asm volatile("s_waitcnt vmcnt(0)" ::: "memory");
        } else {
            XB_SPIN(xb_ld(&bar[XB_XGEN(b.x)]) == gen, bar);
            __builtin_amdgcn_fence(__ATOMIC_ACQUIRE, "agent");
            asm volatile("s_waitcnt vmcnt(0)" ::: "memory");
        }
    }
    __syncthreads();
}

struct EpiMod {
    static constexpr bool PERM = false, AFTER_DRAIN = false;
    float* MOD; const float* bias;
    DI void operator()(const f32x4 (&acc)[2][2][4][2], const pg8::Unit& u, int wr, int wc, int fr, int fq) const {
        const int row0 = u.pm * 256 + wr * 64 + fr, col0 = u.pn * 256 + wc * 32 + 4 * fq;
#pragma unroll
        for (int ai = 0; ai < 2; ++ai)
#pragma unroll
            for (int m = 0; m < 4; ++m) { const int row = row0 + ai * 128 + m * 16;
                if (row < NSEQ) {
#pragma unroll
                    for (int bj = 0; bj < 2; ++bj)
#pragma unroll
                        for (int n = 0; n < 2; ++n) { const int col = col0 + bj * 128 + n * 16, layer = col / MODW, c = col - layer * MODW;
                            *(f32x4*)(MOD + ((size_t)layer * NSEQ + row) * MODW + c) = acc[ai][bj][m][n] + *(const f32x4*)(bias + col); } } }
    }
};
struct EpiRes {
    static constexpr bool PERM = false, AFTER_DRAIN = false;
    const float* bp; const float* bs; float* X; const float* gate;
    DI void operator()(const f32x4 (&acc)[2][2][4][2], const pg8::Unit& u, int wr, int wc, int fr, int fq) const {
        const int row0 = u.pm * 256 + wr * 64 + fr, col0 = u.pn * 256 + wc * 32 + 4 * fq;
#pragma unroll
        for (int ai = 0; ai < 2; ++ai)
#pragma unroll
            for (int m = 0; m < 4; ++m) { const int row = row0 + ai * 128 + m * 16;
                if (row < NR) { const float* base = row < NP ? bp + (size_t)row * D : bs + (size_t)(row - NP) * D; const float* gp = gate + (size_t)seq_of(row) * MODW; float* o = X + (size_t)row * D;
#pragma unroll
                    for (int bj = 0; bj < 2; ++bj)
#pragma unroll
                        for (int n = 0; n < 2; ++n) { const int col = col0 + bj * 128 + n * 16;
                            *(f32x4*)(o + col) = *(const f32x4*)(base + col) + *(const f32x4*)(gp + col) * acc[ai][bj][m][n]; } }
                asm volatile("" ::: "memory"); }
    }
};
struct EpiResNorm {
    static constexpr bool PERM = false, AFTER_DRAIN = true;
    const float* bp; float* X; const float* gate; const float* sc; const float* sh; bf16_t* UB; float* xs; unsigned* cnt;
    DI void operator()(const f32x4 (&)[2][2][4][2], const pg8::Unit&, int, int, int, int) const {}
    DI void fused(f32x4 (&acc)[2][2][4][2], const pg8::Unit& u, int wr, int wc, int fr, int fq, PG8_LAS unsigned char* lds, int wid, int lane) const {
        LAS float* Pp = (LAS float*)lds; LAS float* Sr = (LAS float*)(lds + 8192);
        const int row0 = u.pm * 256 + wr * 64 + fr, col0 = u.pn * 256 + wc * 32 + 4 * fq; const int q = (u.pm * 256) >> 11;
        const float* gp = gate + (size_t)q * MODW + col0;
#pragma unroll
        for (int ai = 0; ai < 2; ++ai)
#pragma unroll
            for (int m = 0; m < 4; ++m) { int row = row0 + ai * 128 + m * 16; asm volatile("" : "+v"(row)); const float* base = bp + (size_t)row * D + col0; float* o = X + (size_t)row * D + col0; float s = 0.f;
#pragma unroll
                for (int bj = 0; bj < 2; ++bj)
#pragma unroll
                    for (int n = 0; n < 2; ++n) { const int co = bj * 128 + n * 16; const f32x4 v = *(const f32x4*)(base + co) + *(const f32x4*)(gp + co) * acc[ai][bj][m][n];
                        acc[ai][bj][m][n] = v; *(f32x4*)(o + co) = v; s += (v.x * v.x + v.y * v.y) + (v.z * v.z + v.w * v.w); }
                s += __shfl_xor(s, 16); s += __shfl_xor(s, 32);
                if (fq == 0) Pp[(ai * 128 + wr * 64 + m * 16 + fr) * 4 + wc] = s;
                asm volatile("" ::: "memory"); }
        asm volatile("s_waitcnt lgkmcnt(0)" ::: "memory"); __builtin_amdgcn_s_barrier(); asm volatile("" ::: "memory");
        const int prow = wid * 32 + (lane & 31);
        if (lane < 32) { const float t = (Pp[prow * 4 + 0] + Pp[prow * 4 + 1]) + (Pp[prow * 4 + 2] + Pp[prow * 4 + 3]);
            __hip_atomic_store(xs + ((size_t)(u.pm * 256 + prow) * 4 + u.pn), t, __ATOMIC_RELAXED, __HIP_MEMORY_SCOPE_AGENT); }
        asm volatile("s_waitcnt vmcnt(0)" ::: "memory");
        if (lane == 0) __hip_atomic_fetch_add(cnt + 64 * u.pm, 1u, __ATOMIC_RELAXED, __HIP_MEMORY_SCOPE_AGENT);
        if (wid == 0) { unsigned spins = 0;
            while ((unsigned)__builtin_amdgcn_readfirstlane(__hip_atomic_load(cnt + 64 * u.pm, __ATOMIC_RELAXED, __HIP_MEMORY_SCOPE_AGENT)) < 32u) { __builtin_amdgcn_s_sleep(2); if (++spins > (1u << 22)) break; }
            __builtin_amdgcn_fence(__ATOMIC_ACQUIRE, "agent"); }
        asm volatile("s_waitcnt vmcnt(0) lgkmcnt(0)" ::: "memory"); __builtin_amdgcn_s_barrier(); asm volatile("" ::: "memory");
        if (lane < 32) { const float* sl = xs + (size_t)(u.pm * 256 + prow) * 4; float t = 0.f;
#pragma unroll
            for (int k = 0; k < 4; ++k) t += __hip_atomic_load(sl + k, __ATOMIC_RELAXED, __HIP_MEMORY_SCOPE_AGENT);
            Sr[prow] = rsqrtf(t * (1.0f / D) + EPS); }
        asm volatile("s_waitcnt lgkmcnt(0)" ::: "memory"); __builtin_amdgcn_s_barrier(); asm volatile("" ::: "memory");
        const float* scp = sc + (size_t)q * MODW + col0; const float* shp = sh + (size_t)q * MODW + col0;
#pragma unroll
        for (int ai = 0; ai < 2; ++ai)
#pragma unroll
            for (int m = 0; m < 4; ++m) { int lrow = ai * 128 + wr * 64 + m * 16 + fr; asm volatile("" : "+v"(lrow)); const float rstd = Sr[lrow]; bf16_t* o = UB + (size_t)(u.pm * 256 + lrow) * D + col0;
#pragma unroll
                for (int bj = 0; bj < 2; ++bj)
#pragma unroll
                    for (int n = 0; n < 2; ++n) { const int co = bj * 128 + n * 16; const f32x4 v = acc[ai][bj][m][n] * rstd * (*(const f32x4*)(scp + co) + 1.0f) + *(const f32x4*)(shp + co);
                        u32x2 w; w.x = pk2(v.x, v.y); w.y = pk2(v.z, v.w); *(u32x2*)(o + co) = w; }
                asm volatile("" ::: "memory"); }
    }
};
struct EpiResAtomic {
    static constexpr bool PERM = false, AFTER_DRAIN = false;
    float* X; const float* gate;
    DI void operator()(const f32x4 (&acc)[2][2][4][2], const pg8::Unit& u, int wr, int wc, int fr, int fq) const {
        const int row0 = NP + wr * 64 + fr, col0 = (u.pn & 3) * 256 + wc * 32 + 4 * fq;
#pragma unroll
        for (int ai = 0; ai < 2; ++ai)
#pragma unroll
            for (int m = 0; m < 4; ++m) { int row = row0 + ai * 128 + m * 16; asm volatile("" : "+v"(row));
                if (row < NR) { const float* gp = gate + (size_t)seq_of(row) * MODW + col0; float* o = X + (size_t)row * D + col0;
#pragma unroll
                    for (int bj = 0; bj < 2; ++bj)
#pragma unroll
                        for (int n = 0; n < 2; ++n) { const f32x4 gv = *(const f32x4*)(gp + bj * 128 + n * 16) * acc[ai][bj][m][n];
#pragma unroll
                            for (int e = 0; e < 4; ++e) __hip_atomic_fetch_add(o + bj * 128 + n * 16 + e, gv[e], __ATOMIC_RELAXED, __HIP_MEMORY_SCOPE_AGENT); } }
                asm volatile("" ::: "memory"); }
    }
};
struct EpiSplit {
    static constexpr bool PERM = true, AFTER_DRAIN = false;
    int act; bf16_t* O0; int ld0, b1; bf16_t* O1; int ld1, b2; float* F; int ldf, ntail;
    DI void operator()(const f32x4 (&acc)[2][2][4][2], const pg8::Unit& u, int wr, int wc, int fr, int fq) const {
        const int row0 = u.pm * 256 + wr * 64 + fr; const int colt = u.pn * 256;
        if (colt >= b2) {
            const int c0 = colt - b2 + wc * 32 + 8 * fq;
#pragma unroll
            for (int ai = 0; ai < 2; ++ai)
#pragma unroll
                for (int m = 0; m < 4; ++m) { const int row = row0 + ai * 128 + m * 16;
#pragma unroll
                    for (int bj = 0; bj < 2; ++bj)
#pragma unroll
                        for (int n = 0; n < 2; ++n) { const int c = c0 + bj * 128 + 4 * n; if (c < ntail) *(f32x4*)(F + (size_t)row * ldf + c) = acc[ai][bj][m][n]; } }
            return;
        }
        const bool s0 = colt < b1; bf16_t* base = s0 ? O0 : O1; const int ld = s0 ? ld0 : ld1; const int col0 = (s0 ? colt : colt - b1) + wc * 32 + 8 * fq;
#pragma unroll
        for (int ai = 0; ai < 2; ++ai)
#pragma unroll
            for (int m = 0; m < 4; ++m) { bf16_t* rowp = base + (size_t)(row0 + ai * 128 + m * 16) * ld + col0;
#pragma unroll
                for (int bj = 0; bj < 2; ++bj) { f32x4 v0 = acc[ai][bj][m][0], v1 = acc[ai][bj][m][1];
                    if (act == 1 && s0) {
#pragma unroll
                        for (int j = 0; j < 4; ++j) { v0[j] = gelu_tanh(v0[j]); v1[j] = gelu_tanh(v1[j]); } }
                    if (act == 2) {
#pragma unroll
                        for (int j = 0; j < 4; ++j) { const float a = fmaxf(v0[j], 0.f), b = fmaxf(v1[j], 0.f); v0[j] = a * a; v1[j] = b * b; } }
                    u32x4 w; w.x = pg8::cvt_pk_bf16(v0[0], v0[1]); w.y = pg8::cvt_pk_bf16(v0[2], v0[3]); w.z = pg8::cvt_pk_bf16(v1[0], v1[1]); w.w = pg8::cvt_pk_bf16(v1[2], v1[3]);
                    *(u32x4*)(rowp + bj * 128) = w; } }
    }
};
struct EpiGate {
    static constexpr bool PERM = false, AFTER_DRAIN = false;
    const bf16_t* XB; const float* gb; const float* ls8; float* LA; float* BX;
    DI void operator()(const f32x4 (&acc)[2][2][4][2], const pg8::Unit& u, int wr, int wc, int fr, int fq) const {
        const int row0 = u.pm * 256 + wr * 64 + fr, ch0 = u.pn * 128 + wc * 32 + 4 * fq;
#pragma unroll
        for (int n = 0; n < 2; ++n) { const int ch = ch0 + n * 16; const f32x4 br = *(const f32x4*)(gb + ch), bi = *(const f32x4*)(gb + D + ch), ls = *(const f32x4*)(ls8 + ch);
#pragma unroll
            for (int ai = 0; ai < 2; ++ai)
#pragma unroll
                for (int m = 0; m < 4; ++m) { const int row = row0 + ai * 128 + m * 16; int o = row * D + ch; asm volatile("" : "+v"(o));
                    if (row < NR) { const u32x2 xw = *(const u32x2*)(XB + o);
                        const float xb[4] = {lo16(xw.x), hi16(xw.x), lo16(xw.y), hi16(xw.y)}; f32x4 la, bx;
#pragma unroll
                        for (int j = 0; j < 4; ++j) { const float r = sigmoidf_(acc[ai][0][m][n][j] + br[j]), ig = sigmoidf_(acc[ai][1][m][n][j] + bi[j]);
                            const float l = r * ls[j], a = __expf(l); la[j] = l; bx[j] = __builtin_amdgcn_sqrtf(fmaxf(1.0f - a * a, 0.f)) * ig * xb[j]; }
                        *(f32x4*)(LA + o) = la; *(f32x4*)(BX + o) = bx; }
                    asm volatile("" ::: "memory"); } }
    }
};
DI void transpose_item(const float* W, int K, int N, bf16_t* WT, int row_off, LAS float* scr, int kb, int nb, int lane) {
    const int k0 = 64 * kb, n0 = 32 * nb; const int n4 = (lane & 7) * 4, kr = lane >> 3;
    const GAS float* Wg = (const GAS float*)W; GAS bf16_t* WTg = (GAS bf16_t*)WT;
    f32x4 v[8];
    if (n0 + 32 <= N) {
#pragma unroll
        for (int i = 0; i < 8; ++i) v[i] = *(const GAS f32x4*)(Wg + (size_t)(k0 + i * 8 + kr) * N + n0 + n4);
    } else {
#pragma unroll
        for (int i = 0; i < 8; ++i) { const GAS float* src = Wg + (size_t)(k0 + i * 8 + kr) * N + n0 + n4;
#pragma unroll
            for (int e = 0; e < 4; ++e) v[i][e] = (n0 + n4 + e < N) ? src[e] : 0.f; }
    }
#pragma unroll
    for (int i = 0; i < 8; ++i) { LAS float* d = scr + (i * 8 + kr) * 33 + n4; d[0] = v[i].x; d[1] = v[i].y; d[2] = v[i].z; d[3] = v[i].w; }
    asm volatile("s_waitcnt lgkmcnt(0)" ::: "memory");
    const int c = lane & 7;
#pragma unroll
    for (int j = 0; j < 4; ++j) { const int n = (lane >> 3) + 8 * j; const LAS float* s = scr + (8 * c) * 33 + n;
        u32x4 o; o.x = pk2(s[0 * 33], s[1 * 33]); o.y = pk2(s[2 * 33], s[3 * 33]); o.z = pk2(s[4 * 33], s[5 * 33]); o.w = pk2(s[6 * 33], s[7 * 33]);
        if (n0 + n < N) *(GAS u32x4*)(WTg + (size_t)(row_off + n0 + n) * K + k0 + 8 * c) = o; }
    asm volatile("s_waitcnt lgkmcnt(0)" ::: "memory");
}
struct TJob { const float* W; bf16_t* WT; int K, N, mode, aux; };
template <class ArgsRef> DI void prep_phase(const Ctx& c, const ArgsRef& a, bool first) {
    unsigned char* ws = a.ws;
    LAS TJob* jobs = (LAS TJob*)(c.lds + 131072 - 4096); LAS int* cum = (LAS int*)(c.lds + 131072 - 512);
    constexpr int NJ = 40;
    if (c.tid == 0) {
        int j = 0;
        auto add = [&](const float* W, bf16_t* WT, int K, int N, int mode, int aux) { jobs[j].W = W; jobs[j].WT = WT; jobs[j].K = K; jobs[j].N = N; jobs[j].mode = mode; jobs[j].aux = aux; ++j; };
        for (int i = 0; i < 4; ++i) add(GIN(10) + (size_t)i * 1024 * MODW, (bf16_t*)(ws + WS_P) + (size_t)i * MODW * 1024, 1024, MODW, 0, 0);
        for (int i = 0; i < 4; ++i) add(GIN(12) + (size_t)i * 1024 * 4096, (bf16_t*)(ws + WS_WUP) + (size_t)i * 4096 * 1024, 1024, 4096, 0, 0);
        for (int i = 0; i < 4; ++i) add(GIN(13) + (size_t)i * 1024 * 4096, (bf16_t*)(ws + WS_WDN) + (size_t)i * 4096 * 1024, 4096, 1024, 0, 0);
        for (int i = 0; i < 2; ++i) add(GIN(15) + (size_t)i * 1024 * 2048, (bf16_t*)(ws + WS_RGIN) + (size_t)i * 2048 * 1024, 1024, 2048, 0, 0);
        for (int i = 0; i < 16; ++i) add(GIN(18) + (size_t)i * 65536, (bf16_t*)(ws + WS_RGGATE) + (size_t)(i >> 3) * 2048 * 256, 256, 256, 1, i & 7);
        for (int i = 0; i < 2; ++i) add(GIN(21) + (size_t)i * 1024 * 1024, (bf16_t*)(ws + WS_RGOUT) + (size_t)i * 1024 * 1024, 1024, 1024, 0, 0);
        add(GIN(22), (bf16_t*)(ws + WS_GDNIN), 1024, GDN_N, 0, 0);
        add(GIN(27), (bf16_t*)(ws + WS_GDNOUT), 1024, 1024, 0, 0);
        add(GIN(28), (bf16_t*)(ws + WS_SSDIN), 1024, SSD_N, 0, 0);
        add(GIN(35), (bf16_t*)(ws + WS_SSDOUT), 2048, 1024, 0, 0);
        int s = 0; for (int i = 0; i < NJ; ++i) { if (i < j) s += (jobs[i].K / 64) * ((jobs[i].N + 31) / 32); cum[i] = s; }
    }
    __syncthreads();
    const int total = cum[NJ - 1]; const int gw = c.bid * 8 + c.wave, NGW = c.G * 8;
    LAS float* scr = (LAS float*)(c.lds + c.wave * 8704);
    for (int it = gw; it < total; it += NGW) {
        int j = 0; while (cum[j] <= it) ++j;
        const int r = it - (j ? cum[j - 1] : 0); const int K = jobs[j].K, N = jobs[j].N, nblk = (N + 31) / 32, kb = r / nblk, nb = r % nblk;
        int row_off = 0;
        if (jobs[j].mode == 1) { const int g = jobs[j].aux >> 2, blk = jobs[j].aux & 3, n0 = nb * 32; row_off = 256 * (2 * blk + (n0 >> 7)) + 128 * g + (n0 & 127) - n0; }
        transpose_item(jobs[j].W, K, N, jobs[j].WT, row_off, scr, kb, nb, c.lane);
    }
    const int gt = c.bid * 512 + c.tid, NT = c.G * 512;
    bf16_t* SC = (bf16_t*)(ws + WS_SC);
    for (int i = gt; i < 256 * 128; i += NT) { const int row = i >> 7, c8 = (i & 127) * 8; float f[8];
        if (row < NSEQ) { const float* src = row < 8 ? GIN(8) + row * D + c8 : GIN(9) + (row - 8) * D + c8;
#pragma unroll
            for (int e = 0; e < 8; ++e) f[e] = siluf_(src[e]); }
        else {
#pragma unroll
            for (int e = 0; e < 8; ++e) f[e] = 0.f; }
        *(u32x4*)(SC + (size_t)row * D + c8) = pack8(f); }
    for (int i = gt; i < 2 * D; i += NT) ((float*)(ws + WS_LS8))[i] = -8.0f * log1pf(__expf(-GIN(20)[i]));
    if (c.bid == 0 && first) for (int i = c.tid; i < 4096; i += 512) ((unsigned*)(ws + WS_BAR))[i] = 0u;
    for (int i = gt; i < 8 * 64 * 64; i += NT) ((unsigned*)(ws + WS_CNT))[i] = 0u;
    for (int i = gt; i < NS * D / 4; i += NT) ((f32x4*)(ws + WS_X + (size_t)NP * D * 4))[i] = ((const f32x4*)GIN(1))[i];
    const u32x4 z4 = {0u, 0u, 0u, 0u};
    for (int i = gt; i < (GDN_NP - GDN_N) * 128; i += NT) *(u32x4*)((bf16_t*)(ws + WS_GDNIN) + (size_t)GDN_N * 1024 + (size_t)i * 8) = z4;
    for (int i = gt; i < (SSD_NP - SSD_N) * 128; i += NT) *(u32x4*)((bf16_t*)(ws + WS_SSDIN) + (size_t)SSD_N * 1024 + (size_t)i * 8) = z4;
}

DI void norm_mod_phase(const Ctx& c, const float* __restrict__ xp, const float* __restrict__ xs, const float* __restrict__ sc, const float* __restrict__ sh, bf16_t* __restrict__ out, int r_begin) {
    const int stride = c.G * 8;
    for (int r = r_begin + c.bid * 8 + c.wave; r < NR; r += 2 * stride) {
        const int r2 = r + stride; const bool two = r2 < NR; const int rb = two ? r2 : r;
        const float* xa = r < NP ? xp + (size_t)r * D : xs + (size_t)(r - NP) * D; const float* xb = rb < NP ? xp + (size_t)rb * D : xs + (size_t)(rb - NP) * D;
        f32x4 va[4], vb[4]; float sa = 0.f, sb = 0.f;
#pragma unroll
        for (int j = 0; j < 4; ++j) { va[j] = *(const f32x4*)(xa + c.lane * 4 + 256 * j); vb[j] = *(const f32x4*)(xb + c.lane * 4 + 256 * j); }
#pragma unroll
        for (int j = 0; j < 4; ++j) { sa += (va[j].x * va[j].x + va[j].y * va[j].y) + (va[j].z * va[j].z + va[j].w * va[j].w); sb += (vb[j].x * vb[j].x + vb[j].y * vb[j].y) + (vb[j].z * vb[j].z + vb[j].w * vb[j].w); }
        const float ra = rsqrtf(wave_sum(sa) * (1.0f / D) + EPS), rbs = rsqrtf(wave_sum(sb) * (1.0f / D) + EPS);
        const int qa = seq_of(r), qb = seq_of(rb);
#pragma unroll
        for (int j = 0; j < 4; ++j) { const int col = c.lane * 4 + 256 * j;
            { const f32x4 s1 = *(const f32x4*)(sc + (size_t)qa * MODW + col), s2 = *(const f32x4*)(sh + (size_t)qa * MODW + col);
              const f32x4 o = va[j] * ra * (s1 + 1.0f) + s2; u32x2 w; w.x = pk2(o.x, o.y); w.y = pk2(o.z, o.w); *(u32x2*)(out + (size_t)r * D + col) = w; }
            if (two) { const f32x4 s1 = *(const f32x4*)(sc + (size_t)qb * MODW + col), s2 = *(const f32x4*)(sh + (size_t)qb * MODW + col);
              const f32x4 o = vb[j] * rbs * (s1 + 1.0f) + s2; u32x2 w; w.x = pk2(o.x, o.y); w.y = pk2(o.z, o.w); *(u32x2*)(out + (size_t)r2 * D + col) = w; } }
    }
}
DI void final_norm_phase(const Ctx& c, const float* X, const float* g, float* out) {
    for (int r = c.bid * 8 + c.wave; r < NR; r += c.G * 8) {
        const float* xr = X + (size_t)r * D; f32x4 v[4]; float ss = 0.f;
#pragma unroll
        for (int j = 0; j < 4; ++j) { v[j] = *(const f32x4*)(xr + c.lane * 4 + 256 * j); ss += (v[j].x * v[j].x + v[j].y * v[j].y) + (v[j].z * v[j].z + v[j].w * v[j].w); }
        const float rstd = rsqrtf(wave_sum(ss) * (1.0f / D) + EPS);
#pragma unroll
        for (int j = 0; j < 4; ++j) { const int col = c.lane * 4 + 256 * j; *(f32x4*)(out + (size_t)r * D + col) = v[j] * rstd * *(const f32x4*)(g + col); }
    }
}

DI void conv8(const bf16_t* P, int ld, int row, int t, const float* st, int nch, const float* w, const float* b, int ch, float* f, float* cur) {
    float x[4][8];
    unpack8(*(const u32x4*)(P + (size_t)row * ld), x[3]);
#pragma unroll
    for (int k = 0; k < 3; ++k) {
        if (t < 0) { const f32x4 a0 = *(const f32x4*)(st + k * nch + ch), a1 = *(const f32x4*)(st + k * nch + ch + 4); x[k][0] = a0.x; x[k][1] = a0.y; x[k][2] = a0.z; x[k][3] = a0.w; x[k][4] = a1.x; x[k][5] = a1.y; x[k][6] = a1.z; x[k][7] = a1.w; }
        else if (t - 3 + k >= 0) unpack8(*(const u32x4*)(P + (size_t)(row - 3 + k) * ld), x[k]);
        else {
#pragma unroll
            for (int e = 0; e < 8; ++e) x[k][e] = 0.f; }
    }
#pragma unroll
    for (int e = 0; e < 8; ++e) { f[e] = b ? b[ch + e] : 0.f; cur[e] = x[3][e]; }
#pragma unroll
    for (int k = 0; k < 4; ++k) { const f32x4 w0 = *(const f32x4*)(w + k * nch + ch), w1 = *(const f32x4*)(w + k * nch + ch + 4);
        f[0] += x[k][0] * w0.x; f[1] += x[k][1] * w0.y; f[2] += x[k][2] * w0.z; f[3] += x[k][3] * w0.w; f[4] += x[k][4] * w1.x; f[5] += x[k][5] * w1.y; f[6] += x[k][6] * w1.z; f[7] += x[k][7] * w1.w; }
}
DI void conv_state8(int row, int t, const float* cur, const float* st, int nch, int ch, float* pout  , float* sout  ) {
    if (t >= 0) { if (t >= SEQL - 3) { float* o = pout + ((size_t)(row >> 11) * 3 + (t - (SEQL - 3))) * nch + ch; *(f32x4*)o = (f32x4){cur[0], cur[1], cur[2], cur[3]}; *(f32x4*)(o + 4) = (f32x4){cur[4], cur[5], cur[6], cur[7]}; } }
    else { const int s = row - NP; float* o = sout + (size_t)s * 3 * nch + ch;
        *(f32x4*)o = *(const f32x4*)(st + nch + ch); *(f32x4*)(o + 4) = *(const f32x4*)(st + nch + ch + 4);
        *(f32x4*)(o + nch) = *(const f32x4*)(st + 2 * nch + ch); *(f32x4*)(o + nch + 4) = *(const f32x4*)(st + 2 * nch + ch + 4);
        *(f32x4*)(o + 2 * nch) = (f32x4){cur[0], cur[1], cur[2], cur[3]}; *(f32x4*)(o + 2 * nch + 4) = (f32x4){cur[4], cur[5], cur[6], cur[7]}; }
}

DI void conv8_slide(const bf16_t* Pc  , int ld, int r0, const float* w, const float* b, int nch, int ch, float (&out)[8][8], u32x4 (&raw)[11]) {
    const bool head = (r0 & (SEQL - 1)) == 0; const u32x4 z = {0u, 0u, 0u, 0u};
#pragma unroll
    for (int k = 0; k < 11; ++k) raw[k] = (k < 3 && head) ? z : *(const u32x4*)(Pc + (size_t)(r0 - 3 + k) * ld);
    float wk[4][8], bb[8];
#pragma unroll
    for (int k = 0; k < 4; ++k) { const f32x4 w0 = *(const f32x4*)(w + k * nch + ch), w1 = *(const f32x4*)(w + k * nch + ch + 4); wk[k][0] = w0.x; wk[k][1] = w0.y; wk[k][2] = w0.z; wk[k][3] = w0.w; wk[k][4] = w1.x; wk[k][5] = w1.y; wk[k][6] = w1.z; wk[k][7] = w1.w; }
#pragma unroll
    for (int e = 0; e < 8; ++e) bb[e] = b ? b[ch + e] : 0.f;
#pragma unroll
    for (int t = 0; t < 8; ++t)
#pragma unroll
        for (int e = 0; e < 8; ++e) out[t][e] = bb[e];
#pragma unroll
    for (int k = 0; k < 11; ++k) { float x[8]; unpack8(raw[k], x);
#pragma unroll
        for (int t = 0; t < 8; ++t) { const int tap = k - t; if (tap >= 0 && tap < 4) {
#pragma unroll
            for (int e = 0; e < 8; ++e) out[t][e] += x[e] * wk[tap][e]; } } }
}
DI void prompt_conv_state(const Ctx& c, const bf16_t* P, int ld, int nch, float* pout) {
    for (int i = c.bid * 512 + c.tid; i < 8 * 3 * nch; i += c.G * 512) { const int ch = i % nch, r = i / nch, k = r % 3, b = r / 3;
        pout[i] = bf2f(P[(size_t)(b * SEQL + SEQL - 3 + k) * ld + ch]); }
}
DI void rg_conv_phase(const Ctx& c, const bf16_t* P  , const float* cw, const float* cb, const float* st  , bf16_t* XB, float* pout, float* sout) {
    for (int i = c.bid * 512 + c.tid; i < (NP / 8) * 128; i += c.G * 512) {
        const int r0 = (i >> 7) * 8, ch = (i & 127) * 8; float o[8][8]; u32x4 raw[11];
        conv8_slide(P + 1024 + ch, 2048, r0, cw, cb, D, ch, o, raw);
#pragma unroll
        for (int t = 0; t < 8; ++t) *(u32x4*)(XB + (size_t)(r0 + t) * D + ch) = pack8(o[t]);
    }
    for (int i = c.bid * 512 + c.tid; i < NS * 128; i += c.G * 512) {
        const int row = NP + (i >> 7), ch = (i & 127) * 8; const float* sp = st + (size_t)(row - NP) * 3 * D;
        float f[8], cur[8]; conv8(P + 1024 + ch, 2048, row, -1, sp, D, cw, cb, ch, f, cur);
        *(u32x4*)(XB + (size_t)row * D + ch) = pack8(f);
        conv_state8(row, -1, cur, sp, D, ch, pout, sout);
    }
    prompt_conv_state(c, P + 1024, 2048, D, pout);
}
DI void rg_scan_phase(const Ctx& c, const float* __restrict__ LA, const float* __restrict__ BX, const bf16_t* __restrict__ P  , const float* h0  , bf16_t* __restrict__ HY, float* ph  , float* sh  ) {
    LAS float* sA = (LAS float*)c.lds; LAS float* sB = sA + 512;
    for (int it = c.bid; it < 256; it += c.G) {
        const int b = it >> 5, ch = (it & 31) * 32 + (c.tid & 31), seg = c.tid >> 5; const int r0 = b * SEQL + seg * 128;
        const float* lap = LA + (size_t)r0 * D + ch; const float* bxp = BX + (size_t)r0 * D + ch; const bf16_t* yp = P + (size_t)r0 * 2048 + ch; bf16_t* op = HY + (size_t)r0 * D + ch;
        float h = 0.f, ap = 0.f;
#pragma unroll 1
        for (int t0 = 0; t0 < 128; t0 += 16) { float la[16], bx[16];
#pragma unroll
            for (int u = 0; u < 16; ++u) { la[u] = lap[(size_t)(t0 + u) * D]; bx[u] = bxp[(size_t)(t0 + u) * D]; }
#pragma unroll
            for (int u = 0; u < 16; ++u) { h = __expf(la[u]) * h + bx[u]; ap += la[u]; } }
        sA[c.tid] = __expf(ap); sB[c.tid] = h;
        __syncthreads();
        float hin = 0.f;
        for (int s = 0; s < seg; ++s) hin = sA[s * 32 + (c.tid & 31)] * hin + sB[s * 32 + (c.tid & 31)];
        h = hin;
#pragma unroll 1
        for (int t0 = 0; t0 < 128; t0 += 16) { float la[16], bx[16]; bf16_t yv[16];
#pragma unroll
            for (int u = 0; u < 16; ++u) { la[u] = lap[(size_t)(t0 + u) * D]; bx[u] = bxp[(size_t)(t0 + u) * D]; yv[u] = yp[(size_t)(t0 + u) * 2048]; }
#pragma unroll
            for (int u = 0; u < 16; ++u) { h = __expf(la[u]) * h + bx[u]; op[(size_t)(t0 + u) * D] = (bf16_t)f2bf(h * bf2f(yv[u])); } }
        if (seg == 15) ph[b * D + ch] = h;
        __syncthreads();
    }
    for (int i = c.bid * 512 + c.tid; i < NS * D; i += c.G * 512) { const int s = i >> 10, ch = i & 1023; const size_t o = (size_t)(NP + s) * D + ch;
        const float h = __expf(LA[o]) * h0[i] + BX[o]; sh[i] = h; HY[o] = (bf16_t)f2bf(h * bf2f(P[(size_t)(NP + s) * 2048 + ch])); }
}
DI void gdn_conv_phase(const Ctx& c, const bf16_t* P, const float* cw  , const float* st  , const float* AB, const float* A_log, const float* dt_bias,
                       bf16_t* Q, bf16_t* K, bf16_t* V, bf16_t* QKVS, float* GB, float* pout, float* sout) {
    for (int wt = c.bid * 8 + c.wave; wt < (NP / 8) * 6; wt += c.G * 8) {
        const int seg = wt % 6, r0 = (wt / 6) * 8, ch = seg * 512 + c.lane * 8; float o[8][8]; u32x4 raw[11];
        conv8_slide(P + ch, 3072, r0, cw, nullptr, 3072, ch, o, raw);
        bf16_t* dst = (seg < 2 ? Q : (seg < 4 ? K : V)) + (seg & 1) * 512 + c.lane * 8;
#pragma unroll
        for (int t = 0; t < 8; ++t) { float ss = 0.f;
#pragma unroll
            for (int e = 0; e < 8; ++e) { o[t][e] = siluf_(o[t][e]); ss += o[t][e] * o[t][e]; }
            if (seg < 4) { ss += __shfl_xor(ss, 1); ss += __shfl_xor(ss, 2); ss += __shfl_xor(ss, 4); ss += __shfl_xor(ss, 8);
                const float sc = rsqrtf(ss + EPS) * (seg < 2 ? 0.08838834764831845f : 1.0f);
#pragma unroll
                for (int e = 0; e < 8; ++e) o[t][e] *= sc; }
            *(u32x4*)(dst + (size_t)(r0 + t) * D) = pack8(o[t]); }
    }
    for (int row = NP + c.bid * 8 + c.wave; row < NR; row += c.G * 8) {
        const float* sp = st + (size_t)(row - NP) * 3 * 3072;
#pragma unroll 1
        for (int pass = 0; pass < 6; ++pass) {
            const int ch = pass * 512 + c.lane * 8; float f[8], cur[8];
            conv8(P + ch, 3072, row, -1, sp, 3072, cw, nullptr, ch, f, cur);
            conv_state8(row, -1, cur, sp, 3072, ch, pout, sout);
            float ss = 0.f;
#pragma unroll
            for (int e = 0; e < 8; ++e) { f[e] = siluf_(f[e]); ss += f[e] * f[e]; }
            if (pass < 4) { ss += __shfl_xor(ss, 1); ss += __shfl_xor(ss, 2); ss += __shfl_xor(ss, 4); ss += __shfl_xor(ss, 8);
                const float sc = rsqrtf(ss + EPS) * (pass < 2 ? 0.08838834764831845f : 1.0f);
#pragma unroll
                for (int e = 0; e < 8; ++e) f[e] *= sc; }
            *(u32x4*)(QKVS + ((size_t)(pass >> 1) * NS + (row - NP)) * D + (pass & 1) * 512 + c.lane * 8) = pack8(f);
        }
    }
    for (int i = c.bid * 512 + c.tid; i < NR * 8; i += c.G * 512) { const int row = i >> 3, h = i & 7; const float a_in = AB[(size_t)row * 16 + h], b_in = AB[(size_t)row * 16 + 8 + h];
        GB[(size_t)row * 16 + h] = -__expf(A_log[h]) * softplusf_(a_in + dt_bias[h]); GB[(size_t)row * 16 + 8 + h] = sigmoidf_(b_in); }
    prompt_conv_state(c, P, 3072, 3072, pout);
}
DI void gdn_prep_phase(const Ctx& c, const bf16_t* Q, const bf16_t* K, const bf16_t* V, const float* GB, float* UT, bf16_t* NW, bf16_t* QD, bf16_t* KDT, bf16_t* QKG, float* GL) {
    const int half = c.tid >> 8, t = c.tid & 255, w4 = c.wave & 3, lr = c.lane & 15, quad = c.lane >> 4;
    ldsp L = c.lds + half * 65536; ldsp kS = L, qS = L + 17408; LAS float* AT = (LAS float*)(L + 34816); LAS float* Gs = (LAS float*)(L + 51200); LAS float* Bs = Gs + 64; LAS float* EGs = Gs + 128;
    for (int pair = c.bid; pair < 1024; pair += c.G) {
        const int item = pair * 2 + half, n = item & 31, h = (item >> 5) & 7, b = item >> 8, r0 = b * SEQL + n * 64;
        if (t < 64) { float G = GB[(size_t)(r0 + t) * 16 + h]; const float be = GB[(size_t)(r0 + t) * 16 + 8 + h];
#pragma unroll
            for (int o = 1; o < 64; o <<= 1) { const float v = __shfl_up(G, o); if (c.lane >= o) G += v; }
            Gs[t] = G; Bs[t] = be; EGs[t] = __expf(G); }
#pragma unroll
        for (int i = 0; i < 4; ++i) { const int ci = t + i * 256, row = ci >> 4, cc = ci & 15; const size_t go = (size_t)(r0 + row) * D + h * 128 + cc * 8;
            *(LAS u32x4*)(kS + row * 272 + cc * 16) = *(const u32x4*)(K + go); *(LAS u32x4*)(qS + row * 272 + cc * 16) = *(const u32x4*)(Q + go); }
        __syncthreads();
        {
            const int ib = w4; float Gi[4], bi[4];
#pragma unroll
            for (int jj = 0; jj < 4; ++jj) { Gi[jj] = Gs[ib * 16 + quad * 4 + jj]; bi[jj] = Bs[ib * 16 + quad * 4 + jj]; }
            bf16_t* qkg = QKG + (size_t)item * 4096;
#pragma unroll 1
            for (int jb = 0; jb < 4; ++jb) {
                if (jb <= ib) {
                    f32x4 akk = {0.f, 0.f, 0.f, 0.f}, aqk = {0.f, 0.f, 0.f, 0.f};
#pragma unroll
                    for (int ks = 0; ks < 4; ++ks) { const bf16x8 ak = *(const LAS bf16x8*)(kS + (ib * 16 + lr) * 272 + ks * 64 + quad * 16), aq = *(const LAS bf16x8*)(qS + (ib * 16 + lr) * 272 + ks * 64 + quad * 16),
                                                                  bk = *(const LAS bf16x8*)(kS + (jb * 16 + lr) * 272 + ks * 64 + quad * 16);
                        akk = MFMA16(ak, bk, akk); aqk = MFMA16(aq, bk, aqk); }
                    const int j = jb * 16 + lr; const float Gj = Gs[j]; f32x4 av;
#pragma unroll
                    for (int jj = 0; jj < 4; ++jj) { const int i = ib * 16 + quad * 4 + jj; const float dec = i >= j ? __expf(Gi[jj] - Gj) : 0.f;
                        av[jj] = i > j ? bi[jj] * akk[jj] * dec : 0.f; qkg[i * 64 + j] = (bf16_t)f2bf(aqk[jj] * dec); }
                    *(LAS f32x4*)(AT + j * 64 + ib * 16 + quad * 4) = av;
                } else {
#pragma unroll
                    for (int jj = 0; jj < 4; ++jj) qkg[(ib * 16 + quad * 4 + jj) * 64 + jb * 16 + lr] = 0;
                }
            }
        }
#pragma unroll
        for (int i = 0; i < 4; ++i) { const int ci = t + i * 256, row = ci >> 4, cc = ci & 15; float f[8]; unpack8(*(const LAS u32x4*)(qS + row * 272 + cc * 16), f); const float eg = EGs[row];
#pragma unroll
            for (int e = 0; e < 8; ++e) f[e] *= eg;
            *(u32x4*)(QD + (size_t)(r0 + row) * D + h * 128 + cc * 8) = pack8(f); }
        { const int dk = t & 127, chf = t >> 7; const float Gl = Gs[63];
#pragma unroll
            for (int c8 = 0; c8 < 4; ++c8) { const int c0 = chf * 32 + c8 * 8; float f[8];
#pragma unroll
                for (int e = 0; e < 8; ++e) f[e] = bf2f(*(const LAS bf16_t*)(kS + (c0 + e) * 272 + dk * 2)) * __expf(Gl - Gs[c0 + e]);
                *(u32x4*)(KDT + ((size_t)item * 128 + dk) * 64 + c0) = pack8(f); }
            if (t == 0) GL[item] = __expf(Gl); }
        __syncthreads();
#pragma unroll
        for (int i = 0; i < 4; ++i) { const int ci = t + i * 256, row = ci >> 4, cc = ci & 15; *(LAS u32x4*)(qS + row * 272 + cc * 16) = *(const u32x4*)(V + (size_t)(r0 + row) * D + h * 128 + cc * 8); }
        __syncthreads();
        {
            float x[64];
            if (t < 128) {
#pragma unroll
                for (int i = 0; i < 64; ++i) x[i] = bf2f(*(const LAS bf16_t*)(qS + i * 272 + t * 2)) * Bs[i];
            } else {
#pragma unroll
                for (int i = 0; i < 64; ++i) x[i] = bf2f(*(const LAS bf16_t*)(kS + i * 272 + (t - 128) * 2)) * Bs[i] * EGs[i];
            }
#pragma unroll
            for (int j = 0; j < 63; ++j) {
#pragma unroll
                for (int i4 = ((j + 1) & ~3); i4 < 64; i4 += 4) { const f32x4 av = *(const LAS f32x4*)(AT + j * 64 + i4);
                    if (i4 + 0 > j) x[i4 + 0] -= av.x * x[j];
                    if (i4 + 1 > j) x[i4 + 1] -= av.y * x[j];
                    if (i4 + 2 > j) x[i4 + 2] -= av.z * x[j];
                    if (i4 + 3 > j) x[i4 + 3] -= av.w * x[j]; }
            }
            __syncthreads();
            if (t < 128) { float* o = UT + ((size_t)item * 128 + t) * 64;
#pragma unroll
                for (int i = 0; i < 16; ++i) *(f32x4*)(o + 4 * i) = (f32x4){x[4 * i], x[4 * i + 1], x[4 * i + 2], x[4 * i + 3]};
            } else {
#pragma unroll
                for (int i = 0; i < 64; ++i) *(LAS bf16_t*)(kS + i * 272 + (t - 128) * 2) = (bf16_t)f2bf(-x[i]);
            }
        }
        __syncthreads();
#pragma unroll
        for (int i = 0; i < 4; ++i) { const int ci = t + i * 256, row = ci >> 4, cc = ci & 15; *(u32x4*)(NW + (size_t)(r0 + row) * D + h * 128 + cc * 8) = *(const LAS u32x4*)(kS + row * 272 + cc * 16); }
        __syncthreads();
    }
}
DI void gdn_seq_phase(const Ctx& c, const float* UT, const bf16_t* NW, const bf16_t* QD, const bf16_t* KDT, const bf16_t* QKG, const float* GL, float* O, float* pS,
                      const bf16_t* QKVS, const float* GB, const float* S0, float* sS) {
    const int lr = c.lane & 15, quad = c.lane >> 4, w = c.wave;
    ldsp Ws = c.lds, Qs = c.lds + 17408, KTs = c.lds + 34816, QKs = c.lds + 53248, Sts = c.lds + 62464, VTs = c.lds + 71168;
    for (int it0 = c.bid; it0 < 256; it0 += c.G) {
        const int cb = (it0 >> 3) & 3, bh = (it0 & 7) * 8 + (it0 >> 5), b = bh >> 3, h = bh & 7, ci = w >> 1, vi = w & 1;
        f32x4 Sacc[2] = {{0.f, 0.f, 0.f, 0.f}, {0.f, 0.f, 0.f, 0.f}};
        for (int i = c.tid; i < 8704 / 4; i += 512) ((LAS unsigned*)Sts)[i] = 0u;
        u32x4 pf[2][7]; f32x4 put[2]; float pgl[2];
        typedef std::integral_constant<int, 0> I0; typedef std::integral_constant<int, 1> I1;
        auto fetch = [&](int n, auto SL) { constexpr int sl = decltype(SL)::value; const int pit = bh * 32 + n, r0 = b * SEQL + n * 64;
            put[sl] = *(const f32x4*)(UT + ((size_t)pit * 128 + cb * 32 + vi * 16 + lr) * 64 + ci * 16 + quad * 4); pgl[sl] = GL[pit];
#pragma unroll
            for (int i = 0; i < 2; ++i) { const int cidx = c.tid + i * 512, row = cidx >> 4, cc = cidx & 15; const size_t go = (size_t)(r0 + row) * D + h * 128 + cc * 8; pf[sl][i] = *(const u32x4*)(NW + go); pf[sl][2 + i] = *(const u32x4*)(QD + go); }
#pragma unroll
            for (int i = 0; i < 2; ++i) { const int cidx = c.tid + i * 512; pf[sl][4 + i] = *(const u32x4*)(KDT + (size_t)pit * 8192 + cidx * 8); }
            pf[sl][6] = *(const u32x4*)(QKG + (size_t)pit * 4096 + c.tid * 8); };
        auto stash = [&](auto SL) { constexpr int sl = decltype(SL)::value;
#pragma unroll
            for (int i = 0; i < 2; ++i) { const int cidx = c.tid + i * 512, row = cidx >> 4, cc = cidx & 15; *(LAS u32x4*)(Ws + row * 272 + cc * 16) = pf[sl][i]; *(LAS u32x4*)(Qs + row * 272 + cc * 16) = pf[sl][2 + i]; }
#pragma unroll
            for (int i = 0; i < 2; ++i) { const int cidx = c.tid + i * 512, row = cidx >> 3, cc = cidx & 7; *(LAS u32x4*)(KTs + row * 144 + cc * 16) = pf[sl][4 + i]; }
            { const int row = c.tid >> 3, cc = c.tid & 7; *(LAS u32x4*)(QKs + row * 144 + cc * 16) = pf[sl][6]; } };
        fetch(0, I0{}); stash(I0{}); fetch(1, I1{});
        __syncthreads();
        const int sv = c.tid & 127, spart = c.tid >> 7; LAS float* sqf = (LAS float*)(c.lds + 80000); LAS float* skf = sqf + 128; LAS float* sred = sqf + 256;
        float s0[32]; bf16_t sqk = 0, svv = 0; float seg = 0.f, sbeta = 0.f; int sit = NS * 8;
#pragma unroll
        for (int i = 0; i < 32; ++i) s0[i] = 0.f;
        auto chunk = [&](int n, auto PAR) { constexpr int par = decltype(PAR)::value;
            const int r0 = b * SEQL + n * 64;
            f32x4 acc = put[par]; const float gl = pgl[par];
            if (n + 2 < 32) fetch(n + 2, PAR);
#pragma unroll
            for (int ks = 0; ks < 4; ++ks) acc = MFMA16(*(const LAS bf16x8*)(Ws + (ci * 16 + lr) * 272 + ks * 64 + quad * 16), *(const LAS bf16x8*)(Sts + (vi * 16 + lr) * 272 + ks * 64 + quad * 16), acc);
            { u32x2 wv; wv.x = pk2(acc[0], acc[1]); wv.y = pk2(acc[2], acc[3]); *(LAS u32x2*)(VTs + (vi * 16 + lr) * 144 + (ci * 16 + quad * 4) * 2) = wv; }
            LDS_BAR();
            { const int st3 = n & 7;
                if (st3 == 0) { sit = (it0 == c.bid) ? c.bid + (n >> 3) * c.G : NS * 8;
                    if (sit < NS * 8) { const int s2 = sit >> 3, h2 = sit & 7, row2 = NP + s2;
                        const float* sp = S0 + ((size_t)(s2 * 8 + h2) * 128 + spart * 32) * 128 + sv;
#pragma unroll
                        for (int i = 0; i < 32; ++i) s0[i] = sp[(size_t)i * 128];
                        if (c.tid < 128) sqk = QKVS[(size_t)s2 * D + h2 * 128 + c.tid]; else if (c.tid < 256) sqk = QKVS[(size_t)(NS + s2) * D + h2 * 128 + c.tid - 128];
                        svv = QKVS[(size_t)(2 * NS + s2) * D + h2 * 128 + sv]; seg = __expf(GB[(size_t)row2 * 16 + h2]); sbeta = GB[(size_t)row2 * 16 + 8 + h2]; } }
                else if (st3 == 1 && sit < NS * 8) { float ksum = 0.f, qsum = 0.f, qk = 0.f;
#pragma unroll
                    for (int i = 0; i < 32; ++i) { const float kk = skf[spart * 32 + i], qq = sqf[spart * 32 + i]; ksum += kk * s0[i]; qsum += qq * s0[i]; qk += qq * kk; }
                    sred[spart * 128 + sv] = ksum; sred[512 + spart * 128 + sv] = qsum; sred[1024 + spart * 128 + sv] = qk; }
                else if (st3 == 2 && sit < NS * 8) { const int s2 = sit >> 3, h2 = sit & 7, row2 = NP + s2;
                    const float ksum = sred[sv] + sred[128 + sv] + sred[256 + sv] + sred[384 + sv], qsum = sred[512 + sv] + sred[640 + sv] + sred[768 + sv] + sred[896 + sv], qk = sred[1024 + sv] + sred[1152 + sv] + sred[1280 + sv] + sred[1408 + sv];
                    const float vn = sbeta * (bf2f(svv) - seg * ksum);
                    if (spart == 0) O[(size_t)row2 * D + h2 * 128 + sv] = seg * qsum + qk * vn;
                    float* so = sS + ((size_t)(s2 * 8 + h2) * 128 + spart * 32) * 128 + sv;
#pragma unroll
                    for (int i = 0; i < 32; ++i) so[(size_t)i * 128] = seg * s0[i] + skf[spart * 32 + i] * vn; } }
            f32x4 ao = {0.f, 0.f, 0.f, 0.f};
#pragma unroll
            for (int ks = 0; ks < 4; ++ks) ao = MFMA16(*(const LAS bf16x8*)(Qs + (ci * 16 + lr) * 272 + ks * 64 + quad * 16), *(const LAS bf16x8*)(Sts + (vi * 16 + lr) * 272 + ks * 64 + quad * 16), ao);
#pragma unroll
            for (int ks = 0; ks < 2; ++ks) ao = MFMA16(*(const LAS bf16x8*)(QKs + (ci * 16 + lr) * 144 + ks * 64 + quad * 16), *(const LAS bf16x8*)(VTs + (vi * 16 + lr) * 144 + ks * 64 + quad * 16), ao);
#pragma unroll
            for (int jj = 0; jj < 4; ++jj) O[(size_t)(r0 + ci * 16 + quad * 4 + jj) * D + h * 128 + cb * 32 + vi * 16 + lr] = ao[jj];
#pragma unroll
            for (int v2 = 0; v2 < 2; ++v2) { Sacc[v2] = Sacc[v2] * gl;
#pragma unroll
                for (int ks = 0; ks < 2; ++ks) Sacc[v2] = MFMA16(*(const LAS bf16x8*)(KTs + (w * 16 + lr) * 144 + ks * 64 + quad * 16), *(const LAS bf16x8*)(VTs + (v2 * 16 + lr) * 144 + ks * 64 + quad * 16), Sacc[v2]); }
            LDS_BAR();
            if ((n & 7) == 0 && sit < NS * 8 && c.tid < 256) sqf[c.tid] = bf2f(sqk);
#pragma unroll
            for (int v2 = 0; v2 < 2; ++v2) { u32x2 wv; wv.x = pk2(Sacc[v2][0], Sacc[v2][1]); wv.y = pk2(Sacc[v2][2], Sacc[v2][3]); *(LAS u32x2*)(Sts + (v2 * 16 + lr) * 272 + (w * 16 + quad * 4) * 2) = wv; }
            if (n + 1 < 32) stash(std::integral_constant<int, par ^ 1>{});
            LDS_BAR();
        };
#pragma unroll 1
        for (int n = 0; n < 32; n += 2) { chunk(n, I0{}); chunk(n + 1, I1{}); }
#pragma unroll
        for (int v2 = 0; v2 < 2; ++v2)
#pragma unroll
            for (int jj = 0; jj < 4; ++jj) pS[((size_t)bh * 128 + w * 16 + quad * 4 + jj) * 128 + cb * 32 + v2 * 16 + lr] = Sacc[v2][jj];
        __syncthreads();
    }
    LAS float* qf = (LAS float*)c.lds; LAS float* kf = qf + 128; LAS float* red = qf + 256;
    for (int it = (c.bid < 256 ? c.bid + 4 * c.G : c.bid); it < NS * 8; it += c.G) {
        const int s = it >> 3, h = it & 7, row = NP + s, v = c.tid & 127, part = c.tid >> 7;
        __syncthreads();
        if (c.tid < 128) qf[c.tid] = bf2f(QKVS[(size_t)s * D + h * 128 + c.tid]); else if (c.tid < 256) kf[c.tid - 128] = bf2f(QKVS[(size_t)(NS + s) * D + h * 128 + c.tid - 128]);
        __syncthreads();
        const float eg = __expf(GB[(size_t)row * 16 + h]), beta = GB[(size_t)row * 16 + 8 + h];
        const float* sp = S0 + ((size_t)(s * 8 + h) * 128 + part * 32) * 128 + v;
        float s0[32], ksum = 0.f, qsum = 0.f, qk = 0.f;
#pragma unroll
        for (int i = 0; i < 32; ++i) { s0[i] = sp[(size_t)i * 128]; const float kk = kf[part * 32 + i], qq = qf[part * 32 + i]; ksum += kk * s0[i]; qsum += qq * s0[i]; qk += qq * kk; }
        red[part * 128 + v] = ksum; red[512 + part * 128 + v] = qsum; red[1024 + part * 128 + v] = qk;
        __syncthreads();
        ksum = red[v] + red[128 + v] + red[256 + v] + red[384 + v]; qsum = red[512 + v] + red[640 + v] + red[768 + v] + red[896 + v]; qk = red[1024 + v] + red[1152 + v] + red[1280 + v] + red[1408 + v];
        const float vv = bf2f(QKVS[(size_t)(2 * NS + s) * D + h * 128 + v]); const float vn = beta * (vv - eg * ksum);
        if (part == 0) O[(size_t)row * D + h * 128 + v] = eg * qsum + qk * vn;
        float* so = sS + ((size_t)(s * 8 + h) * 128 + part * 32) * 128 + v;
#pragma unroll
        for (int i = 0; i < 32; ++i) so[(size_t)i * 128] = eg * s0[i] + kf[part * 32 + i] * vn;
    }
}
DI void gdn_post_phase(const Ctx& c, const float* O, const bf16_t* GATE, const float* ng, bf16_t* OG) {
    for (int row = c.bid * 8 + c.wave; row < NR; row += c.G * 8) {
#pragma unroll
        for (int pass = 0; pass < 2; ++pass) { const int col = pass * 512 + c.lane * 8, dv = (c.lane & 15) * 8;
            const f32x4 a = *(const f32x4*)(O + (size_t)row * D + col), b2 = *(const f32x4*)(O + (size_t)row * D + col + 4); float f[8] = {a.x, a.y, a.z, a.w, b2.x, b2.y, b2.z, b2.w}, g[8];
            float ss = 0.f;
#pragma unroll
            for (int e = 0; e < 8; ++e) ss += f[e] * f[e];
            ss += __shfl_xor(ss, 1); ss += __shfl_xor(ss, 2); ss += __shfl_xor(ss, 4); ss += __shfl_xor(ss, 8);
            const float rstd = rsqrtf(ss * (1.0f / 128.0f) + EPS);
            unpack8(*(const u32x4*)(GATE + (size_t)row * D + col), g);
#pragma unroll
            for (int e = 0; e < 8; ++e) f[e] = f[e] * rstd * ng[dv + e] * siluf_(g[e]);
            *(u32x4*)(OG + (size_t)row * D + col) = pack8(f); }
    }
}
DI void ssd_conv_phase(const Ctx& c, const bf16_t* P, const float* cw, const float* cb, const float* st  , const float* DTR, const float* dt_bias,
                       bf16_t* BM, bf16_t* CM, bf16_t* XSN, float* DT, bf16_t* XST, bf16_t* BMT, float* pout, float* sout) {
    for (int wt = c.bid * 8 + c.wave; wt < (NP / 8) * 6; wt += c.G * 8) {
        const int seg = wt % 6, rb = wt / 6, r0 = rb * 8, ch = seg * 512 + c.lane * 8, bn = rb >> 3, s8 = rb & 7; float o[8][8]; u32x4 raw[11];
        conv8_slide(P + ch, 3072, r0, cw, cb, 3072, ch, o, raw);
#pragma unroll
        for (int t = 0; t < 8; ++t)
#pragma unroll
            for (int e = 0; e < 8; ++e) o[t][e] = siluf_(o[t][e]);
        if (seg >= 4) { bf16_t* dst = (seg == 4 ? BM : CM) + c.lane * 8;
#pragma unroll
            for (int t = 0; t < 8; ++t) *(u32x4*)(dst + (size_t)(r0 + t) * 512) = pack8(o[t]); }
        if (seg <= 4) { bf16_t* dst = seg < 4 ? XST + ((size_t)bn * 2048 + ch) * 64 + s8 * 8 : BMT + ((size_t)bn * 512 + c.lane * 8) * 64 + s8 * 8;
#pragma unroll
            for (int e = 0; e < 8; ++e) { const float col[8] = {o[0][e], o[1][e], o[2][e], o[3][e], o[4][e], o[5][e], o[6][e], o[7][e]}; *(u32x4*)(dst + (size_t)e * 64) = pack8(col); } }
    }
    for (int row = NP + c.bid * 8 + c.wave; row < NR; row += c.G * 8) {
        const float* sp = st + (size_t)(row - NP) * 3 * 3072;
#pragma unroll 1
        for (int pass = 0; pass < 6; ++pass) {
            const int ch = pass * 512 + c.lane * 8; float f[8], cur[8];
            conv8(P + ch, 3072, row, -1, sp, 3072, cw, cb, ch, f, cur);
            conv_state8(row, -1, cur, sp, 3072, ch, pout, sout);
#pragma unroll
            for (int e = 0; e < 8; ++e) f[e] = siluf_(f[e]);
            if (pass < 4) *(u32x4*)(XSN + (size_t)(row - NP) * 2048 + ch) = pack8(f);
            else if (pass == 4) *(u32x4*)(BM + (size_t)row * 512 + c.lane * 8) = pack8(f);
            else *(u32x4*)(CM + (size_t)row * 512 + c.lane * 8) = pack8(f);
        }
    }
    for (int i = c.bid * 512 + c.tid; i < NR * 32; i += c.G * 512) DT[i] = softplusf_(DTR[i] + dt_bias[i & 31]);
    prompt_conv_state(c, P, 3072, 3072, pout);
}
DI void ssd_seq_phase(const Ctx& c, const bf16_t* XST, const bf16_t* BM, const bf16_t* CM, const bf16_t* BMT, const float* DT, const float* A_log, const float* Dsk, bf16_t* Y, float* pH,
                      const bf16_t* XSN, const float* H0, float* sH) {
    const int lr = c.lane & 15, quad = c.lane >> 4, w = c.wave;
    ldsp Cs = c.lds, Bs = c.lds + 17408, BTs = c.lds + 34816, XTs = c.lds + 53248, XDs = c.lds + 62464, XRs = c.lds + 71680, Ms = c.lds + 80896, Hs = c.lds + 90112;
    LAS float* DTs = (LAS float*)(c.lds + 107520); LAS float* ACs = DTs + 64;
    for (int it0 = c.bid; it0 < 256; it0 += c.G) {
        const int pr = (it0 & 7) * 4 + (it0 >> 6), b = pr >> 2, g = pr & 3, hd = g * 8 + ((it0 >> 3) & 7), item = b * 32 + hd; const float A = -__expf(A_log[hd]), Dk = Dsk[hd];
        f32x4 hacc[4];
#pragma unroll
        for (int i = 0; i < 4; ++i) hacc[i] = (f32x4){0.f, 0.f, 0.f, 0.f};
        __syncthreads();
        for (int i = c.tid; i < 17408 / 4; i += 512) ((LAS unsigned*)Hs)[i] = 0u;
        u32x4 pC[2], pB[2], pT[2], pX; float pdt = 0.f;
        auto fetch = [&](int n) { const int bn = b * 32 + n, r0 = b * SEQL + n * 64;
            if (c.tid < 64) pdt = DT[(size_t)(r0 + c.tid) * 32 + hd];
#pragma unroll
            for (int i = 0; i < 2; ++i) { const int ci = c.tid + i * 512, row = ci >> 4, cc = ci & 15; const size_t go = (size_t)(r0 + row) * 512 + g * 128 + cc * 8; pC[i] = *(const u32x4*)(CM + go); pB[i] = *(const u32x4*)(BM + go); }
#pragma unroll
            for (int i = 0; i < 2; ++i) { const int ci = c.tid + i * 512, row = ci >> 3, cc = ci & 7; pT[i] = *(const u32x4*)(BMT + ((size_t)bn * 512 + g * 128 + row) * 64 + cc * 8); }
            pX = *(const u32x4*)(XST + ((size_t)bn * 2048 + hd * 64 + (c.tid >> 3)) * 64 + (c.tid & 7) * 8); };
        fetch(0);
        const int sp_ = c.tid >> 3, snp = c.tid & 7; LAS float* SBf = (LAS float*)(c.lds + 108032);
        f32x4 shc[4]; bf16_t sbc = 0; float sdt = 0.f, sxv = 0.f; int sit = NS * 32;
#pragma unroll
        for (int i = 0; i < 4; ++i) shc[i] = (f32x4){0.f, 0.f, 0.f, 0.f};
#pragma unroll 1
        for (int n = 0; n < 32; ++n) {
            const int r0 = b * SEQL + n * 64;
            if (c.tid < 64) { const float dt = pdt; float ac = dt * A;
#pragma unroll
                for (int o = 1; o < 64; o <<= 1) { const float v = __shfl_up(ac, o); if (c.lane >= o) ac += v; }
                DTs[c.tid] = dt; ACs[c.tid] = ac; }
#pragma unroll
            for (int i = 0; i < 2; ++i) { const int ci = c.tid + i * 512, row = ci >> 4, cc = ci & 15; *(LAS u32x4*)(Cs + row * 272 + cc * 16) = pC[i]; *(LAS u32x4*)(Bs + row * 272 + cc * 16) = pB[i]; }
#pragma unroll
            for (int i = 0; i < 2; ++i) { const int ci = c.tid + i * 512, row = ci >> 3, cc = ci & 7; *(LAS u32x4*)(BTs + row * 144 + cc * 16) = pT[i]; }
            const int xrow = c.tid >> 3, xcc = c.tid & 7; const u32x4 xraw = pX;
            LDS_BAR();
            if ((n & 1) == 0) {
                sit = (it0 == c.bid) ? c.bid + (n >> 1) * c.G : NS * 32;
                if (sit < NS * 32) { const int s2 = sit >> 5, hd2 = sit & 31, g2 = hd2 >> 3, row2 = NP + s2;
                    if (c.tid < 128) sbc = BM[(size_t)row2 * 512 + g2 * 128 + c.tid]; else if (c.tid < 256) sbc = CM[(size_t)row2 * 512 + g2 * 128 + c.tid - 128];
                    const float* hp = H0 + ((size_t)sit * 64 + sp_) * 128 + snp * 16;
#pragma unroll
                    for (int i = 0; i < 4; ++i) shc[i] = *(const f32x4*)(hp + 4 * i);
                    sdt = DT[(size_t)row2 * 32 + hd2]; sxv = bf2f(XSN[(size_t)s2 * 2048 + hd2 * 64 + sp_]); }
            } else if (sit < NS * 32) { const int s2 = sit >> 5, hd2 = sit & 31, row2 = NP + s2;
                const float ea = __expf(-sdt * __expf(A_log[hd2])), Dk2 = Dsk[hd2], xdt = sxv * sdt;
                float* ho = sH + ((size_t)sit * 64 + sp_) * 128 + snp * 16; float yo = 0.f, cbp = 0.f;
#pragma unroll
                for (int i = 0; i < 4; ++i) { f32x4 o4;
#pragma unroll
                    for (int e = 0; e < 4; ++e) { const int nn = snp * 16 + 4 * i + e; const float bv = SBf[nn], cv = SBf[128 + nn]; yo += cv * shc[i][e]; cbp += cv * bv; o4[e] = ea * shc[i][e] + xdt * bv; }
                    *(f32x4*)(ho + 4 * i) = o4; }
                yo += __shfl_xor(yo, 1); yo += __shfl_xor(yo, 2); yo += __shfl_xor(yo, 4); cbp += __shfl_xor(cbp, 1); cbp += __shfl_xor(cbp, 2); cbp += __shfl_xor(cbp, 4);
                if (snp == 0) Y[(size_t)row2 * 2048 + hd2 * 64 + sp_] = (bf16_t)f2bf(cbp * xdt + ea * yo + Dk2 * sxv);
            }
            if (n + 1 < 32) fetch(n + 1);
            { float f[8], fd[8]; unpack8(xraw, f); const float al = ACs[63];
#pragma unroll
                for (int e = 0; e < 8; ++e) { const int s = xcc * 8 + e; f[e] *= DTs[s]; fd[e] = f[e] * __expf(al - ACs[s]); }
                *(LAS u32x4*)(XRs + xrow * 144 + xcc * 16) = xraw; *(LAS u32x4*)(XTs + xrow * 144 + xcc * 16) = pack8(f); *(LAS u32x4*)(XDs + xrow * 144 + xcc * 16) = pack8(fd); }
            LDS_BAR();
            const int li = w >> 1; float acl[4];
#pragma unroll
            for (int jj = 0; jj < 4; ++jj) acl[jj] = ACs[li * 16 + quad * 4 + jj];
            f32x4 aoff[2];
#pragma unroll
            for (int q2 = 0; q2 < 2; ++q2) { const int sj = 2 * (w & 1) + q2;
                if (sj <= li) { f32x4 a = {0.f, 0.f, 0.f, 0.f};
#pragma unroll
                    for (int ks = 0; ks < 4; ++ks) a = MFMA16(*(const LAS bf16x8*)(Cs + (li * 16 + lr) * 272 + ks * 64 + quad * 16), *(const LAS bf16x8*)(Bs + (sj * 16 + lr) * 272 + ks * 64 + quad * 16), a);
                    const int s = sj * 16 + lr; const float as = ACs[s];
#pragma unroll
                    for (int jj = 0; jj < 4; ++jj) { const int l = li * 16 + quad * 4 + jj; *(LAS bf16_t*)(Ms + l * 144 + s * 2) = (bf16_t)f2bf(l >= s ? a[jj] * __expf(acl[jj] - as) : 0.f); }
                } else {
#pragma unroll
                    for (int jj = 0; jj < 4; ++jj) *(LAS bf16_t*)(Ms + (li * 16 + quad * 4 + jj) * 144 + (sj * 16 + lr) * 2) = 0;
                }
                const int pj = 2 * (w & 1) + q2; f32x4 a2 = {0.f, 0.f, 0.f, 0.f};
#pragma unroll
                for (int ks = 0; ks < 4; ++ks) a2 = MFMA16(*(const LAS bf16x8*)(Cs + (li * 16 + lr) * 272 + ks * 64 + quad * 16), *(const LAS bf16x8*)(Hs + (pj * 16 + lr) * 272 + ks * 64 + quad * 16), a2);
                aoff[q2] = a2; }
            LDS_BAR();
#pragma unroll
            for (int q2 = 0; q2 < 2; ++q2) { const int pj = 2 * (w & 1) + q2; f32x4 a = {0.f, 0.f, 0.f, 0.f};
#pragma unroll
                for (int ks = 0; ks < 2; ++ks) a = MFMA16(*(const LAS bf16x8*)(Ms + (li * 16 + lr) * 144 + ks * 64 + quad * 16), *(const LAS bf16x8*)(XTs + (pj * 16 + lr) * 144 + ks * 64 + quad * 16), a);
                const u32x2 xr = *(const LAS u32x2*)(XRs + (pj * 16 + lr) * 144 + (li * 16 + quad * 4) * 2); const float xv[4] = {lo16(xr.x), hi16(xr.x), lo16(xr.y), hi16(xr.y)};
#pragma unroll
                for (int jj = 0; jj < 4; ++jj) { const float yv = a[jj] + __expf(acl[jj]) * aoff[q2][jj] + Dk * xv[jj];
                    Y[(size_t)(r0 + li * 16 + quad * 4 + jj) * 2048 + hd * 64 + pj * 16 + lr] = (bf16_t)f2bf(yv); } }
            { const float cd = __expf(ACs[63]);
#pragma unroll
                for (int pj = 0; pj < 4; ++pj) { hacc[pj] = hacc[pj] * cd;
#pragma unroll
                    for (int ks = 0; ks < 2; ++ks) hacc[pj] = MFMA16(*(const LAS bf16x8*)(BTs + (w * 16 + lr) * 144 + ks * 64 + quad * 16), *(const LAS bf16x8*)(XDs + (pj * 16 + lr) * 144 + ks * 64 + quad * 16), hacc[pj]); } }
            LDS_BAR();
#pragma unroll
            for (int pj = 0; pj < 4; ++pj) { u32x2 wv; wv.x = pk2(hacc[pj][0], hacc[pj][1]); wv.y = pk2(hacc[pj][2], hacc[pj][3]); *(LAS u32x2*)(Hs + (pj * 16 + lr) * 272 + (w * 16 + quad * 4) * 2) = wv; }
            if ((n & 1) == 0 && sit < NS * 32 && c.tid < 256) SBf[c.tid] = bf2f(sbc);
        }
#pragma unroll
        for (int pj = 0; pj < 4; ++pj) *(f32x4*)(pH + ((size_t)item * 64 + pj * 16 + lr) * 128 + w * 16 + quad * 4) = hacc[pj];
    }
    LAS float* Bf = (LAS float*)c.lds; LAS float* Cf = Bf + 128;
    {
        const int p = c.tid >> 3, np = c.tid & 7;
        f32x4 hn[4];
        const int it0 = c.bid < 256 ? c.bid + 16 * c.G : c.bid;
        if (it0 < NS * 32) { const float* hp = H0 + ((size_t)it0 * 64 + p) * 128 + np * 16;
#pragma unroll
            for (int i = 0; i < 4; ++i) hn[i] = *(const f32x4*)(hp + 4 * i); }
#pragma unroll 1
        for (int it = it0; it < NS * 32; it += c.G) {
            const int s = it >> 5, hd = it & 31, g = hd >> 3, row = NP + s;
            f32x4 hc[4];
#pragma unroll
            for (int i = 0; i < 4; ++i) hc[i] = hn[i];
            if (it + c.G < NS * 32) { const float* hp = H0 + ((size_t)(it + c.G) * 64 + p) * 128 + np * 16;
#pragma unroll
                for (int i = 0; i < 4; ++i) hn[i] = *(const f32x4*)(hp + 4 * i); }
            __syncthreads();
            if (c.tid < 128) Bf[c.tid] = bf2f(BM[(size_t)row * 512 + g * 128 + c.tid]); else if (c.tid < 256) Cf[c.tid - 128] = bf2f(CM[(size_t)row * 512 + g * 128 + c.tid - 128]);
            const float dt = DT[(size_t)row * 32 + hd], ea = __expf(-dt * __expf(A_log[hd])), Dk = Dsk[hd];
            const float xv = bf2f(XSN[(size_t)s * 2048 + hd * 64 + p]), xdt = xv * dt;
            __syncthreads();
            float* ho = sH + ((size_t)it * 64 + p) * 128 + np * 16;
            float yo = 0.f, cbp = 0.f;
#pragma unroll
            for (int i = 0; i < 4; ++i) { f32x4 o4;
#pragma unroll
                for (int e = 0; e < 4; ++e) { const int nn = np * 16 + 4 * i + e; const float bv = Bf[nn], cv = Cf[nn]; yo += cv * hc[i][e]; cbp += cv * bv; o4[e] = ea * hc[i][e] + xdt * bv; }
                *(f32x4*)(ho + 4 * i) = o4; }
            yo += __shfl_xor(yo, 1); yo += __shfl_xor(yo, 2); yo += __shfl_xor(yo, 4); cbp += __shfl_xor(cbp, 1); cbp += __shfl_xor(cbp, 2); cbp += __shfl_xor(cbp, 4);
            if (np == 0) Y[(size_t)row * 2048 + hd * 64 + p] = (bf16_t)f2bf(cbp * xdt + ea * yo + Dk * xv);
        }
    }
}
DI void ssd_post_phase(const Ctx& c, const bf16_t* Y, const bf16_t* ZB, const float* ng, bf16_t* YN) {
    for (int row = c.bid * 8 + c.wave; row < NR; row += c.G * 8) {
#pragma unroll
        for (int gi = 0; gi < 4; ++gi) { const int col = gi * 512 + c.lane * 8; float y[8], z[8];
            unpack8(*(const u32x4*)(Y + (size_t)row * 2048 + col), y); unpack8(*(const u32x4*)(ZB + (size_t)row * 2048 + col), z);
            float ss = 0.f;
#pragma unroll
            for (int e = 0; e < 8; ++e) { y[e] *= siluf_(z[e]); ss += y[e] * y[e]; }
            const float rstd = rsqrtf(wave_sum(ss) * (1.0f / 512.0f) + EPS);
#pragma unroll
            for (int e = 0; e < 8; ++e) y[e] = y[e] * rstd * ng[col + e];
            *(u32x4*)(YN + (size_t)row * 2048 + col) = pack8(y); }
    }
}
template <class Epi> DI void run_gemm(const Ctx& c, const bf16_t* A, int lda, const bf16_t* Bt, int ldb, int M, int N, int K, int ksh, int kmul, const Epi& E, int kmulb = 0, int bmask = 0x7fffffff) {
    asm volatile("" : "+s"(K));
    pg8::Gemm g{A, Bt, M, N, K, lda, ldb, ksh, kmul, kmulb, bmask, M == RP ? NP / 256 : (1 << 30)}; pg8::StaticOrder S; S.init(M, N, c.G, c.bid);
    pg8::gemm_phase<Epi, pg8::StaticOrder>(c.lds, g, S, E, c.tid);
}
DI void res_gemm(const Ctx& c, const bf16_t* A, const bf16_t* Bt, int K, const float* bp, float* X, const float* gate, const float* nsc, const float* nsh, bf16_t* UB, float* xs, unsigned* cnt) {
    if (nsc != nullptr) { EpiResNorm E{bp, X, gate, nsc, nsh, UB, xs, cnt}; run_gemm(c, A, K, Bt, K, NP, 1024, K, 0, 0, E); }
    else { EpiRes E{bp, X + (size_t)NP * D, X, gate}; run_gemm(c, A, K, Bt, K, NP, 1024, K, 0, 0, E); }
    { EpiResAtomic E{X, gate}; run_gemm(c, A + (size_t)NP * K, K, Bt, K, 256, 4 * K, 256, 2, 256, E, 256, 3); }
}
#define B_X ((float*)(ws + WS_X))
#define B_UB ((bf16_t*)(ws + WS_UB))
#define B_P ((bf16_t*)(ws + WS_P))
#define B_S (ws + WS_S)
#define B_MOD ((float*)(ws + WS_MOD))
#define B_MODL (B_MOD + (size_t)L * NSEQ * MODW)
#define B_XP (L == 0 ? GIN(0) : (const float*)B_X)
#define B_XS (L == 0 ? GIN(1) : (const float*)(B_X + (size_t)NP * D))
#define B_XB ((bf16_t*)B_S)
#define B_LA ((float*)(B_S + (size_t)RP * 1024 * 2))
#define B_BX ((float*)(B_S + (size_t)RP * 1024 * 6))
#define B_Q ((bf16_t*)B_S)
#define B_K (B_Q + (size_t)RP * D)
#define B_V (B_Q + (size_t)2 * RP * D)
#define B_GATE (B_Q + (size_t)3 * RP * D)
#define B_QKG (B_Q + (size_t)4 * RP * D)
#define B_AB ((float*)(ws + WS_AB))
#define B_GB ((float*)(ws + WS_GB))
#define B_GL ((float*)(ws + WS_GL))
#define B_QKVS ((bf16_t*)(ws + WS_QKVS))
#define B_UT ((float*)B_P)
#define B_NW ((bf16_t*)(ws + WS_P + (size_t)NP * D * 4))
#define B_QD (B_NW + (size_t)NP * D)
#define B_KDT (B_NW + (size_t)2 * NP * D)
#define B_OF ((float*)B_S)
#define B_XST ((bf16_t*)B_S)
#define B_BM (B_XST + (size_t)NP * 2048)
#define B_CM (B_BM + (size_t)RP * 512)
#define B_BMT (B_CM + (size_t)RP * 512)
#define B_ZB (B_P + (size_t)RP * 3072)
#define B_YN ((bf16_t*)B_S)
#define B_DTR ((float*)(ws + WS_DTR))
#define B_DT ((float*)(ws + WS_DT))
#define B_XSN ((bf16_t*)(ws + WS_XSN))
__global__ void __launch_bounds__(512, 2) mega(Args a) {
    extern __shared__ __attribute__((aligned(16))) unsigned char lds_raw[];
    cg::grid_group grid = cg::this_grid();
    Ctx c0; c0.lds = (ldsp)lds_raw; c0.tid = threadIdx.x; c0.lane = c0.tid & 63; c0.wave = __builtin_amdgcn_readfirstlane(c0.tid >> 6); c0.bid = blockIdx.x; c0.G = gridDim.x;
    int ph = 0; const int lo = a.lo, hi = a.hi;
    volatile LAS unsigned* bst = (volatile LAS unsigned*)(c0.lds + 131072);
    if (c0.tid < 2) bst[c0.tid] = 0u;
    __syncthreads();
    XcdBarrier xbar; xbar.bar = (unsigned*)(a.ws + WS_BAR); xbar.x = 0; xbar.st = bst;
#ifndef REPMASK
#define REPMASK 0ull
#endif
#ifndef SYNCREP
#define SYNCREP 1
#endif
#define PH_BEGIN if (ph >= lo && ph < hi) { const int nrep_ = ((REPMASK >> ph) & 1ull) ? 2 : 1; for (int rep_ = 0; rep_ < nrep_; ++rep_) { if (rep_) xcd_barrier(xbar); const __attribute__((address_space(4))) Args* ap_ = (const __attribute__((address_space(4))) Args*)__builtin_amdgcn_kernarg_segment_ptr(); asm volatile("" : "+s"(ap_)); const __attribute__((address_space(4))) Args& a = *ap_; Ctx c = c0; GAS unsigned char* wsg_ = (GAS unsigned char*)a.ws; GAS float* outg_ = (GAS float*)a.out; asm volatile("" : "+s"(wsg_)); asm volatile("" : "+s"(outg_)); unsigned char* ws = (unsigned char*)wsg_; float* out = (float*)outg_; { int t_ = c0.tid; asm volatile("" : "+v"(t_)); asm volatile("" : "+s"(c.G)); asm volatile("" : "+s"(c.bid)); c.tid = t_; c.lane = t_ & 63; c.wave = __builtin_amdgcn_readfirstlane(t_ >> 6); } (void)out;
#define PH_END } if (ph + 1 < hi) { for (int s_ = 0; s_ < SYNCREP; ++s_) { if (ph == 0) { if (s_ == 0) { grid.sync(); xbar = xcd_barrier_post((unsigned*)(a.ws + WS_BAR), bst); } } else xcd_barrier(xbar); } } } ++ph;

    PH_BEGIN prep_phase(c, a, true);
#ifdef PREP2
    __syncthreads(); prep_phase(c, a, false);
#endif
    PH_END
    PH_BEGIN { EpiMod E{B_MOD, GIN(11)}; run_gemm(c, (const bf16_t*)(ws + WS_SC), 1024, B_P, 1024, 256, 4 * MODW, 1024, 0, 0, E); } PH_END
#pragma unroll 1
    for (int L = 0; L < 4; ++L) {
        const int kind = L % 3, j = L / 3;
        PH_BEGIN norm_mod_phase(c, B_XP, B_XS, B_MODL + 1024, B_MODL, B_UB, (L > 0 && c.G == 256) ? NP : 0); PH_END
        PH_BEGIN {
            EpiSplit E; const bf16_t* Bt; int N;
            if (kind == 0) { E = EpiSplit{1, B_P, 2048, 1024, B_P + 1024, 2048, 2048, nullptr, 0, 0}; Bt = (const bf16_t*)(ws + WS_RGIN) + (size_t)j * 2048 * 1024; N = 2048; }
            else if (kind == 1) { E = EpiSplit{0, B_P, 3072, 3072, B_GATE, 1024, 4096, B_AB, 16, 16}; Bt = (const bf16_t*)(ws + WS_GDNIN); N = GDN_NP; }
            else { E = EpiSplit{0, B_ZB, 2048, 2048, B_P, 3072, 5120, B_DTR, 32, 32}; Bt = (const bf16_t*)(ws + WS_SSDIN); N = SSD_NP; }
            run_gemm(c, B_UB, 1024, Bt, 1024, RP, N, 1024, 0, 0, E); } PH_END
        if (kind == 0) {
            PH_BEGIN rg_conv_phase(c, B_P, GIN(16) + j * 4 * D, GIN(17) + j * D, GIN(2) + (size_t)j * NS * 3 * D, B_XB, out + O_PRGC + j * 8 * 3 * D, out + O_SRGC + j * NS * 3 * D); PH_END
            PH_BEGIN { EpiGate E{B_XB, GIN(19) + j * 2 * D, (const float*)(ws + WS_LS8) + j * D, B_LA, B_BX}; run_gemm(c, B_XB, 1024, (const bf16_t*)(ws + WS_RGGATE) + (size_t)j * 2048 * 256, 256, RP, 2048, 256, 1, 256, E); } PH_END
            PH_BEGIN rg_scan_phase(c, B_LA, B_BX, B_P, GIN(3) + (size_t)j * NS * D, B_UB, out + O_PRGH + j * 8 * D, out + O_SRGH + j * NS * D); PH_END
        } else if (kind == 1) {
            PH_BEGIN gdn_conv_phase(c, B_P, GIN(23), GIN(4), B_AB, GIN(24), GIN(25), B_Q, B_K, B_V, B_QKVS, B_GB, out + O_PGDC, out + O_SGDC); PH_END
            PH_BEGIN gdn_prep_phase(c, B_Q, B_K, B_V, B_GB, B_UT, B_NW, B_QD, B_KDT, B_QKG, B_GL); PH_END
            PH_BEGIN gdn_seq_phase(c, B_UT, B_NW, B_QD, B_KDT, B_QKG, B_GL, B_OF, out + O_PGDS, B_QKVS, B_GB, GIN(5), out + O_SGDS); PH_END
            PH_BEGIN gdn_post_phase(c, B_OF, B_GATE, GIN(26), B_UB); PH_END
        } else {
            PH_BEGIN ssd_conv_phase(c, B_P, GIN(29), GIN(30), GIN(6), B_DTR, GIN(32), B_BM, B_CM, B_XSN, B_DT, B_XST, B_BMT, out + O_PSSC, out + O_SSSC); PH_END
            PH_BEGIN ssd_seq_phase(c, B_XST, B_BM, B_CM, B_BMT, B_DT, GIN(31), GIN(33), B_P, out + O_PSSH, B_XSN, GIN(7), out + O_SSSH); PH_END
            PH_BEGIN ssd_post_phase(c, B_P, B_ZB, GIN(34), B_YN); PH_END
        }
        PH_BEGIN {
            const bf16_t* oA = kind == 2 ? B_YN : B_UB; const int oK = kind == 2 ? 2048 : 1024;
            const bf16_t* oB = kind == 0 ? (const bf16_t*)(ws + WS_RGOUT) + (size_t)j * 1024 * 1024 : (kind == 1 ? (const bf16_t*)(ws + WS_GDNOUT) : (const bf16_t*)(ws + WS_SSDOUT));
            const bool fuse = c.G == 256;
            res_gemm(c, oA, oB, oK, B_XP, B_X, B_MODL + 2048, fuse ? B_MODL + 4 * 1024 : nullptr, B_MODL + 3 * 1024, B_UB, (float*)(ws + WS_XS), (unsigned*)(ws + WS_CNT) + (size_t)(2 * L) * 4096); } PH_END
        PH_BEGIN norm_mod_phase(c, B_X, B_X + (size_t)NP * D, B_MODL + 4 * 1024, B_MODL + 3 * 1024, B_UB, c.G == 256 ? NP : 0); PH_END
        PH_BEGIN { EpiSplit E{2, B_P, 4096, 4096, nullptr, 0, 4096, nullptr, 0, 0}; run_gemm(c, B_UB, 1024, (const bf16_t*)(ws + WS_WUP) + (size_t)L * 4096 * 1024, 1024, RP, 4096, 1024, 0, 0, E); } PH_END
        PH_BEGIN { const bool fuse = c.G == 256 && L < 3; const float* modN = B_MOD + (size_t)(L + 1) * NSEQ * MODW;
            res_gemm(c, B_P, (const bf16_t*)(ws + WS_WDN) + (size_t)L * 4096 * 1024, 4096, B_X, B_X, B_MODL + 5 * 1024, fuse ? modN + 1024 : nullptr, modN, B_UB, (float*)(ws + WS_XS), (unsigned*)(ws + WS_CNT) + (size_t)(2 * L + 1) * 4096); } PH_END
    }
    PH_BEGIN final_norm_phase(c, B_X, GIN(14), out + O_Y); PH_END
}
constexpr int N_PHASES = 40;

extern "C" void kernel_launch(void* const* d_in, const int* in_sizes, int n_in, void* d_out, int out_size, void* d_ws, size_t ws_size, hipStream_t stream) {
    static int grid = 0;
    if (grid == 0) {
        int dev = 0, cus = 0, per_cu = 0;
        (void)hipGetDevice(&dev);
        (void)hipDeviceGetAttribute(&cus, hipDeviceAttributeMultiprocessorCount, dev);
        (void)hipFuncSetAttribute((const void*)mega, hipFuncAttributeMaxDynamicSharedMemorySize, LDS_BYTES);
        (void)hipOccupancyMaxActiveBlocksPerMultiprocessor(&per_cu, (const void*)mega, 512, LDS_BYTES);
        if (per_cu < 1) { fprintf(stderr, "kernel_launch: occupancy query reports %d blocks/CU\n", per_cu); }
        grid = cus > 0 ? cus : 256;
        if (ws_size < WS_END) { fprintf(stderr, "kernel_launch: workspace too small: need %zu, have %zu\n", (size_t)WS_END, ws_size); grid = -1; }
        if (n_in != 36) { fprintf(stderr, "kernel_launch: expected 36 inputs, got %d\n", n_in); grid = -1; }
    }
    if (grid < 0) return;
    Args a{};
    for (int i = 0; i < 36; ++i) a.in[i] = (const float*)d_in[i];
    a.out = (float*)d_out; a.ws = (unsigned char*)d_ws; a.lo = 0; a.hi = N_PHASES;
    void* args[] = {&a};
    hipError_t e = hipLaunchCooperativeKernel((const void*)mega, dim3(grid), dim3(512), args, LDS_BYTES, stream);
    if (e != hipSuccess) fprintf(stderr, "kernel_launch: cooperative launch failed: %s (grid %d)\n", hipGetErrorString(e), grid);
}
```

```cpp
#include <hip/hip_runtime.h>
#include <hip/hip_cooperative_groups.h>
#include <cstdio>
#include <type_traits>
namespace cg = cooperative_groups;

namespace pg8 {
#define PG8_LAS __attribute__((address_space(3)))
typedef unsigned short bf16_t;
typedef short bf16x8 __attribute__((ext_vector_type(8)));
typedef float f32x4 __attribute__((ext_vector_type(4)));
typedef unsigned u32x4 __attribute__((ext_vector_type(4)));
constexpr int BM = 256, BK = 64, HALF = 128, HTB = HALF * BK * 2  , STAGE_BYTES = 8 * HTB, NXCD = 8, WGM = 8;

__host__ __device__ __forceinline__ int lds_byte(int r, int c) { const int st = (r >> 4) * 2 + (c >> 5), rr = r & 15, cc = c & 31, ob = rr * 64 + cc * 2; return st * 1024 + (ob ^ (((ob >> 9) & 1) << 5)); }
__host__ __device__ __forceinline__ void stage_rc(int b, int& R, int& C) { const int st = b / 1024, sb = b % 1024, swz = sb ^ (((sb >> 9) & 1) << 5); R = (st >> 1) * 16 + swz / 64; C = (st & 1) * 32 + (swz % 64) / 2; }
__host__ __device__ __forceinline__ int perm32(int rho) { const int n = rho >> 4, i = rho & 15; return 8 * (i >> 2) + 4 * n + (i & 3); }

struct Unit { int pm, pn; };
struct Gemm { const bf16_t* A; const bf16_t* Bt; int M, N, K, lda, ldb, ksh, kmul, kmulb, bmask; };

struct StaticOrder {
    int nM, nN, nwg, G, c;
    __host__ __device__ void init(int M, int N, int G_, int c_) { nM = M / BM; nN = N / BM; nwg = nM * nN; G = G_; c = c_; }
    __host__ __device__ bool next(int i, Unit& u) const {
        const long L = (long)i * G + c; if (L >= nwg) return false;
        int wgid = (int)L; { const int q = nwg / NXCD, r = nwg % NXCD, xcd = wgid % NXCD, off = wgid / NXCD; wgid = (xcd < r ? xcd * (q + 1) : r * (q + 1) + (xcd - r) * q) + off; }
        const int nig = WGM * nN, gid = wgid / nig, fm = gid * WGM, gsz = (nM - fm) < WGM ? (nM - fm) : WGM;
        u.pm = fm + ((wgid % nig) % gsz); u.pn = (wgid % nig) / gsz; return true;
    }
    __device__ __forceinline__ void a_ready(const Unit&) const {}
    __device__ __forceinline__ void done(const Unit&) const {}
};
__device__ __forceinline__ unsigned cvt_pk_bf16(float lo, float hi) { unsigned r; asm volatile("v_cvt_pk_bf16_f32 %0, %1, %2" : "=v"(r) : "v"(lo), "v"(hi)); return r; }
typedef float f32x2 __attribute__((ext_vector_type(2)));
template <class Epi, class Sched>
__device__ __forceinline__ void gemm_phase(PG8_LAS unsigned char* lds, const Gemm g, const Sched& S, const Epi& E, const int tid_in) {
    const int tid = tid_in, wid = __builtin_amdgcn_readfirstlane(tid >> 6), lane = tid & 63, wr = wid >> 2, wc = wid & 3, fr = lane & 15, fq = lane >> 4;
    const int K = g.K, nt = K / BK;

    unsigned voffA[2], voffB[2];
#pragma unroll
    for (int i = 0; i < 2; ++i) { int R, C; stage_rc(tid * 16 + i * 8192, R, C); const int Rb = Epi::PERM ? ((R & ~31) + perm32(R & 31)) : R;
        voffA[i] = (unsigned)(R * g.lda + C) * 2u; voffB[i] = (unsigned)(Rb * g.ldb + C) * 2u; }
    const size_t kstep = (size_t)(BK * 2);
    const size_t hstepA = (size_t)HALF * g.lda * 2, hstepB = (size_t)HALF * g.ldb * 2;
    const size_t tstepA = 2 * hstepA, tstepB = 2 * hstepB;
    const unsigned ldsw = (unsigned)wid * 1024u;
    const int aoff = lds_byte(wr * 64 + fr, fq * 8), boff = lds_byte(wc * 32 + fr, fq * 8);
#define PG8_SA(b, h) (((b) * 2 + (h)) * HTB)
#define PG8_SB(b, h) ((4 + (b) * 2 + (h)) * HTB)
#define PG8_STAGE(bufoff, gbase, voff) do { _Pragma("unroll") for (int _i = 0; _i < 2; ++_i) \
        __builtin_amdgcn_global_load_lds((const unsigned*)((const char*)(gbase) + (voff)[_i]), (PG8_LAS unsigned*)(lds + (bufoff) + ldsw + _i * 8192), 16, 0, 0); } while (0)
#define PG8_LDA(dst, b, h) do { _Pragma("unroll") for (int m = 0; m < 4; ++m) _Pragma("unroll") for (int k = 0; k < 2; ++k) dst[m][k] = *(const PG8_LAS bf16x8*)(lds + PG8_SA(b, h) + aoff + m * 2048 + k * 1024); } while (0)
#define PG8_LDB(dst, b, h) do { _Pragma("unroll") for (int n = 0; n < 2; ++n) _Pragma("unroll") for (int k = 0; k < 2; ++k) dst[n][k] = *(const PG8_LAS bf16x8*)(lds + PG8_SB(b, h) + boff + n * 2048 + k * 1024); } while (0)
#define PG8_MMA(ai, bj, At, Bt) do { __builtin_amdgcn_s_setprio(1); _Pragma("unroll") for (int m = 0; m < 4; ++m) _Pragma("unroll") for (int n = 0; n < 2; ++n) _Pragma("unroll") for (int k = 0; k < 2; ++k) \
        acc[ai][bj][m][n] = __builtin_amdgcn_mfma_f32_16x16x32_bf16(Bt[n][k], At[m][k], acc[ai][bj][m][n], 0, 0, 0); __builtin_amdgcn_s_setprio(0); } while (0)
#define PG8_WAIT_V(n) asm volatile("s_waitcnt vmcnt(" #n ")" ::: "memory")
#define PG8_WAIT_L(n) asm volatile("s_waitcnt lgkmcnt(" #n ")" ::: "memory")
#define PG8_BAR __builtin_amdgcn_s_barrier()
#define PG8_SCHED __builtin_amdgcn_sched_barrier(0)
    Unit cur, nxt; int ui = 0;
    if (!S.next(0, cur)) return;
    f32x4 acc[2][2][4][2];
#pragma unroll
    for (int a = 0; a < 2; ++a)
#pragma unroll
        for (int b = 0; b < 2; ++b)
#pragma unroll
            for (int m = 0; m < 4; ++m)
#pragma unroll
                for (int n = 0; n < 2; ++n) acc[a][b][m][n] = (f32x4){0.f, 0.f, 0.f, 0.f};
    bf16x8 At[4][2], B0[2][2], B1[2][2];
    const char* cA = (const char*)g.A + (size_t)cur.pm * tstepA + (size_t)((cur.pn >> g.ksh) * g.kmul) * 2; const char* cB = (const char*)g.Bt + (size_t)(cur.pn & g.bmask) * tstepB + (size_t)((cur.pn >> g.ksh) * g.kmulb) * 2;
    S.a_ready(cur);
    PG8_STAGE(PG8_SB(0, 0), cB, voffB); PG8_STAGE(PG8_SA(0, 0), cA, voffA); PG8_STAGE(PG8_SB(0, 1), cB + hstepB, voffB); PG8_STAGE(PG8_SA(0, 1), cA + hstepA, voffA);
    if (wr == 1) PG8_BAR;
    PG8_WAIT_V(4); PG8_BAR;
    PG8_STAGE(PG8_SB(1, 0), cB + kstep, voffB); PG8_STAGE(PG8_SA(1, 0), cA + kstep, voffA); PG8_STAGE(PG8_SB(1, 1), cB + hstepB + kstep, voffB);
    PG8_WAIT_V(6); PG8_BAR;

    for (;;) {
        const bool has_next = S.next(ui + 1, nxt);
        const char* nA = has_next ? (const char*)g.A + (size_t)nxt.pm * tstepA + (size_t)((nxt.pn >> g.ksh) * g.kmul) * 2 : cA; const char* nB = has_next ? (const char*)g.Bt + (size_t)(nxt.pn & g.bmask) * tstepB + (size_t)((nxt.pn >> g.ksh) * g.kmulb) * 2 : cB;
        for (int t = 0; t < nt; t += 2) {
            const bool last = (t == nt - 2);
            const char* a1 = cA + (size_t)(t + 1) * kstep;
            const char* a2 = last ? nA : cA + (size_t)(t + 2) * kstep; const char* b2 = last ? nB : cB + (size_t)(t + 2) * kstep;
            const char* a3 = a2 + kstep; const char* b3 = b2 + kstep;
            if (last && has_next) S.a_ready(nxt);
            PG8_LDB(B0, 0, 0); PG8_SCHED; PG8_LDA(At, 0, 0); PG8_STAGE(PG8_SA(1, 1), a1 + hstepA, voffA);
            PG8_WAIT_L(8); PG8_BAR; PG8_WAIT_L(0); PG8_MMA(0, 0, At, B0); PG8_BAR; PG8_SCHED;
            PG8_LDB(B1, 0, 1); PG8_STAGE(PG8_SB(0, 0), b2, voffB);
            PG8_BAR; PG8_WAIT_L(0); PG8_MMA(0, 1, At, B1); PG8_BAR;
            PG8_LDA(At, 0, 1); PG8_STAGE(PG8_SA(0, 0), a2, voffA);
            PG8_BAR; PG8_WAIT_L(0); PG8_MMA(1, 0, At, B0); PG8_BAR; PG8_SCHED;
            PG8_STAGE(PG8_SB(0, 1), b2 + hstepB, voffB);
            PG8_WAIT_V(6); PG8_BAR; PG8_MMA(1, 1, At, B1); PG8_BAR;
            PG8_LDB(B0, 1, 0); PG8_SCHED; PG8_LDA(At, 1, 0); PG8_STAGE(PG8_SA(0, 1), a2 + hstepA, voffA);
            PG8_WAIT_L(8); PG8_BAR; PG8_WAIT_L(0); PG8_MMA(0, 0, At, B0); PG8_BAR; PG8_SCHED;
            PG8_LDB(B1, 1, 1); PG8_STAGE(PG8_SB(1, 0), b3, voffB);
            PG8_BAR; PG8_WAIT_L(0); PG8_MMA(0, 1, At, B1); PG8_BAR;
            PG8_LDA(At, 1, 1); PG8_STAGE(PG8_SA(1, 0), a3, voffA);
            PG8_BAR; PG8_WAIT_L(0); PG8_MMA(1, 0, At, B0); PG8_BAR; PG8_SCHED;
            PG8_STAGE(PG8_SB(1, 1), b3 + hstepB, voffB);
            PG8_WAIT_V(6); PG8_BAR; PG8_MMA(1, 1, At, B1); PG8_BAR;
        }

        if constexpr (!Epi::AFTER_DRAIN) { E(acc, cur, wr, wc, fr, fq); S.done(cur); }

        if (!has_next) break;
#pragma unroll
        for (int a = 0; a < 2; ++a)
#pragma unroll
            for (int b = 0; b < 2; ++b)
#pragma unroll
                for (int m = 0; m < 4; ++m)
#pragma unroll
                    for (int n = 0; n < 2; ++n) acc[a][b][m][n] = (f32x4){0.f, 0.f, 0.f, 0.f};
        cur = nxt; cA = nA; cB = nB; ++ui;
    }
    PG8_WAIT_V(0);
    if (wr == 0) PG8_BAR;
    PG8_BAR;
    if constexpr (Epi::AFTER_DRAIN) { E.fused(acc, cur, wr, wc, fr, fq, lds, wid, lane); S.done(cur); }

#undef PG8_SA
#undef PG8_SB
#undef PG8_STAGE
#undef PG8_LDA
#undef PG8_LDB
#undef PG8_MMA
#undef PG8_WAIT_V
#undef PG8_WAIT_L
#undef PG8_BAR
#undef PG8_SCHED
}
}
using pg8::bf16_t; using pg8::bf16x8; using pg8::f32x4; using pg8::u32x4; using pg8::f32x2;
typedef unsigned u32x2 __attribute__((ext_vector_type(2)));
#define LAS __attribute__((address_space(3)))
#define GAS __attribute__((address_space(1)))
#define GIN(k) ((const float*)(const GAS float*)a.in[k])
typedef LAS unsigned char* ldsp;
#define DI __device__ __forceinline__
#define LDS_BAR() do { asm volatile("s_waitcnt lgkmcnt(0)" ::: "memory"); __builtin_amdgcn_s_barrier(); asm volatile("" ::: "memory"); } while (0)
#define MFMA16(a, b, c) __builtin_amdgcn_mfma_f32_16x16x32_bf16((a), (b), (c), 0, 0, 0)

constexpr int D = 1024, NP = 16384, NS = 128, NR = NP + NS, RP = 16640, SEQL = 2048, NSEQ = 136, MODW = 6144;
constexpr int GDN_N = 4112, GDN_NP = 4352, SSD_N = 5152, SSD_NP = 5376;
constexpr float EPS = 1e-6f;
constexpr int LDS_BYTES = 132096;
constexpr size_t al256(size_t x) { return (x + 255) & ~(size_t)255; }
constexpr size_t WS_WUP = 0;
constexpr size_t WS_WDN = WS_WUP + (size_t)4 * 4096 * 1024 * 2;
constexpr size_t WS_RGIN = WS_WDN + (size_t)4 * 4096 * 1024 * 2;
constexpr size_t WS_RGGATE = WS_RGIN + (size_t)2 * 2048 * 1024 * 2;
constexpr size_t WS_RGOUT = WS_RGGATE + (size_t)2 * 2048 * 256 * 2;
constexpr size_t WS_GDNIN = WS_RGOUT + (size_t)2 * 1024 * 1024 * 2;
constexpr size_t WS_GDNOUT = WS_GDNIN + (size_t)GDN_NP * 1024 * 2;
constexpr size_t WS_SSDIN = WS_GDNOUT + (size_t)1024 * 1024 * 2;
constexpr size_t WS_SSDOUT = WS_SSDIN + (size_t)SSD_NP * 1024 * 2;
constexpr size_t WS_SC = WS_SSDOUT + (size_t)1024 * 2048 * 2;
constexpr size_t WS_MOD = WS_SC + (size_t)256 * 1024 * 2;
constexpr size_t WS_AB = al256(WS_MOD + (size_t)4 * NSEQ * MODW * 4);
constexpr size_t WS_GB = WS_AB + (size_t)RP * 16 * 4;
constexpr size_t WS_DTR = WS_GB + (size_t)RP * 16 * 4;
constexpr size_t WS_DT = WS_DTR + (size_t)RP * 32 * 4;
constexpr size_t WS_GL = WS_DT + (size_t)RP * 32 * 4;
constexpr size_t WS_XSN = WS_GL + 2048 * 4;
constexpr size_t WS_QKVS = WS_XSN + (size_t)128 * 2048 * 2;
constexpr size_t WS_LS8 = WS_QKVS + (size_t)3 * 128 * 1024 * 2;
constexpr size_t WS_BAR = al256(WS_LS8 + 2 * 1024 * 4);
constexpr size_t WS_XS = al256(WS_BAR + 16384);
constexpr size_t WS_CNT = WS_XS + (size_t)NP * 4 * 4;
constexpr size_t WS_X = al256(WS_CNT + (size_t)8 * 64 * 64 * 4);
constexpr size_t WS_UB = WS_X + (size_t)RP * 1024 * 4;
constexpr size_t WS_P = WS_UB + (size_t)RP * 1024 * 2;
constexpr size_t P_BYTES = (size_t)RP * 5120 * 2;
constexpr size_t WS_S = WS_P + P_BYTES;
constexpr size_t S_BYTES = (size_t)RP * 1024 * 10;
constexpr size_t WS_END = WS_S + S_BYTES;
constexpr int O_Y = 0, O_PRGC = 16908288, O_PRGH = O_PRGC + 49152, O_PGDC = O_PRGH + 16384, O_PGDS = O_PGDC + 73728, O_PSSC = O_PGDS + 1048576, O_PSSH = O_PSSC + 73728,
              O_SRGC = O_PSSH + 2097152, O_SRGH = O_SRGC + 786432, O_SGDC = O_SRGH + 262144, O_SGDS = O_SGDC + 1179648, O_SSSC = O_SGDS + 16777216, O_SSSH = O_SSSC + 1179648;

struct Args { const float* in[36]; float* out; unsigned char* ws; int lo, hi; };
struct Ctx { ldsp lds; int tid, lane, wave, bid, G; };

DI float bf2f(unsigned short b) { return __uint_as_float(((unsigned)b) << 16); }
DI unsigned pk2(float lo, float hi) { typedef float f2_ __attribute__((ext_vector_type(2))); typedef __bf16 b2_ __attribute__((ext_vector_type(2))); const b2_ r = __builtin_convertvector((f2_){lo, hi}, b2_); return __builtin_bit_cast(unsigned, r); }
DI unsigned f2bf(float f) { return pk2(f, f) & 0xffffu; }
DI float lo16(unsigned w) { return __uint_as_float(w << 16); }
DI float hi16(unsigned w) { return __uint_as_float(w & 0xffff0000u); }
DI void unpack8(u32x4 w, float* f) { f[0] = lo16(w.x); f[1] = hi16(w.x); f[2] = lo16(w.y); f[3] = hi16(w.y); f[4] = lo16(w.z); f[5] = hi16(w.z); f[6] = lo16(w.w); f[7] = hi16(w.w); }
DI u32x4 pack8(const float* f) { u32x4 w; w.x = pk2(f[0], f[1]); w.y = pk2(f[2], f[3]); w.z = pk2(f[4], f[5]); w.w = pk2(f[6], f[7]); return w; }
DI float sigmoidf_(float x) { return __builtin_amdgcn_rcpf(1.0f + __expf(-x)); }
DI float siluf_(float x) { return x * __builtin_amdgcn_rcpf(1.0f + __expf(-x)); }
DI float softplusf_(float x) { return x > 20.f ? x : log1pf(__expf(x)); }
DI float gelu_tanh(float x) { const float y = 1.5957691216f * (x + 0.044715f * x * x * x); return x * __builtin_amdgcn_rcpf(1.0f + __expf(-y)); }
DI float wave_sum(float v) {
#pragma unroll
    for (int o = 1; o < 64; o <<= 1) v += __shfl_xor(v, o);
    return v;
}
DI int seq_of(int row) { int q = row < NP ? (row >> 11) : 8 + row - NP; return q > NSEQ - 1 ? NSEQ - 1 : q; }

#define XB_TMO      128
#define XB_XCNT(j)  (256  + 64 * (j))
#define XB_XSUB(j)  (1280 + 64 * (j))
#define XB_XGEN(j)  (2304 + 64 * (j))
#define XB_TOP      3328
#define XB_TOPGEN   3392
#define XCD_BAR_WORDS 3456
#define XB_SPIN_CAP (1u << 18)

__device__ __forceinline__ unsigned xb_ld(unsigned* p)              { return __hip_atomic_load(p, __ATOMIC_RELAXED, __HIP_MEMORY_SCOPE_AGENT); }
__device__ __forceinline__ unsigned xb_add(unsigned* p, unsigned v) { return __hip_atomic_fetch_add(p, v, __ATOMIC_RELAXED, __HIP_MEMORY_SCOPE_AGENT); }
__device__ __forceinline__ unsigned xb_xcc_id() { return (unsigned)__builtin_amdgcn_s_getreg((3 << 11) | 20) & 0xFu; }
#define XB_SPIN(cond, bar) do { unsigned _sp = 0; while (cond) { __builtin_amdgcn_s_sleep(1); \
    if ((++_sp & 255u) == 0u) { if (xb_ld(&(bar)[XB_TMO])) break; if (_sp > XB_SPIN_CAP) { atomicAdd(&(bar)[XB_TMO], 1u); break; } } } } while (0)

struct XcdBarrier {
    unsigned* bar; unsigned x;
    volatile LAS unsigned* st;
};

__device__ __forceinline__ XcdBarrier xcd_barrier_post(unsigned* bar, volatile LAS unsigned* st) {
    XcdBarrier b; b.bar = bar; b.x = xb_xcc_id(); b.st = st;
    if (threadIdx.x == 0) (void)xb_add(&bar[XB_XCNT(b.x)], 1u);
    return b;
}
__device__ __forceinline__ void xcd_barrier_complete(unsigned* bar, unsigned x, unsigned& nloc, unsigned& nx) {
    const unsigned G = gridDim.x * gridDim.y * gridDim.z;
    unsigned sum, cnt, mine, sp = 0u;
    for (;;) {
        sum = 0u; cnt = 0u; mine = 0u;
#pragma unroll
        for (unsigned j = 0; j < 16; ++j) { const unsigned c = xb_ld(&bar[XB_XCNT(j)]); sum += c; cnt += (c > 0u) ? 1u : 0u; mine = (j == x) ? c : mine; }
        if (sum == G) break;
        __builtin_amdgcn_s_sleep(1);
        if ((++sp & 255u) == 0u) { if (xb_ld(&bar[XB_TMO])) break; if (sp > XB_SPIN_CAP) { atomicAdd(&bar[XB_TMO], 1u); break; } }
    }
    nloc = mine > 0u ? mine : 1u; nx = cnt > 0u ? cnt : 1u;
}

__device__ __forceinline__ void xcd_barrier(const XcdBarrier& b) {
    asm volatile("s_waitcnt vmcnt(0)" ::: "memory");
    __syncthreads();
    if (threadIdx.x == 0) {
        unsigned* bar = b.bar;
        __builtin_amdgcn_s_waitcnt(0);
        unsigned nloc = b.st[0], nx = b.st[1];
        if (nloc == 0u) { xcd_barrier_complete(bar, b.x, nloc, nx); b.st[0] = nloc; b.st[1] = nx; }
        const unsigned old = xb_add(&bar[XB_XSUB(b.x)], 1u);
        const unsigned gen = old / nloc;
        if (old + 1u == (gen + 1u) * nloc) {
            __builtin_amdgcn_fence(__ATOMIC_RELEASE, "agent");
            asm volatile("s_waitcnt vmcnt(0)" ::: "memory");
            const unsigned og = xb_add(&bar[XB_TOP], 1u);
            const unsigned tg = og / nx;
            if (og + 1u == (tg + 1u) * nx) xb_add(&bar[XB_TOPGEN], 1u);
            else XB_SPIN(xb_ld(&bar[XB_TOPGEN]) == tg, bar);
            __builtin_amdgcn_fence(__ATOMIC_ACQUIRE, "agent");
            xb_add(&bar[XB_XGEN(b.x)], 1u);
            asm volatile("s_waitcnt vmcnt(0)" ::: "memory");
        } else {
            XB_SPIN(xb_ld(&bar[XB_XGEN(b.x)]) == gen, bar);
            __builtin_amdgcn_fence(__ATOMIC_ACQUIRE, "agent");
            asm volatile("s_waitcnt vmcnt(0)" ::: "memory");
        }
    }
    __syncthreads();
}

struct EpiMod {
    static constexpr bool PERM = false, AFTER_DRAIN = false;
    float* MOD; const float* bias;
    DI void operator()(const f32x4 (&acc)[2][2][4][2], const pg8::Unit& u, int wr, int wc, int fr, int fq) const {
        const int row0 = u.pm * 256 + wr * 64 + fr, col0 = u.pn * 256 + wc * 32 + 4 * fq;
#pragma unroll
        for (int ai = 0; ai < 2; ++ai)
#pragma unroll
            for (int m = 0; m < 4; ++m) { const int row = row0 + ai * 128 + m * 16;
                if (row < NSEQ) {
#pragma unroll
                    for (int bj = 0; bj < 2; ++bj)
#pragma unroll
                        for (int n = 0; n < 2; ++n) { const int col = col0 + bj * 128 + n * 16, layer = col / MODW, c = col - layer * MODW;
                            *(f32x4*)(MOD + ((size_t)layer * NSEQ + row) * MODW + c) = acc[ai][bj][m][n] + *(const f32x4*)(bias + col); } } }
    }
};
struct EpiRes {
    static constexpr bool PERM = false, AFTER_DRAIN = false;
    const float* bp; const float* bs; float* X; const float* gate;
    DI void operator()(const f32x4 (&acc)[2][2][4][2], const pg8::Unit& u, int wr, int wc, int fr, int fq) const {
        const int row0 = u.pm * 256 + wr * 64 + fr, col0 = u.pn * 256 + wc * 32 + 4 * fq;
#pragma unroll
        for (int ai = 0; ai < 2; ++ai)
#pragma unroll
            for (int m = 0; m < 4; ++m) { const int row = row0 + ai * 128 + m * 16;
                if (row < NR) { const float* base = row < NP ? bp + (size_t)row * D : bs + (size_t)(row - NP) * D; const float* gp = gate + (size_t)seq_of(row) * MODW; float* o = X + (size_t)row * D;
#pragma unroll
                    for (int bj = 0; bj < 2; ++bj)
#pragma unroll
                        for (int n = 0; n < 2; ++n) { const int col = col0 + bj * 128 + n * 16;
                            *(f32x4*)(o + col) = *(const f32x4*)(base + col) + *(const f32x4*)(gp + col) * acc[ai][bj][m][n]; } }
                asm volatile("" ::: "memory"); }
    }
};
struct EpiResNorm {
    static constexpr bool PERM = false, AFTER_DRAIN = true;
    const float* bp; float* X; const float* gate; const float* sc; const float* sh; bf16_t* UB; float* xs; unsigned* cnt;
    DI void operator()(const f32x4 (&)[2][2][4][2], const pg8::Unit&, int, int, int, int) const {}
    DI void fused(f32x4 (&acc)[2][2][4][2], const pg8::Unit& u, int wr, int wc, int fr, int fq, PG8_LAS unsigned char* lds, int wid, int lane) const {
        LAS float* Pp = (LAS float*)lds; LAS float* Sr = (LAS float*)(lds + 8192);
        const int row0 = u.pm * 256 + wr * 64 + fr, col0 = u.pn * 256 + wc * 32 + 4 * fq; const int q = (u.pm * 256) >> 11;
        const float* gp = gate + (size_t)q * MODW + col0;
#pragma unroll
        for (int ai = 0; ai < 2; ++ai)
#pragma unroll
            for (int m = 0; m < 4; ++m) { int row = row0 + ai * 128 + m * 16; asm volatile("" : "+v"(row)); const float* base = bp + (size_t)row * D + col0; float* o = X + (size_t)row * D + col0; float s = 0.f;
#pragma unroll
                for (int bj = 0; bj < 2; ++bj)
#pragma unroll
                    for (int n = 0; n < 2; ++n) { const int co = bj * 128 + n * 16; const f32x4 v = *(const f32x4*)(base + co) + *(const f32x4*)(gp + co) * acc[ai][bj][m][n];
                        acc[ai][bj][m][n] = v; *(f32x4*)(o + co) = v; s += (v.x * v.x + v.y * v.y) + (v.z * v.z + v.w * v.w); }
                s += __shfl_xor(s, 16); s += __shfl_xor(s, 32);
                if (fq == 0) Pp[(ai * 128 + wr * 64 + m * 16 + fr) * 4 + wc] = s;
                asm volatile("" ::: "memory"); }
        asm volatile("s_waitcnt lgkmcnt(0)" ::: "memory"); __builtin_amdgcn_s_barrier(); asm volatile("" ::: "memory");
        const int prow = wid * 32 + (lane & 31);
        if (lane < 32) { const float t = (Pp[prow * 4 + 0] + Pp[prow * 4 + 1]) + (Pp[prow * 4 + 2] + Pp[prow * 4 + 3]);
            __hip_atomic_store(xs + ((size_t)(u.pm * 256 + prow) * 4 + u.pn), t, __ATOMIC_RELAXED, __HIP_MEMORY_SCOPE_AGENT); }
        asm volatile("s_waitcnt vmcnt(0)" ::: "memory");
        if (lane == 0) __hip_atomic_fetch_add(cnt + 64 * u.pm, 1u, __ATOMIC_RELAXED, __HIP_MEMORY_SCOPE_AGENT);
        if (wid == 0) { unsigned spins = 0;
            while ((unsigned)__builtin_amdgcn_readfirstlane(__hip_atomic_load(cnt + 64 * u.pm, __ATOMIC_RELAXED, __HIP_MEMORY_SCOPE_AGENT)) < 32u) { __builtin_amdgcn_s_sleep(2); if (++spins > (1u << 22)) break; }
            __builtin_amdgcn_fence(__ATOMIC_ACQUIRE, "agent"); }
        asm volatile("s_waitcnt vmcnt(0) lgkmcnt(0)" ::: "memory"); __builtin_amdgcn_s_barrier(); asm volatile("" ::: "memory");
        if (lane < 32) { const float* sl = xs + (size_t)(u.pm * 256 + prow) * 4; float t = 0.f;
#pragma unroll
            for (int k = 0; k < 4; ++k) t += __hip_atomic_load(sl + k, __ATOMIC_RELAXED, __HIP_MEMORY_SCOPE_AGENT);
            Sr[prow] = rsqrtf(t * (1.0f / D) + EPS); }
        asm volatile("s_waitcnt lgkmcnt(0)" ::: "memory"); __builtin_amdgcn_s_barrier(); asm volatile("" ::: "memory");
        const float* scp = sc + (size_t)q * MODW + col0; const float* shp = sh + (size_t)q * MODW + col0;
#pragma unroll
        for (int ai = 0; ai < 2; ++ai)
#pragma unroll
            for (int m = 0; m < 4; ++m) { int lrow = ai * 128 + wr * 64 + m * 16 + fr; asm volatile("" : "+v"(lrow)); const float rstd = Sr[lrow]; bf16_t* o = UB + (size_t)(u.pm * 256 + lrow) * D + col0;
#pragma unroll
                for (int bj = 0; bj < 2; ++bj)
#pragma unroll
                    for (int n = 0; n < 2; ++n) { const int co = bj * 128 + n * 16; const f32x4 v = acc[ai][bj][m][n] * rstd * (*(const f32x4*)(scp + co) + 1.0f) + *(const f32x4*)(shp + co);
                        u32x2 w; w.x = pk2(v.x, v.y); w.y = pk2(v.z, v.w); *(u32x2*)(o + co) = w; }
                asm volatile("" ::: "memory"); }
    }
};
struct EpiResAtomic {
    static constexpr bool PERM = false, AFTER_DRAIN = false;
    float* X; const float* gate;
    DI void operator()(const f32x4 (&acc)[2][2][4][2], const pg8::Unit& u, int wr, int wc, int fr, int fq) const {
        const int row0 = NP + wr * 64 + fr, col0 = (u.pn & 3) * 256 + wc * 32 + 4 * fq;
#pragma unroll
        for (int ai = 0; ai < 2; ++ai)
#pragma unroll
            for (int m = 0; m < 4; ++m) { int row = row0 + ai * 128 + m * 16; asm volatile("" : "+v"(row));
                if (row < NR) { const float* gp = gate + (size_t)seq_of(row) * MODW + col0; float* o = X + (size_t)row * D + col0;
#pragma unroll
                    for (int bj = 0; bj < 2; ++bj)
#pragma unroll
                        for (int n = 0; n < 2; ++n) { const f32x4 gv = *(const f32x4*)(gp + bj * 128 + n * 16) * acc[ai][bj][m][n];
#pragma unroll
                            for (int e = 0; e < 4; ++e) __hip_atomic_fetch_add(o + bj * 128 + n * 16 + e, gv[e], __ATOMIC_RELAXED, __HIP_MEMORY_SCOPE_AGENT); } }
                asm volatile("" ::: "memory"); }
    }
};
struct EpiSplit {
    static constexpr bool PERM = true, AFTER_DRAIN = false;
    int act; bf16_t* O0; int ld0, b1; bf16_t* O1; int ld1, b2; float* F; int ldf, ntail;
    DI void operator()(const f32x4 (&acc)[2][2][4][2], const pg8::Unit& u, int wr, int wc, int fr, int fq) const {
        const int row0 = u.pm * 256 + wr * 64 + fr; const int colt = u.pn * 256;
        if (colt >= b2) {
            const int c0 = colt - b2 + wc * 32 + 8 * fq;
#pragma unroll
            for (int ai = 0; ai < 2; ++ai)
#pragma unroll
                for (int m = 0; m < 4; ++m) { const int row = row0 + ai * 128 + m * 16;
#pragma unroll
                    for (int bj = 0; bj < 2; ++bj)
#pragma unroll
                        for (int n = 0; n < 2; ++n) { const int c = c0 + bj * 128 + 4 * n; if (c < ntail) *(f32x4*)(F + (size_t)row * ldf + c) = acc[ai][bj][m][n]; } }
            return;
        }
        const bool s0 = colt < b1; bf16_t* base = s0 ? O0 : O1; const int ld = s0 ? ld0 : ld1; const int col0 = (s0 ? colt : colt - b1) + wc * 32 + 8 * fq;
#pragma unroll
        for (int ai = 0; ai < 2; ++ai)
#pragma unroll
            for (int m = 0; m < 4; ++m) { bf16_t* rowp = base + (size_t)(row0 + ai * 128 + m * 16) * ld + col0;
#pragma unroll
                for (int bj = 0; bj < 2; ++bj) { f32x4 v0 = acc[ai][bj][m][0], v1 = acc[ai][bj][m][1];
                    if (act == 1 && s0) {
#pragma unroll
                        for (int j = 0; j < 4; ++j) { v0[j] = gelu_tanh(v0[j]); v1[j] = gelu_tanh(v1[j]); } }
                    if (act == 2) {
#pragma unroll
                        for (int j = 0; j < 4; ++j) { const float a = fmaxf(v0[j], 0.f), b = fmaxf(v1[j], 0.f); v0[j] = a * a; v1[j] = b * b; } }
                    u32x4 w; w.x = pg8::cvt_pk_bf16(v0[0], v0[1]); w.y = pg8::cvt_pk_bf16(v0[2], v0[3]); w.z = pg8::cvt_pk_bf16(v1[0], v1[1]); w.w = pg8::cvt_pk_bf16(v1[2], v1[3]);
                    *(u32x4*)(rowp + bj * 128) = w; } }
    }
};
struct EpiGate {
    static constexpr bool PERM = false, AFTER_DRAIN = false;
    const bf16_t* XB; const float* gb; const float* ls8; float* LA; float* BX;
    DI void operator()(const f32x4 (&acc)[2][2][4][2], const pg8::Unit& u, int wr, int wc, int fr, int fq) const {
        const int row0 = u.pm * 256 + wr * 64 + fr, ch0 = u.pn * 128 + wc * 32 + 4 * fq;
#pragma unroll
        for (int n = 0; n < 2; ++n) { const int ch = ch0 + n * 16; const f32x4 br = *(const f32x4*)(gb + ch), bi = *(const f32x4*)(gb + D + ch), ls = *(const f32x4*)(ls8 + ch);
#pragma unroll
            for (int ai = 0; ai < 2; ++ai)
#pragma unroll
                for (int m = 0; m < 4; ++m) { const int row = row0 + ai * 128 + m * 16; int o = row * D + ch; asm volatile("" : "+v"(o));
                    if (row < NR) { const u32x2 xw = *(const u32x2*)(XB + o);
                        const float xb[4] = {lo16(xw.x), hi16(xw.x), lo16(xw.y), hi16(xw.y)}; f32x4 la, bx;
#pragma unroll
                        for (int j = 0; j < 4; ++j) { const float r = sigmoidf_(acc[ai][0][m][n][j] + br[j]), ig = sigmoidf_(acc[ai][1][m][n][j] + bi[j]);
                            const float l = r * ls[j], a = __expf(l); la[j] = l; bx[j] = __builtin_amdgcn_sqrtf(fmaxf(1.0f - a * a, 0.f)) * ig * xb[j]; }
                        *(f32x4*)(LA + o) = la; *(f32x4*)(BX + o) = bx; }
                    asm volatile("" ::: "memory"); } }
    }
};
DI void transpose_item(const float* W, int K, int N, bf16_t* WT, int row_off, LAS float* scr, int kb, int nb, int lane) {
    const int k0 = 64 * kb, n0 = 32 * nb; const int n4 = (lane & 7) * 4, kr = lane >> 3;
    const GAS float* Wg = (const GAS float*)W; GAS bf16_t* WTg = (GAS bf16_t*)WT;
    f32x4 v[8];
    if (n0 + 32 <= N) {
#pragma unroll
        for (int i = 0; i < 8; ++i) v[i] = *(const GAS f32x4*)(Wg + (size_t)(k0 + i * 8 + kr) * N + n0 + n4);
    } else {
#pragma unroll
        for (int i = 0; i < 8; ++i) { const GAS float* src = Wg + (size_t)(k0 + i * 8 + kr) * N + n0 + n4;
#pragma unroll
            for (int e = 0; e < 4; ++e) v[i][e] = (n0 + n4 + e < N) ? src[e] : 0.f; }
    }
#pragma unroll
    for (int i = 0; i < 8; ++i) { LAS float* d = scr + (i * 8 + kr) * 33 + n4; d[0] = v[i].x; d[1] = v[i].y; d[2] = v[i].z; d[3] = v[i].w; }
    asm volatile("s_waitcnt lgkmcnt(0)" ::: "memory");
    const int c = lane & 7;
#pragma unroll
    for (int j = 0; j < 4; ++j) { const int n = (lane >> 3) + 8 * j; const LAS float* s = scr + (8 * c) * 33 + n;
        u32x4 o; o.x = pk2(s[0 * 33], s[1 * 33]); o.y = pk2(s[2 * 33], s[3 * 33]); o.z = pk2(s[4 * 33], s[5 * 33]); o.w = pk2(s[6 * 33], s[7 * 33]);
        if (n0 + n < N) *(GAS u32x4*)(WTg + (size_t)(row_off + n0 + n) * K + k0 + 8 * c) = o; }
    asm volatile("s_waitcnt lgkmcnt(0)" ::: "memory");
}
struct TJob { const float* W; bf16_t* WT; int K, N, mode, aux; };
template <class ArgsRef> DI void prep_phase(const Ctx& c, const ArgsRef& a, bool first) {
    unsigned char* ws = a.ws;
    LAS TJob* jobs = (LAS TJob*)(c.lds + 131072 - 4096); LAS int* cum = (LAS int*)(c.lds + 131072 - 512);
    constexpr int NJ = 40;
    if (c.tid == 0) {
        int j = 0;
        auto add = [&](const float* W, bf16_t* WT, int K, int N, int mode, int aux) { jobs[j].W = W; jobs[j].WT = WT; jobs[j].K = K; jobs[j].N = N; jobs[j].mode = mode; jobs[j].aux = aux; ++j; };
        for (int i = 0; i < 4; ++i) add(GIN(10) + (size_t)i * 1024 * MODW, (bf16_t*)(ws + WS_P) + (size_t)i * MODW * 1024, 1024, MODW, 0, 0);
        for (int i = 0; i < 4; ++i) add(GIN(12) + (size_t)i * 1024 * 4096, (bf16_t*)(ws + WS_WUP) + (size_t)i * 4096 * 1024, 1024, 4096, 0, 0);
        for (int i = 0; i < 4; ++i) add(GIN(13) + (size_t)i * 1024 * 4096, (bf16_t*)(ws + WS_WDN) + (size_t)i * 4096 * 1024, 4096, 1024, 0, 0);
        for (int i = 0; i < 2; ++i) add(GIN(15) + (size_t)i * 1024 * 2048, (bf16_t*)(ws + WS_RGIN) + (size_t)i * 2048 * 1024, 1024, 2048, 0, 0);
        for (int i = 0; i < 16; ++i) add(GIN(18) + (size_t)i * 65536, (bf16_t*)(ws + WS_RGGATE) + (size_t)(i >> 3) * 2048 * 256, 256, 256, 1, i & 7);
        for (int i = 0; i < 2; ++i) add(GIN(21) + (size_t)i * 1024 * 1024, (bf16_t*)(ws + WS_RGOUT) + (size_t)i * 1024 * 1024, 1024, 1024, 0, 0);
        add(GIN(22), (bf16_t*)(ws + WS_GDNIN), 1024, GDN_N, 0, 0);
        add(GIN(27), (bf16_t*)(ws + WS_GDNOUT), 1024, 1024, 0, 0);
        add(GIN(28), (bf16_t*)(ws + WS_SSDIN), 1024, SSD_N, 0, 0);
        add(GIN(35), (bf16_t*)(ws + WS_SSDOUT), 2048, 1024, 0, 0);
        int s = 0; for (int i = 0; i < NJ; ++i) { if (i < j) s += (jobs[i].K / 64) * ((jobs[i].N + 31) / 32); cum[i] = s; }
    }
    __syncthreads();
    const int total = cum[NJ - 1]; const int gw = c.bid * 8 + c.wave, NGW = c.G * 8;
    LAS float* scr = (LAS float*)(c.lds + c.wave * 8704);
    for (int it = gw; it < total; it += NGW) {
        int j = 0; while (cum[j] <= it) ++j;
        const int r = it - (j ? cum[j - 1] : 0); const int K = jobs[j].K, N = jobs[j].N, nblk = (N + 31) / 32, kb = r / nblk, nb = r % nblk;
        int row_off = 0;
        if (jobs[j].mode == 1) { const int g = jobs[j].aux >> 2, blk = jobs[j].aux & 3, n0 = nb * 32; row_off = 256 * (2 * blk + (n0 >> 7)) + 128 * g + (n0 & 127) - n0; }
        transpose_item(jobs[j].W, K, N, jobs[j].WT, row_off, scr, kb, nb, c.lane);
    }
    const int gt = c.bid * 512 + c.tid, NT = c.G * 512;
    bf16_t* SC = (bf16_t*)(ws + WS_SC);
    for (int i = gt; i < 256 * 128; i += NT) { const int row = i >> 7, c8 = (i & 127) * 8; float f[8];
        if (row < NSEQ) { const float* src = row < 8 ? GIN(8) + row * D + c8 : GIN(9) + (row - 8) * D + c8;
#pragma unroll
            for (int e = 0; e < 8; ++e) f[e] = siluf_(src[e]); }
        else {
#pragma unroll
            for (int e = 0; e < 8; ++e) f[e] = 0.f; }
        *(u32x4*)(SC + (size_t)row * D + c8) = pack8(f); }
    for (int i = gt; i < 2 * D; i += NT) ((float*)(ws + WS_LS8))[i] = -8.0f * log1pf(__expf(-GIN(20)[i]));
    if (c.bid == 0 && first) for (int i = c.tid; i < 4096; i += 512) ((unsigned*)(ws + WS_BAR))[i] = 0u;
    for (int i = gt; i < 8 * 64 * 64; i += NT) ((unsigned*)(ws + WS_CNT))[i] = 0u;
    for (int i = gt; i < NS * D / 4; i += NT) ((f32x4*)(ws + WS_X + (size_t)NP * D * 4))[i] = ((const f32x4*)GIN(1))[i];
    const u32x4 z4 = {0u, 0u, 0u, 0u};
    for (int i = gt; i < (GDN_NP - GDN_N) * 128; i += NT) *(u32x4*)((bf16_t*)(ws + WS_GDNIN) + (size_t)GDN_N * 1024 + (size_t)i * 8) = z4;
    for (int i = gt; i < (SSD_NP - SSD_N) * 128; i += NT) *(u32x4*)((bf16_t*)(ws + WS_SSDIN) + (size_t)SSD_N * 1024 + (size_t)i * 8) = z4;
}

DI void norm_mod_phase(const Ctx& c, const float* __restrict__ xp, const float* __restrict__ xs, const float* __restrict__ sc, const float* __restrict__ sh, bf16_t* __restrict__ out, int r_begin) {
    const int stride = c.G * 8;
    for (int r = r_begin + c.bid * 8 + c.wave; r < NR; r += 2 * stride) {
        const int r2 = r + stride; const bool two = r2 < NR; const int rb = two ? r2 : r;
        const float* xa = r < NP ? xp + (size_t)r * D : xs + (size_t)(r - NP) * D; const float* xb = rb < NP ? xp + (size_t)rb * D : xs + (size_t)(rb - NP) * D;
        f32x4 va[4], vb[4]; float sa = 0.f, sb = 0.f;
#pragma unroll
        for (int j = 0; j < 4; ++j) { va[j] = *(const f32x4*)(xa + c.lane * 4 + 256 * j); vb[j] = *(const f32x4*)(xb + c.lane * 4 + 256 * j); }
#pragma unroll
        for (int j = 0; j < 4; ++j) { sa += (va[j].x * va[j].x + va[j].y * va[j].y) + (va[j].z * va[j].z + va[j].w * va[j].w); sb += (vb[j].x * vb[j].x + vb[j].y * vb[j].y) + (vb[j].z * vb[j].z + vb[j].w * vb[j].w); }
        const float ra = rsqrtf(wave_sum(sa) * (1.0f / D) + EPS), rbs = rsqrtf(wave_sum(sb) * (1.0f / D) + EPS);
        const int qa = seq_of(r), qb = seq_of(rb);
#pragma unroll
        for (int j = 0; j < 4; ++j) { const int col = c.lane * 4 + 256 * j;
            { const f32x4 s1 = *(const f32x4*)(sc + (size_t)qa * MODW + col), s2 = *(const f32x4*)(sh + (size_t)qa * MODW + col);
              const f32x4 o = va[j] * ra * (s1 + 1.0f) + s2; u32x2 w; w.x = pk2(o.x, o.y); w.y = pk2(o.z, o.w); *(u32x2*)(out + (size_t)r * D + col) = w; }
            if (two) { const f32x4 s1 = *(const f32x4*)(sc + (size_t)qb * MODW + col), s2 = *(const f32x4*)(sh + (size_t)qb * MODW + col);
              const f32x4 o = vb[j] * rbs * (s1 + 1.0f) + s2; u32x2 w; w.x = pk2(o.x, o.y); w.y = pk2(o.z, o.w); *(u32x2*)(out + (size_t)r2 * D + col) = w; } }
    }
}
DI void final_norm_phase(const Ctx& c, const float* X, const float* g, float* out) {
    for (int r = c.bid * 8 + c.wave; r < NR; r += c.G * 8) {
        const float* xr = X + (size_t)r * D; f32x4 v[4]; float ss = 0.f;
#pragma unroll
        for (int j = 0; j < 4; ++j) { v[j] = *(const f32x4*)(xr + c.lane * 4 + 256 * j); ss += (v[j].x * v[j].x + v[j].y * v[j].y) + (v[j].z * v[j].z + v[j].w * v[j].w); }
        const float rstd = rsqrtf(wave_sum(ss) * (1.0f / D) + EPS);
#pragma unroll
        for (int j = 0; j < 4; ++j) { const int col = c.lane * 4 + 256 * j; *(f32x4*)(out + (size_t)r * D + col) = v[j] * rstd * *(const f32x4*)(g + col); }
    }
}

DI void conv8(const bf16_t* P, int ld, int row, int t, const float* st, int nch, const float* w, const float* b, int ch, float* f, float* cur) {
    float x[4][8];
    unpack8(*(const u32x4*)(P + (size_t)row * ld), x[3]);
#pragma unroll
    for (int k = 0; k < 3; ++k) {
        if (t < 0) { const f32x4 a0 = *(const f32x4*)(st + k * nch + ch), a1 = *(const f32x4*)(st + k * nch + ch + 4); x[k][0] = a0.x; x[k][1] = a0.y; x[k][2] = a0.z; x[k][3] = a0.w; x[k][4] = a1.x; x[k][5] = a1.y; x[k][6] = a1.z; x[k][7] = a1.w; }
        else if (t - 3 + k >= 0) unpack8(*(const u32x4*)(P + (size_t)(row - 3 + k) * ld), x[k]);
        else {
#pragma unroll
            for (int e = 0; e < 8; ++e) x[k][e] = 0.f; }
    }
#pragma unroll
    for (int e = 0; e < 8; ++e) { f[e] = b ? b[ch + e] : 0.f; cur[e] = x[3][e]; }
#pragma unroll
    for (int k = 0; k < 4; ++k) { const f32x4 w0 = *(const f32x4*)(w + k * nch + ch), w1 = *(const f32x4*)(w + k * nch + ch + 4);
        f[0] += x[k][0] * w0.x; f[1] += x[k][1] * w0.y; f[2] += x[k][2] * w0.z; f[3] += x[k][3] * w0.w; f[4] += x[k][4] * w1.x; f[5] += x[k][5] * w1.y; f[6] += x[k][6] * w1.z; f[7] += x[k][7] * w1.w; }
}
DI void conv_state8(int row, int t, const float* cur, const float* st, int nch, int ch, float* pout  , float* sout  ) {
    if (t >= 0) { if (t >= SEQL - 3) { float* o = pout + ((size_t)(row >> 11) * 3 + (t - (SEQL - 3))) * nch + ch; *(f32x4*)o = (f32x4){cur[0], cur[1], cur[2], cur[3]}; *(f32x4*)(o + 4) = (f32x4){cur[4], cur[5], cur[6], cur[7]}; } }
    else { const int s = row - NP; float* o = sout + (size_t)s * 3 * nch + ch;
        *(f32x4*)o = *(const f32x4*)(st + nch + ch); *(f32x4*)(o + 4) = *(const f32x4*)(st + nch + ch + 4);
        *(f32x4*)(o + nch) = *(const f32x4*)(st + 2 * nch + ch); *(f32x4*)(o + nch + 4) = *(const f32x4*)(st + 2 * nch + ch + 4);
        *(f32x4*)(o + 2 * nch) = (f32x4){cur[0], cur[1], cur[2], cur[3]}; *(f32x4*)(o + 2 * nch + 4) = (f32x4){cur[4], cur[5], cur[6], cur[7]}; }
}

DI void conv8_slide(const bf16_t* Pc  , int ld, int r0, const float* w, const float* b, int nch, int ch, float (&out)[8][8], u32x4 (&raw)[11]) {
    const bool head = (r0 & (SEQL - 1)) == 0; const u32x4 z = {0u, 0u, 0u, 0u};
#pragma unroll
    for (int k = 0; k < 11; ++k) raw[k] = (k < 3 && head) ? z : *(const u32x4*)(Pc + (size_t)(r0 - 3 + k) * ld);
    float wk[4][8], bb[8];
#pragma unroll
    for (int k = 0; k < 4; ++k) { const f32x4 w0 = *(const f32x4*)(w + k * nch + ch), w1 = *(const f32x4*)(w + k * nch + ch + 4); wk[k][0] = w0.x; wk[k][1] = w0.y; wk[k][2] = w0.z; wk[k][3] = w0.w; wk[k][4] = w1.x; wk[k][5] = w1.y; wk[k][6] = w1.z; wk[k][7] = w1.w; }
#pragma unroll
    for (int e = 0; e < 8; ++e) bb[e] = b ? b[ch + e] : 0.f;
#pragma unroll
    for (int t = 0; t < 8; ++t)
#pragma unroll
        for (int e = 0; e < 8; ++e) out[t][e] = bb[e];
#pragma unroll
    for (int k = 0; k < 11; ++k) { float x[8]; unpack8(raw[k], x);
#pragma unroll
        for (int t = 0; t < 8; ++t) { const int tap = k - t; if (tap >= 0 && tap < 4) {
#pragma unroll
            for (int e = 0; e < 8; ++e) out[t][e] += x[e] * wk[tap][e]; } } }
}
DI void prompt_conv_state(const Ctx& c, const bf16_t* P, int ld, int nch, float* pout) {
    for (int i = c.bid * 512 + c.tid; i < 8 * 3 * nch; i += c.G * 512) { const int ch = i % nch, r = i / nch, k = r % 3, b = r / 3;
        pout[i] = bf2f(P[(size_t)(b * SEQL + SEQL - 3 + k) * ld + ch]); }
}
DI void rg_conv_phase(const Ctx& c, const bf16_t* P  , const float* cw, const float* cb, const float* st  , bf16_t* XB, float* pout, float* sout) {
    for (int i = c.bid * 512 + c.tid; i < (NP / 8) * 128; i += c.G * 512) {
        const int r0 = (i >> 7) * 8, ch = (i & 127) * 8; float o[8][8]; u32x4 raw[11];
        conv8_slide(P + 1024 + ch, 2048, r0, cw, cb, D, ch, o, raw);
#pragma unroll
        for (int t = 0; t < 8; ++t) *(u32x4*)(XB + (size_t)(r0 + t) * D + ch) = pack8(o[t]);
    }
    for (int i = c.bid * 512 + c.tid; i < NS * 128; i += c.G * 512) {
        const int row = NP + (i >> 7), ch = (i & 127) * 8; const float* sp = st + (size_t)(row - NP) * 3 * D;
        float f[8], cur[8]; conv8(P + 1024 + ch, 2048, row, -1, sp, D, cw, cb, ch, f, cur);
        *(u32x4*)(XB + (size_t)row * D + ch) = pack8(f);
        conv_state8(row, -1, cur, sp, D, ch, pout, sout);
    }
    prompt_conv_state(c, P + 1024, 2048, D, pout);
}
DI void rg_scan_phase(const Ctx& c, const float* __restrict__ LA, const float* __restrict__ BX, const bf16_t* __restrict__ P  , const float* h0  , bf16_t* __restrict__ HY, float* ph  , float* sh  ) {
    LAS float* sA = (LAS float*)c.lds; LAS float* sB = sA + 512;
    for (int it = c.bid; it < 256; it += c.G) {
        const int b = it >> 5, ch = (it & 31) * 32 + (c.tid & 31), seg = c.tid >> 5; const int r0 = b * SEQL + seg * 128;
        const float* lap = LA + (size_t)r0 * D + ch; const float* bxp = BX + (size_t)r0 * D + ch; const bf16_t* yp = P + (size_t)r0 * 2048 + ch; bf16_t* op = HY + (size_t)r0 * D + ch;
        float h = 0.f, ap = 0.f;
#pragma unroll 1
        for (int t0 = 0; t0 < 128; t0 += 16) { float la[16], bx[16];
#pragma unroll
            for (int u = 0; u < 16; ++u) { la[u] = lap[(size_t)(t0 + u) * D]; bx[u] = bxp[(size_t)(t0 + u) * D]; }
#pragma unroll
            for (int u = 0; u < 16; ++u) { h = __expf(la[u]) * h + bx[u]; ap += la[u]; } }
        sA[c.tid] = __expf(ap); sB[c.tid] = h;
        __syncthreads();
        float hin = 0.f;
        for (int s = 0; s < seg; ++s) hin = sA[s * 32 + (c.tid & 31)] * hin + sB[s * 32 + (c.tid & 31)];
        h = hin;
#pragma unroll 1
        for (int t0 = 0; t0 < 128; t0 += 16) { float la[16], bx[16]; bf16_t yv[16];
#pragma unroll
            for (int u = 0; u < 16; ++u) { la[u] = lap[(size_t)(t0 + u) * D]; bx[u] = bxp[(size_t)(t0 + u) * D]; yv[u] = yp[(size_t)(t0 + u) * 2048]; }
#pragma unroll
            for (int u = 0; u < 16; ++u) { h = __expf(la[u]) * h + bx[u]; op[(size_t)(t0 + u) * D] = (bf16_t)f2bf(h * bf2f(yv[u])); } }
        if (seg == 15) ph[b * D + ch] = h;
        __syncthreads();
    }
    for (int i = c.bid * 512 + c.tid; i < NS * D; i += c.G * 512) { const int s = i >> 10, ch = i & 1023; const size_t o = (size_t)(NP + s) * D + ch;
        const float h = __expf(LA[o]) * h0[i] + BX[o]; sh[i] = h; HY[o] = (bf16_t)f2bf(h * bf2f(P[(size_t)(NP + s) * 2048 + ch])); }
}
DI void gdn_conv_phase(const Ctx& c, const bf16_t* P, const float* cw  , const float* st  , const float* AB, const float* A_log, const float* dt_bias,
                       bf16_t* Q, bf16_t* K, bf16_t* V, bf16_t* QKVS, float* GB, float* pout, float* sout) {
    for (int wt = c.bid * 8 + c.wave; wt < (NP / 8) * 6; wt += c.G * 8) {
        const int seg = wt % 6, r0 = (wt / 6) * 8, ch = seg * 512 + c.lane * 8; float o[8][8]; u32x4 raw[11];
        conv8_slide(P + ch, 3072, r0, cw, nullptr, 3072, ch, o, raw);
        bf16_t* dst = (seg < 2 ? Q : (seg < 4 ? K : V)) + (seg & 1) * 512 + c.lane * 8;
#pragma unroll
        for (int t = 0; t < 8; ++t) { float ss = 0.f;
#pragma unroll
            for (int e = 0; e < 8; ++e) { o[t][e] = siluf_(o[t][e]); ss += o[t][e] * o[t][e]; }
            if (seg < 4) { ss += __shfl_xor(ss, 1); ss += __shfl_xor(ss, 2); ss += __shfl_xor(ss, 4); ss += __shfl_xor(ss, 8);
                const float sc = rsqrtf(ss + EPS) * (seg < 2 ? 0.08838834764831845f : 1.0f);
#pragma unroll
                for (int e = 0; e < 8; ++e) o[t][e] *= sc; }
            *(u32x4*)(dst + (size_t)(r0 + t) * D) = pack8(o[t]); }
    }
    for (int row = NP + c.bid * 8 + c.wave; row < NR; row += c.G * 8) {
        const float* sp = st + (size_t)(row - NP) * 3 * 3072;
#pragma unroll 1
        for (int pass = 0; pass < 6; ++pass) {
            const int ch = pass * 512 + c.lane * 8; float f[8], cur[8];
            conv8(P + ch, 3072, row, -1, sp, 3072, cw, nullptr, ch, f, cur);
            conv_state8(row, -1, cur, sp, 3072, ch, pout, sout);
            float ss = 0.f;
#pragma unroll
            for (int e = 0; e < 8; ++e) { f[e] = siluf_(f[e]); ss += f[e] * f[e]; }
            if (pass < 4) { ss += __shfl_xor(ss, 1); ss += __shfl_xor(ss, 2); ss += __shfl_xor(ss, 4); ss += __shfl_xor(ss, 8);
                const float sc = rsqrtf(ss + EPS) * (pass < 2 ? 0.08838834764831845f : 1.0f);
#pragma unroll
                for (int e = 0; e < 8; ++e) f[e] *= sc; }
            *(u32x4*)(QKVS + ((size_t)(pass >> 1) * NS + (row - NP)) * D + (pass & 1) * 512 + c.lane * 8) = pack8(f);
        }
    }
    for (int i = c.bid * 512 + c.tid; i < NR * 8; i += c.G * 512) { const int row = i >> 3, h = i & 7; const float a_in = AB[(size_t)row * 16 + h], b_in = AB[(size_t)row * 16 + 8 + h];
        GB[(size_t)row * 16 + h] = -__expf(A_log[h]) * softplusf_(a_in + dt_bias[h]); GB[(size_t)row * 16 + 8 + h] = sigmoidf_(b_in); }
    prompt_conv_state(c, P, 3072, 3072, pout);
}
DI void gdn_prep_phase(const Ctx& c, const bf16_t* Q, const bf16_t* K, const bf16_t* V, const float* GB, float* UT, bf16_t* NW, bf16_t* QD, bf16_t* KDT, bf16_t* QKG, float* GL) {
    const int half = c.tid >> 8, t = c.tid & 255, w4 = c.wave & 3, lr = c.lane & 15, quad = c.lane >> 4;
    ldsp L = c.lds + half * 65536; ldsp kS = L, qS = L + 17408; LAS float* AT = (LAS float*)(L + 34816); LAS float* Gs = (LAS float*)(L + 51200); LAS float* Bs = Gs + 64; LAS float* EGs = Gs + 128;
    for (int pair = c.bid; pair < 1024; pair += c.G) {
        const int item = pair * 2 + half, n = item & 31, h = (item >> 5) & 7, b = item >> 8, r0 = b * SEQL + n * 64;
        if (t < 64) { float G = GB[(size_t)(r0 + t) * 16 + h]; const float be = GB[(size_t)(r0 + t) * 16 + 8 + h];
#pragma unroll
            for (int o = 1; o < 64; o <<= 1) { const float v = __shfl_up(G, o); if (c.lane >= o) G += v; }
            Gs[t] = G; Bs[t] = be; EGs[t] = __expf(G); }
#pragma unroll
        for (int i = 0; i < 4; ++i) { const int ci = t + i * 256, row = ci >> 4, cc = ci & 15; const size_t go = (size_t)(r0 + row) * D + h * 128 + cc * 8;
            *(LAS u32x4*)(kS + row * 272 + cc * 16) = *(const u32x4*)(K + go); *(LAS u32x4*)(qS + row * 272 + cc * 16) = *(const u32x4*)(Q + go); }
        __syncthreads();
        {
            const int ib = w4; float Gi[4], bi[4];
#pragma unroll
            for (int jj = 0; jj < 4; ++jj) { Gi[jj] = Gs[ib * 16 + quad * 4 + jj]; bi[jj] = Bs[ib * 16 + quad * 4 + jj]; }
            bf16_t* qkg = QKG + (size_t)item * 4096;
#pragma unroll 1
            for (int jb = 0; jb < 4; ++jb) {
                if (jb <= ib) {
                    f32x4 akk = {0.f, 0.f, 0.f, 0.f}, aqk = {0.f, 0.f, 0.f, 0.f};
#pragma unroll
                    for (int ks = 0; ks < 4; ++ks) { const bf16x8 ak = *(const LAS bf16x8*)(kS + (ib * 16 + lr) * 272 + ks * 64 + quad * 16), aq = *(const LAS bf16x8*)(qS + (ib * 16 + lr) * 272 + ks * 64 + quad * 16),
                                                                  bk = *(const LAS bf16x8*)(kS + (jb * 16 + lr) * 272 + ks * 64 + quad * 16);
                        akk = MFMA16(ak, bk, akk); aqk = MFMA16(aq, bk, aqk); }
                    const int j = jb * 16 + lr; const float Gj = Gs[j]; f32x4 av;
#pragma unroll
                    for (int jj = 0; jj < 4; ++jj) { const int i = ib * 16 + quad * 4 + jj; const float dec = i >= j ? __expf(Gi[jj] - Gj) : 0.f;
                        av[jj] = i > j ? bi[jj] * akk[jj] * dec : 0.f; qkg[i * 64 + j] = (bf16_t)f2bf(aqk[jj] * dec); }
                    *(LAS f32x4*)(AT + j * 64 + ib * 16 + quad * 4) = av;
                } else {
#pragma unroll
                    for (int jj = 0; jj < 4; ++jj) qkg[(ib * 16 + quad * 4 + jj) * 64 + jb * 16 + lr] = 0;
                }
            }
        }
#pragma unroll
        for (int i = 0; i < 4; ++i) { const int ci = t + i * 256, row = ci >> 4, cc = ci & 15; float f[8]; unpack8(*(const LAS u32x4*)(qS + row * 272 + cc * 16), f); const float eg = EGs[row];
#pragma unroll
            for (int e = 0; e < 8; ++e) f[e] *= eg;
            *(u32x4*)(QD + (size_t)(r0 + row) * D + h * 128 + cc * 8) = pack8(f); }
        { const int dk = t & 127, chf = t >> 7; const float Gl = Gs[63];
#pragma unroll
            for (int c8 = 0; c8 < 4; ++c8) { const int c0 = chf * 32 + c8 * 8; float f[8];
#pragma unroll
                for (int e = 0; e < 8; ++e) f[e] = bf2f(*(const LAS bf16_t*)(kS + (c0 + e) * 272 + dk * 2)) * __expf(Gl - Gs[c0 + e]);
                *(u32x4*)(KDT + ((size_t)item * 128 + dk) * 64 + c0) = pack8(f); }
            if (t == 0) GL[item] = __expf(Gl); }
        __syncthreads();
#pragma unroll
        for (int i = 0; i < 4; ++i) { const int ci = t + i * 256, row = ci >> 4, cc = ci & 15; *(LAS u32x4*)(qS + row * 272 + cc * 16) = *(const u32x4*)(V + (size_t)(r0 + row) * D + h * 128 + cc * 8); }
        __syncthreads();
        {
            float x[64];
            if (t < 128) {
#pragma unroll
                for (int i = 0; i < 64; ++i) x[i] = bf2f(*(const LAS bf16_t*)(qS + i * 272 + t * 2)) * Bs[i];
            } else {
#pragma unroll
                for (int i = 0; i < 64; ++i) x[i] = bf2f(*(const LAS bf16_t*)(kS + i * 272 + (t - 128) * 2)) * Bs[i] * EGs[i];
            }
#pragma unroll
            for (int j = 0; j < 63; ++j) {
#pragma unroll
                for (int i4 = ((j + 1) & ~3); i4 < 64; i4 += 4) { const f32x4 av = *(const LAS f32x4*)(AT + j * 64 + i4);
                    if (i4 + 0 > j) x[i4 + 0] -= av.x * x[j];
                    if (i4 + 1 > j) x[i4 + 1] -= av.y * x[j];
                    if (i4 + 2 > j) x[i4 + 2] -= av.z * x[j];
                    if (i4 + 3 > j) x[i4 + 3] -= av.w * x[j]; }
            }
            __syncthreads();
            if (t < 128) { float* o = UT + ((size_t)item * 128 + t) * 64;
#pragma unroll
                for (int i = 0; i < 16; ++i) *(f32x4*)(o + 4 * i) = (f32x4){x[4 * i], x[4 * i + 1], x[4 * i + 2], x[4 * i + 3]};
            } else {
#pragma unroll
                for (int i = 0; i < 64; ++i) *(LAS bf16_t*)(kS + i * 272 + (t - 128) * 2) = (bf16_t)f2bf(-x[i]);
            }
        }
        __syncthreads();
#pragma unroll
        for (int i = 0; i < 4; ++i) { const int ci = t + i * 256, row = ci >> 4, cc = ci & 15; *(u32x4*)(NW + (size_t)(r0 + row) * D + h * 128 + cc * 8) = *(const LAS u32x4*)(kS + row * 272 + cc * 16); }
        __syncthreads();
    }
}
DI void gdn_seq_phase(const Ctx& c, const float* UT, const bf16_t* NW, const bf16_t* QD, const bf16_t* KDT, const bf16_t* QKG, const float* GL, float* O, float* pS,
                      const bf16_t* QKVS, const float* GB, const float* S0, float* sS) {
    const int lr = c.lane & 15, quad = c.lane >> 4, w = c.wave;
    ldsp Ws = c.lds, Qs = c.lds + 17408, KTs = c.lds + 34816, QKs = c.lds + 53248, Sts = c.lds + 62464, VTs = c.lds + 71168;
    for (int it0 = c.bid; it0 < 256; it0 += c.G) {
        const int cb = (it0 >> 3) & 3, bh = (it0 & 7) * 8 + (it0 >> 5), b = bh >> 3, h = bh & 7, ci = w >> 1, vi = w & 1;
        f32x4 Sacc[2] = {{0.f, 0.f, 0.f, 0.f}, {0.f, 0.f, 0.f, 0.f}};
        for (int i = c.tid; i < 8704 / 4; i += 512) ((LAS unsigned*)Sts)[i] = 0u;
        u32x4 pf[2][7]; f32x4 put[2]; float pgl[2];
        typedef std::integral_constant<int, 0> I0; typedef std::integral_constant<int, 1> I1;
        auto fetch = [&](int n, auto SL) { constexpr int sl = decltype(SL)::value; const int pit = bh * 32 + n, r0 = b * SEQL + n * 64;
            put[sl] = *(const f32x4*)(UT + ((size_t)pit * 128 + cb * 32 + vi * 16 + lr) * 64 + ci * 16 + quad * 4); pgl[sl] = GL[pit];
#pragma unroll
            for (int i = 0; i < 2; ++i) { const int cidx = c.tid + i * 512, row = cidx >> 4, cc = cidx & 15; const size_t go = (size_t)(r0 + row) * D + h * 128 + cc * 8; pf[sl][i] = *(const u32x4*)(NW + go); pf[sl][2 + i] = *(const u32x4*)(QD + go); }
#pragma unroll
            for (int i = 0; i < 2; ++i) { const int cidx = c.tid + i * 512; pf[sl][4 + i] = *(const u32x4*)(KDT + (size_t)pit * 8192 + cidx * 8); }
            pf[sl][6] = *(const u32x4*)(QKG + (size_t)pit * 4096 + c.tid * 8); };
        auto stash = [&](auto SL) { constexpr int sl = decltype(SL)::value;
#pragma unroll
            for (int i = 0; i < 2; ++i) { const int cidx = c.tid + i * 512, row = cidx >> 4, cc = cidx & 15; *(LAS u32x4*)(Ws + row * 272 + cc * 16) = pf[sl][i]; *(LAS u32x4*)(Qs + row * 272 + cc * 16) = pf[sl][2 + i]; }
#pragma unroll
            for (int i = 0; i < 2; ++i) { const int cidx = c.tid + i * 512, row = cidx >> 3, cc = cidx & 7; *(LAS u32x4*)(KTs + row * 144 + cc * 16) = pf[sl][4 + i]; }
            { const int row = c.tid >> 3, cc = c.tid & 7; *(LAS u32x4*)(QKs + row * 144 + cc * 16) = pf[sl][6]; } };
        fetch(0, I0{}); stash(I0{}); fetch(1, I1{});
        __syncthreads();
        const int sv = c.tid & 127, spart = c.tid >> 7; LAS float* sqf = (LAS float*)(c.lds + 80000); LAS float* skf = sqf + 128; LAS float* sred = sqf + 256;
        float s0[32]; bf16_t sqk = 0, svv = 0; float seg = 0.f, sbeta = 0.f; int sit = NS * 8;
#pragma unroll
        for (int i = 0; i < 32; ++i) s0[i] = 0.f;
        auto chunk = [&](int n, auto PAR) { constexpr int par = decltype(PAR)::value;
            const int r0 = b * SEQL + n * 64;
            f32x4 acc = put[par]; const float gl = pgl[par];
            if (n + 2 < 32) fetch(n + 2, PAR);
#pragma unroll
            for (int ks = 0; ks < 4; ++ks) acc = MFMA16(*(const LAS bf16x8*)(Ws + (ci * 16 + lr) * 272 + ks * 64 + quad * 16), *(const LAS bf16x8*)(Sts + (vi * 16 + lr) * 272 + ks * 64 + quad * 16), acc);
            { u32x2 wv; wv.x = pk2(acc[0], acc[1]); wv.y = pk2(acc[2], acc[3]); *(LAS u32x2*)(VTs + (vi * 16 + lr) * 144 + (ci * 16 + quad * 4) * 2) = wv; }
            LDS_BAR();
            { const int st3 = n & 7;
                if (st3 == 0) { sit = (it0 == c.bid) ? c.bid + (n >> 3) * c.G : NS * 8;
                    if (sit < NS * 8) { const int s2 = sit >> 3, h2 = sit & 7, row2 = NP + s2;
                        const float* sp = S0 + ((size_t)(s2 * 8 + h2) * 128 + spart * 32) * 128 + sv;
#pragma unroll
                        for (int i = 0; i < 32; ++i) s0[i] = sp[(size_t)i * 128];
                        if (c.tid < 128) sqk = QKVS[(size_t)s2 * D + h2 * 128 + c.tid]; else if (c.tid < 256) sqk = QKVS[(size_t)(NS + s2) * D + h2 * 128 + c.tid - 128];
                        svv = QKVS[(size_t)(2 * NS + s2) * D + h2 * 128 + sv]; seg = __expf(GB[(size_t)row2 * 16 + h2]); sbeta = GB[(size_t)row2 * 16 + 8 + h2]; } }
                else if (st3 == 1 && sit < NS * 8) { float ksum = 0.f, qsum = 0.f, qk = 0.f;
#pragma unroll
                    for (int i = 0; i < 32; ++i) { const float kk = skf[spart * 32 + i], qq = sqf[spart * 32 + i]; ksum += kk * s0[i]; qsum += qq * s0[i]; qk += qq * kk; }
                    sred[spart * 128 + sv] = ksum; sred[512 + spart * 128 + sv] = qsum; sred[1024 + spart * 128 + sv] = qk; }
                else if (st3 == 2 && sit < NS * 8) { const int s2 = sit >> 3, h2 = sit & 7, row2 = NP + s2;
                    const float ksum = sred[sv] + sred[128 + sv] + sred[256 + sv] + sred[384 + sv], qsum = sred[512 + sv] + sred[640 + sv] + sred[768 + sv] + sred[896 + sv], qk = sred[1024 + sv] + sred[1152 + sv] + sred[1280 + sv] + sred[1408 + sv];
                    const float vn = sbeta * (bf2f(svv) - seg * ksum);
                    if (spart == 0) O[(size_t)row2 * D + h2 * 128 + sv] = seg * qsum + qk * vn;
                    float* so = sS + ((size_t)(s2 * 8 + h2) * 128 + spart * 32) * 128 + sv;
#pragma unroll
                    for (int i = 0; i < 32; ++i) so[(size_t)i * 128] = seg * s0[i] + skf[spart * 32 + i] * vn; } }
            f32x4 ao = {0.f, 0.f, 0.f, 0.f};
#pragma unroll
            for (int ks = 0; ks < 4; ++ks) ao = MFMA16(*(const LAS bf16x8*)(Qs + (ci * 16 + lr) * 272 + ks * 64 + quad * 16), *(const LAS bf16x8*)(Sts + (vi * 16 + lr) * 272 + ks * 64 + quad * 16), ao);
#pragma unroll
            for (int ks = 0; ks < 2; ++ks) ao = MFMA16(*(const LAS bf16x8*)(QKs + (ci * 16 + lr) * 144 + ks * 64 + quad * 16), *(const LAS bf16x8*)(VTs + (vi * 16 + lr) * 144 + ks * 64 + quad * 16), ao);
#pragma unroll
            for (int jj = 0; jj < 4; ++jj) O[(size_t)(r0 + ci * 16 + quad * 4 + jj) * D + h * 128 + cb * 32 + vi * 16 + lr] = ao[jj];
#pragma unroll
            for (int v2 = 0; v2 < 2; ++v2) { Sacc[v2] = Sacc[v2] * gl;
#pragma unroll
                for (int ks = 0; ks < 2; ++ks) Sacc[v2] = MFMA16(*(const LAS bf16x8*)(KTs + (w * 16 + lr) * 144 + ks * 64 + quad * 16), *(const LAS bf16x8*)(VTs + (v2 * 16 + lr) * 144 + ks * 64 + quad * 16), Sacc[v2]); }
            LDS_BAR();
            if ((n & 7) == 0 && sit < NS * 8 && c.tid < 256) sqf[c.tid] = bf2f(sqk);
#pragma unroll
            for (int v2 = 0; v2 < 2; ++v2) { u32x2 wv; wv.x = pk2(Sacc[v2][0], Sacc[v2][1]); wv.y = pk2(Sacc[v2][2], Sacc[v2][3]); *(LAS u32x2*)(Sts + (v2 * 16 + lr) * 272 + (w * 16 + quad * 4) * 2) = wv; }
            if (n + 1 < 32) stash(std::integral_constant<int, par ^ 1>{});
            LDS_BAR();
        };
#pragma unroll 1
        for (int n = 0; n < 32; n += 2) { chunk(n, I0{}); chunk(n + 1, I1{}); }
#pragma unroll
        for (int v2 = 0; v2 < 2; ++v2)
#pragma unroll
            for (int jj = 0; jj < 4; ++jj) pS[((size_t)bh * 128 + w * 16 + quad * 4 + jj) * 128 + cb * 32 + v2 * 16 + lr] = Sacc[v2][jj];
        __syncthreads();
    }
    LAS float* qf = (LAS float*)c.lds; LAS float* kf = qf + 128; LAS float* red = qf + 256;
    for (int it = (c.bid < 256 ? c.bid + 4 * c.G : c.bid); it < NS * 8; it += c.G) {
        const int s = it >> 3, h = it & 7, row = NP + s, v = c.tid & 127, part = c.tid >> 7;
        __syncthreads();
        if (c.tid < 128) qf[c.tid] = bf2f(QKVS[(size_t)s * D + h * 128 + c.tid]); else if (c.tid < 256) kf[c.tid - 128] = bf2f(QKVS[(size_t)(NS + s) * D + h * 128 + c.tid - 128]);
        __syncthreads();
        const float eg = __expf(GB[(size_t)row * 16 + h]), beta = GB[(size_t)row * 16 + 8 + h];
        const float* sp = S0 + ((size_t)(s * 8 + h) * 128 + part * 32) * 128 + v;
        float s0[32], ksum = 0.f, qsum = 0.f, qk = 0.f;
#pragma unroll
        for (int i = 0; i < 32; ++i) { s0[i] = sp[(size_t)i * 128]; const float kk = kf[part * 32 + i], qq = qf[part * 32 + i]; ksum += kk * s0[i]; qsum += qq * s0[i]; qk += qq * kk; }
        red[part * 128 + v] = ksum; red[512 + part * 128 + v] = qsum; red[1024 + part * 128 + v] = qk;
        __syncthreads();
        ksum = red[v] + red[128 + v] + red[256 + v] + red[384 + v]; qsum = red[512 + v] + red[640 + v] + red[768 + v] + red[896 + v]; qk = red[1024 + v] + red[1152 + v] + red[1280 + v] + red[1408 + v];
        const float vv = bf2f(QKVS[(size_t)(2 * NS + s) * D + h * 128 + v]); const float vn = beta * (vv - eg * ksum);
        if (part == 0) O[(size_t)row * D + h * 128 + v] = eg * qsum + qk * vn;
        float* so = sS + ((size_t)(s * 8 + h) * 128 + part * 32) * 128 + v;
#pragma unroll
        for (int i = 0; i < 32; ++i) so[(size_t)i * 128] = eg * s0[i] + kf[part * 32 + i] * vn;
    }
}
DI void gdn_post_phase(const Ctx& c, const float* O, const bf16_t* GATE, const float* ng, bf16_t* OG) {
    for (int row = c.bid * 8 + c.wave; row < NR; row += c.G * 8) {
#pragma unroll
        for (int pass = 0; pass < 2; ++pass) { const int col = pass * 512 + c.lane * 8, dv = (c.lane & 15) * 8;
            const f32x4 a = *(const f32x4*)(O + (size_t)row * D + col), b2 = *(const f32x4*)(O + (size_t)row * D + col + 4); float f[8] = {a.x, a.y, a.z, a.w, b2.x, b2.y, b2.z, b2.w}, g[8];
            float ss = 0.f;
#pragma unroll
            for (int e = 0; e < 8; ++e) ss += f[e] * f[e];
            ss += __shfl_xor(ss, 1); ss += __shfl_xor(ss, 2); ss += __shfl_xor(ss, 4); ss += __shfl_xor(ss, 8);
            const float rstd = rsqrtf(ss * (1.0f / 128.0f) + EPS);
            unpack8(*(const u32x4*)(GATE + (size_t)row * D + col), g);
#pragma unroll
            for (int e = 0; e < 8; ++e) f[e] = f[e] * rstd * ng[dv + e] * siluf_(g[e]);
            *(u32x4*)(OG + (size_t)row * D + col) = pack8(f); }
    }
}
DI void ssd_conv_phase(const Ctx& c, const bf16_t* P, const float* cw, const float* cb, const float* st  , const float* DTR, const float* dt_bias,
                       bf16_t* BM, bf16_t* CM, bf16_t* XSN, float* DT, bf16_t* XST, bf16_t* BMT, float* pout, float* sout) {
    for (int wt = c.bid * 8 + c.wave; wt < (NP / 8) * 6; wt += c.G * 8) {
        const int seg = wt % 6, rb = wt / 6, r0 = rb * 8, ch = seg * 512 + c.lane * 8, bn = rb >> 3, s8 = rb & 7; float o[8][8]; u32x4 raw[11];
        conv8_slide(P + ch, 3072, r0, cw, cb, 3072, ch, o, raw);
#pragma unroll
        for (int t = 0; t < 8; ++t)
#pragma unroll
            for (int e = 0; e < 8; ++e) o[t][e] = siluf_(o[t][e]);
        if (seg >= 4) { bf16_t* dst = (seg == 4 ? BM : CM) + c.lane * 8;
#pragma unroll
            for (int t = 0; t < 8; ++t) *(u32x4*)(dst + (size_t)(r0 + t) * 512) = pack8(o[t]); }
        if (seg <= 4) { bf16_t* dst = seg < 4 ? XST + ((size_t)bn * 2048 + ch) * 64 + s8 * 8 : BMT + ((size_t)bn * 512 + c.lane * 8) * 64 + s8 * 8;
#pragma unroll
            for (int e = 0; e < 8; ++e) { const float col[8] = {o[0][e], o[1][e], o[2][e], o[3][e], o[4][e], o[5][e], o[6][e], o[7][e]}; *(u32x4*)(dst + (size_t)e * 64) = pack8(col); } }
    }
    for (int row = NP + c.bid * 8 + c.wave; row < NR; row += c.G * 8) {
        const float* sp = st + (size_t)(row - NP) * 3 * 3072;
#pragma unroll 1
        for (int pass = 0; pass < 6; ++pass) {
            const int ch = pass * 512 + c.lane * 8; float f[8], cur[8];
            conv8(P + ch, 3072, row, -1, sp, 3072, cw, cb, ch, f, cur);
            conv_state8(row, -1, cur, sp, 3072, ch, pout, sout);
#pragma unroll
            for (int e = 0; e < 8; ++e) f[e] = siluf_(f[e]);
            if (pass < 4) *(u32x4*)(XSN + (size_t)(row - NP) * 2048 + ch) = pack8(f);
            else if (pass == 4) *(u32x4*)(BM + (size_t)row * 512 + c.lane * 8) = pack8(f);
            else *(u32x4*)(CM + (size_t)row * 512 + c.lane * 8) = pack8(f);
        }
    }
    for (int i = c.bid * 512 + c.tid; i < NR * 32; i += c.G * 512) DT[i] = softplusf_(DTR[i] + dt_bias[i & 31]);
    prompt_conv_state(c, P, 3072, 3072, pout);
}
DI void ssd_seq_phase(const Ctx& c, const bf16_t* XST, const bf16_t* BM, const bf16_t* CM, const bf16_t* BMT, const float* DT, const float* A_log, const float* Dsk, bf16_t* Y, float* pH,
                      const bf16_t* XSN, const float* H0, float* sH) {
    const int lr = c.lane & 15, quad = c.lane >> 4, w = c.wave;
    ldsp Cs = c.lds, Bs = c.lds + 17408, BTs = c.lds + 34816, XTs = c.lds + 53248, XDs = c.lds + 62464, XRs = c.lds + 71680, Ms = c.lds + 80896, Hs = c.lds + 90112;
    LAS float* DTs = (LAS float*)(c.lds + 107520); LAS float* ACs = DTs + 64;
    for (int it0 = c.bid; it0 < 256; it0 += c.G) {
        const int pr = (it0 & 7) * 4 + (it0 >> 6), b = pr >> 2, g = pr & 3, hd = g * 8 + ((it0 >> 3) & 7), item = b * 32 + hd; const float A = -__expf(A_log[hd]), Dk = Dsk[hd];
        f32x4 hacc[4];
#pragma unroll
        for (int i = 0; i < 4; ++i) hacc[i] = (f32x4){0.f, 0.f, 0.f, 0.f};
        __syncthreads();
        for (int i = c.tid; i < 17408 / 4; i += 512) ((LAS unsigned*)Hs)[i] = 0u;
        u32x4 pC[2], pB[2], pT[2], pX; float pdt = 0.f;
        auto fetch = [&](int n) { const int bn = b * 32 + n, r0 = b * SEQL + n * 64;
            if (c.tid < 64) pdt = DT[(size_t)(r0 + c.tid) * 32 + hd];
#pragma unroll
            for (int i = 0; i < 2; ++i) { const int ci = c.tid + i * 512, row = ci >> 4, cc = ci & 15; const size_t go = (size_t)(r0 + row) * 512 + g * 128 + cc * 8; pC[i] = *(const u32x4*)(CM + go); pB[i] = *(const u32x4*)(BM + go); }
#pragma unroll
            for (int i = 0; i < 2; ++i) { const int ci = c.tid + i * 512, row = ci >> 3, cc = ci & 7; pT[i] = *(const u32x4*)(BMT + ((size_t)bn * 512 + g * 128 + row) * 64 + cc * 8); }
            pX = *(const u32x4*)(XST + ((size_t)bn * 2048 + hd * 64 + (c.tid >> 3)) * 64 + (c.tid & 7) * 8); };
        fetch(0);
        const int sp_ = c.tid >> 3, snp = c.tid & 7; LAS float* SBf = (LAS float*)(c.lds + 108032);
        f32x4 shc[4]; bf16_t sbc = 0; float sdt = 0.f, sxv = 0.f; int sit = NS * 32;
#pragma unroll
        for (int i = 0; i < 4; ++i) shc[i] = (f32x4){0.f, 0.f, 0.f, 0.f};
#pragma unroll 1
        for (int n = 0; n < 32; ++n) {
            const int r0 = b * SEQL + n * 64;
            if (c.tid < 64) { const float dt = pdt; float ac = dt * A;
#pragma unroll
                for (int o = 1; o < 64; o <<= 1) { const float v = __shfl_up(ac, o); if (c.lane >= o) ac += v; }
                DTs[c.tid] = dt; ACs[c.tid] = ac; }
#pragma unroll
            for (int i = 0; i < 2; ++i) { const int ci = c.tid + i * 512, row = ci >> 4, cc = ci & 15; *(LAS u32x4*)(Cs + row * 272 + cc * 16) = pC[i]; *(LAS u32x4*)(Bs + row * 272 + cc * 16) = pB[i]; }
#pragma unroll
            for (int i = 0; i < 2; ++i) { const int ci = c.tid + i * 512, row = ci >> 3, cc = ci & 7; *(LAS u32x4*)(BTs + row * 144 + cc * 16) = pT[i]; }
            const int xrow = c.tid >> 3, xcc = c.tid & 7; const u32x4 xraw = pX;
            LDS_BAR();
            if ((n & 1) == 0) {
                sit = (it0 == c.bid) ? c.bid + (n >> 1) * c.G : NS * 32;
                if (sit < NS * 32) { const int s2 = sit >> 5, hd2 = sit & 31, g2 = hd2 >> 3, row2 = NP + s2;
                    if (c.tid < 128) sbc = BM[(size_t)row2 * 512 + g2 * 128 + c.tid]; else if (c.tid < 256) sbc = CM[(size_t)row2 * 512 + g2 * 128 + c.tid - 128];
                    const float* hp = H0 + ((size_t)sit * 64 + sp_) * 128 + snp * 16;
#pragma unroll
                    for (int i = 0; i < 4; ++i) shc[i] = *(const f32x4*)(hp + 4 * i);
                    sdt = DT[(size_t)row2 * 32 + hd2]; sxv = bf2f(XSN[(size_t)s2 * 2048 + hd2 * 64 + sp_]); }
            } else if (sit < NS * 32) { const int s2 = sit >> 5, hd2 = sit & 31, row2 = NP + s2;
                const float ea = __expf(-sdt * __expf(A_log[hd2])), Dk2 = Dsk[hd2], xdt = sxv * sdt;
                float* ho = sH + ((size_t)sit * 64 + sp_) * 128 + snp * 16; float yo = 0.f, cbp = 0.f;
#pragma unroll
                for (int i = 0; i < 4; ++i) { f32x4 o4;
#pragma unroll
                    for (int e = 0; e < 4; ++e) { const int nn = snp * 16 + 4 * i + e; const float bv = SBf[nn], cv = SBf[128 + nn]; yo += cv * shc[i][e]; cbp += cv * bv; o4[e] = ea * shc[i][e] + xdt * bv; }
                    *(f32x4*)(ho + 4 * i) = o4; }
                yo += __shfl_xor(yo, 1); yo += __shfl_xor(yo, 2); yo += __shfl_xor(yo, 4); cbp += __shfl_xor(cbp, 1); cbp += __shfl_xor(cbp, 2); cbp += __shfl_xor(cbp, 4);
                if (snp == 0) Y[(size_t)row2 * 2048 + hd2 * 64 + sp_] = (bf16_t)f2bf(cbp * xdt + ea * yo + Dk2 * sxv);
            }
            if (n + 1 < 32) fetch(n + 1);
            { float f[8], fd[8]; unpack8(xraw, f); const float al = ACs[63];
#pragma unroll
                for (int e = 0; e < 8; ++e) { const int s = xcc * 8 + e; f[e] *= DTs[s]; fd[e] = f[e] * __expf(al - ACs[s]); }
                *(LAS u32x4*)(XRs + xrow * 144 + xcc * 16) = xraw; *(LAS u32x4*)(XTs + xrow * 144 + xcc * 16) = pack8(f); *(LAS u32x4*)(XDs + xrow * 144 + xcc * 16) = pack8(fd); }
            LDS_BAR();
            const int li = w >> 1; float acl[4];
#pragma unroll
            for (int jj = 0; jj < 4; ++jj) acl[jj] = ACs[li * 16 + quad * 4 + jj];
            f32x4 aoff[2];
#pragma unroll
            for (int q2 = 0; q2 < 2; ++q2) { const int sj = 2 * (w & 1) + q2;
                if (sj <= li) { f32x4 a = {0.f, 0.f, 0.f, 0.f};
#pragma unroll
                    for (int ks = 0; ks < 4; ++ks) a = MFMA16(*(const LAS bf16x8*)(Cs + (li * 16 + lr) * 272 + ks * 64 + quad * 16), *(const LAS bf16x8*)(Bs + (sj * 16 + lr) * 272 + ks * 64 + quad * 16), a);
                    const int s = sj * 16 + lr; const float as = ACs[s];
#pragma unroll
                    for (int jj = 0; jj < 4; ++jj) { const int l = li * 16 + quad * 4 + jj; *(LAS bf16_t*)(Ms + l * 144 + s * 2) = (bf16_t)f2bf(l >= s ? a[jj] * __expf(acl[jj] - as) : 0.f); }
                } else {
#pragma unroll
                    for (int jj = 0; jj < 4; ++jj) *(LAS bf16_t*)(Ms + (li * 16 + quad * 4 + jj) * 144 + (sj * 16 + lr) * 2) = 0;
                }
                const int pj = 2 * (w & 1) + q2; f32x4 a2 = {0.f, 0.f, 0.f, 0.f};
#pragma unroll
                for (int ks = 0; ks < 4; ++ks) a2 = MFMA16(*(const LAS bf16x8*)(Cs + (li * 16 + lr) * 272 + ks * 64 + quad * 16), *(const LAS bf16x8*)(Hs + (pj * 16 + lr) * 272 + ks * 64 + quad * 16), a2);
                aoff[q2] = a2; }
            LDS_BAR();
#pragma unroll
            for (int q2 = 0; q2 < 2; ++q2) { const int pj = 2 * (w & 1) + q2; f32x4 a = {0.f, 0.f, 0.f, 0.f};
#pragma unroll
                for (int ks = 0; ks < 2; ++ks) a = MFMA16(*(const LAS bf16x8*)(Ms + (li * 16 + lr) * 144 + ks * 64 + quad * 16), *(const LAS bf16x8*)(XTs + (pj * 16 + lr) * 144 + ks * 64 + quad * 16), a);
                const u32x2 xr = *(const LAS u32x2*)(XRs + (pj * 16 + lr) * 144 + (li * 16 + quad * 4) * 2); const float xv[4] = {lo16(xr.x), hi16(xr.x), lo16(xr.y), hi16(xr.y)};
#pragma unroll
                for (int jj = 0; jj < 4; ++jj) { const float yv = a[jj] + __expf(acl[jj]) * aoff[q2][jj] + Dk * xv[jj];
                    Y[(size_t)(r0 + li * 16 + quad * 4 + jj) * 2048 + hd * 64 + pj * 16 + lr] = (bf16_t)f2bf(yv); } }
            { const float cd = __expf(ACs[63]);
#pragma unroll
                for (int pj = 0; pj < 4; ++pj) { hacc[pj] = hacc[pj] * cd;
#pragma unroll
                    for (int ks = 0; ks < 2; ++ks) hacc[pj] = MFMA16(*(const LAS bf16x8*)(BTs + (w * 16 + lr) * 144 + ks * 64 + quad * 16), *(const LAS bf16x8*)(XDs + (pj * 16 + lr) * 144 + ks * 64 + quad * 16), hacc[pj]); } }
            LDS_BAR();
#pragma unroll
            for (int pj = 0; pj < 4; ++pj) { u32x2 wv; wv.x = pk2(hacc[pj][0], hacc[pj][1]); wv.y = pk2(hacc[pj][2], hacc[pj][3]); *(LAS u32x2*)(Hs + (pj * 16 + lr) * 272 + (w * 16 + quad * 4) * 2) = wv; }
            if ((n & 1) == 0 && sit < NS * 32 && c.tid < 256) SBf[c.tid] = bf2f(sbc);
        }
#pragma unroll
        for (int pj = 0; pj < 4; ++pj) *(f32x4*)(pH + ((size_t)item * 64 + pj * 16 + lr) * 128 + w * 16 + quad * 4) = hacc[pj];
    }
    LAS float* Bf = (LAS float*)c.lds; LAS float* Cf = Bf + 128;
    {
        const int p = c.tid >> 3, np = c.tid & 7;
        f32x4 hn[4];
        const int it0 = c.bid < 256 ? c.bid + 16 * c.G : c.bid;
        if (it0 < NS * 32) { const float* hp = H0 + ((size_t)it0 * 64 + p) * 128 + np * 16;
#pragma unroll
            for (int i = 0; i < 4; ++i) hn[i] = *(const f32x4*)(hp + 4 * i); }
#pragma unroll 1
        for (int it = it0; it < NS * 32; it += c.G) {
            const int s = it >> 5, hd = it & 31, g = hd >> 3, row = NP + s;
            f32x4 hc[4];
#pragma unroll
            for (int i = 0; i < 4; ++i) hc[i] = hn[i];
            if (it + c.G < NS * 32) { const float* hp = H0 + ((size_t)(it + c.G) * 64 + p) * 128 + np * 16;
#pragma unroll
                for (int i = 0; i < 4; ++i) hn[i] = *(const f32x4*)(hp + 4 * i); }
            __syncthreads();
            if (c.tid < 128) Bf[c.tid] = bf2f(BM[(size_t)row * 512 + g * 128 + c.tid]); else if (c.tid < 256) Cf[c.tid - 128] = bf2f(CM[(size_t)row * 512 + g * 128 + c.tid - 128]);
            const float dt = DT[(size_t)row * 32 + hd], ea = __expf(-dt * __expf(A_log[hd])), Dk = Dsk[hd];
            const float xv = bf2f(XSN[(size_t)s * 2048 + hd * 64 + p]), xdt = xv * dt;
            __syncthreads();
            float* ho = sH + ((size_t)it * 64 + p) * 128 + np * 16;
            float yo = 0.f, cbp = 0.f;
#pragma unroll
            for (int i = 0; i < 4; ++i) { f32x4 o4;
#pragma unroll
                for (int e = 0; e < 4; ++e) { const int nn = np * 16 + 4 * i + e; const float bv = Bf[nn], cv = Cf[nn]; yo += cv * hc[i][e]; cbp += cv * bv; o4[e] = ea * hc[i][e] + xdt * bv; }
                *(f32x4*)(ho + 4 * i) = o4; }
            yo += __shfl_xor(yo, 1); yo += __shfl_xor(yo, 2); yo += __shfl_xor(yo, 4); cbp += __shfl_xor(cbp, 1); cbp += __shfl_xor(cbp, 2); cbp += __shfl_xor(cbp, 4);
            if (np == 0) Y[(size_t)row * 2048 + hd * 64 + p] = (bf16_t)f2bf(cbp * xdt + ea * yo + Dk * xv);
        }
    }
}
DI void ssd_post_phase(const Ctx& c, const bf16_t* Y, const bf16_t* ZB, const float* ng, bf16_t* YN) {
    for (int row = c.bid * 8 + c.wave; row < NR; row += c.G * 8) {
#pragma unroll
        for (int gi = 0; gi < 4; ++gi) { const int col = gi * 512 + c.lane * 8; float y[8], z[8];
            unpack8(*(const u32x4*)(Y + (size_t)row * 2048 + col), y); unpack8(*(const u32x4*)(ZB + (size_t)row * 2048 + col), z);
            float ss = 0.f;
#pragma unroll
            for (int e = 0; e < 8; ++e) { y[e] *= siluf_(z[e]); ss += y[e] * y[e]; }
            const float rstd = rsqrtf(wave_sum(ss) * (1.0f / 512.0f) + EPS);
#pragma unroll
            for (int e = 0; e < 8; ++e) y[e] = y[e] * rstd * ng[col + e];
            *(u32x4*)(YN + (size_t)row * 2048 + col) = pack8(y); }
    }
}
template <class Epi> DI void run_gemm(const Ctx& c, const bf16_t* A, int lda, const bf16_t* Bt, int ldb, int M, int N, int K, int ksh, int kmul, const Epi& E, int kmulb = 0, int bmask = 0x7fffffff) {
    asm volatile("" : "+s"(K));
    pg8::Gemm g{A, Bt, M, N, K, lda, ldb, ksh, kmul, kmulb, bmask}; pg8::StaticOrder S; S.init(M, N, c.G, c.bid);
    pg8::gemm_phase<Epi, pg8::StaticOrder>(c.lds, g, S, E, c.tid);
}
DI void res_gemm(const Ctx& c, const bf16_t* A, const bf16_t* Bt, int K, const float* bp, float* X, const float* gate, const float* nsc, const float* nsh, bf16_t* UB, float* xs, unsigned* cnt) {
    if (nsc != nullptr) { EpiResNorm E{bp, X, gate, nsc, nsh, UB, xs, cnt}; run_gemm(c, A, K, Bt, K, NP, 1024, K, 0, 0, E); }
    else { EpiRes E{bp, X + (size_t)NP * D, X, gate}; run_gemm(c, A, K, Bt, K, NP, 1024, K, 0, 0, E); }
    { const int ks = K >= 4096 ? 1024 : 512;
      EpiResAtomic E{X, gate}; run_gemm(c, A + (size_t)NP * K, K, Bt, K, 256, 1024 * (K / ks), ks, 2, ks, E, ks, 3); }
}
#define B_X ((float*)(ws + WS_X))
#define B_UB ((bf16_t*)(ws + WS_UB))
#define B_P ((bf16_t*)(ws + WS_P))
#define B_S (ws + WS_S)
#define B_MOD ((float*)(ws + WS_MOD))
#define B_MODL (B_MOD + (size_t)L * NSEQ * MODW)
#define B_XP (L == 0 ? GIN(0) : (const float*)B_X)
#define B_XS (L == 0 ? GIN(1) : (const float*)(B_X + (size_t)NP * D))
#define B_XB ((bf16_t*)B_S)
#define B_LA ((float*)(B_S + (size_t)RP * 1024 * 2))
#define B_BX ((float*)(B_S + (size_t)RP * 1024 * 6))
#define B_Q ((bf16_t*)B_S)
#define B_K (B_Q + (size_t)RP * D)
#define B_V (B_Q + (size_t)2 * RP * D)
#define B_GATE (B_Q + (size_t)3 * RP * D)
#define B_QKG (B_Q + (size_t)4 * RP * D)
#define B_AB ((float*)(ws + WS_AB))
#define B_GB ((float*)(ws + WS_GB))
#define B_GL ((float*)(ws + WS_GL))
#define B_QKVS ((bf16_t*)(ws + WS_QKVS))
#define B_UT ((float*)B_P)
#define B_NW ((bf16_t*)(ws + WS_P + (size_t)NP * D * 4))
#define B_QD (B_NW + (size_t)NP * D)
#define B_KDT (B_NW + (size_t)2 * NP * D)
#define B_OF ((float*)B_S)
#define B_XST ((bf16_t*)B_S)
#define B_BM (B_XST + (size_t)NP * 2048)
#define B_CM (B_BM + (size_t)RP * 512)
#define B_BMT (B_CM + (size_t)RP * 512)
#define B_ZB (B_P + (size_t)RP * 3072)
#define B_YN ((bf16_t*)B_S)
#define B_DTR ((float*)(ws + WS_DTR))
#define B_DT ((float*)(ws + WS_DT))
#define B_XSN ((bf16_t*)(ws + WS_XSN))
__global__ void __launch_bounds__(512, 2) mega(Args a) {
    extern __shared__ __attribute__((aligned(16))) unsigned char lds_raw[];
    cg::grid_group grid = cg::this_grid();
    Ctx c0; c0.lds = (ldsp)lds_raw; c0.tid = threadIdx.x; c0.lane = c0.tid & 63; c0.wave = __builtin_amdgcn_readfirstlane(c0.tid >> 6); c0.bid = blockIdx.x; c0.G = gridDim.x;
    int ph = 0; const int lo = a.lo, hi = a.hi;
    volatile LAS unsigned* bst = (volatile LAS unsigned*)(c0.lds + 131072);
    if (c0.tid < 2) bst[c0.tid] = 0u;
    __syncthreads();
    XcdBarrier xbar; xbar.bar = (unsigned*)(a.ws + WS_BAR); xbar.x = 0; xbar.st = bst;
#ifndef REPMASK
#define REPMASK 0ull
#endif
#ifndef SYNCREP
#define SYNCREP 1
#endif
#define PH_BEGIN if (ph >= lo && ph < hi) { const int nrep_ = ((REPMASK >> ph) & 1ull) ? 2 : 1; for (int rep_ = 0; rep_ < nrep_; ++rep_) { if (rep_) xcd_barrier(xbar); const __attribute__((address_space(4))) Args* ap_ = (const __attribute__((address_space(4))) Args*)__builtin_amdgcn_kernarg_segment_ptr(); asm volatile("" : "+s"(ap_)); const __attribute__((address_space(4))) Args& a = *ap_; Ctx c = c0; GAS unsigned char* wsg_ = (GAS unsigned char*)a.ws; GAS float* outg_ = (GAS float*)a.out; asm volatile("" : "+s"(wsg_)); asm volatile("" : "+s"(outg_)); unsigned char* ws = (unsigned char*)wsg_; float* out = (float*)outg_; { int t_ = c0.tid; asm volatile("" : "+v"(t_)); asm volatile("" : "+s"(c.G)); asm volatile("" : "+s"(c.bid)); c.tid = t_; c.lane = t_ & 63; c.wave = __builtin_amdgcn_readfirstlane(t_ >> 6); } (void)out;
#define PH_END } if (ph + 1 < hi) { for (int s_ = 0; s_ < SYNCREP; ++s_) { if (ph == 0) { if (s_ == 0) { grid.sync(); xbar = xcd_barrier_post((unsigned*)(a.ws + WS_BAR), bst); } } else xcd_barrier(xbar); } } } ++ph;

    PH_BEGIN prep_phase(c, a, true);
#ifdef PREP2
    __syncthreads(); prep_phase(c, a, false);
#endif
    PH_END
    PH_BEGIN { EpiMod E{B_MOD, GIN(11)}; run_gemm(c, (const bf16_t*)(ws + WS_SC), 1024, B_P, 1024, 256, 4 * MODW, 1024, 0, 0, E); } PH_END
#pragma unroll 1
    for (int L = 0; L < 4; ++L) {
        const int kind = L % 3, j = L / 3;
        PH_BEGIN norm_mod_phase(c, B_XP, B_XS, B_MODL + 1024, B_MODL, B_UB, (L > 0 && c.G == 256) ? NP : 0); PH_END
        PH_BEGIN {
            EpiSplit E; const bf16_t* Bt; int N;
            if (kind == 0) { E = EpiSplit{1, B_P, 2048, 1024, B_P + 1024, 2048, 2048, nullptr, 0, 0}; Bt = (const bf16_t*)(ws + WS_RGIN) + (size_t)j * 2048 * 1024; N = 2048; }
            else if (kind == 1) { E = EpiSplit{0, B_P, 3072, 3072, B_GATE, 1024, 4096, B_AB, 16, 16}; Bt = (const bf16_t*)(ws + WS_GDNIN); N = GDN_NP; }
            else { E = EpiSplit{0, B_ZB, 2048, 2048, B_P, 3072, 5120, B_DTR, 32, 32}; Bt = (const bf16_t*)(ws + WS_SSDIN); N = SSD_NP; }
            run_gemm(c, B_UB, 1024, Bt, 1024, RP, N, 1024, 0, 0, E); } PH_END
        if (kind == 0) {
            PH_BEGIN rg_conv_phase(c, B_P, GIN(16) + j * 4 * D, GIN(17) + j * D, GIN(2) + (size_t)j * NS * 3 * D, B_XB, out + O_PRGC + j * 8 * 3 * D, out + O_SRGC + j * NS * 3 * D); PH_END
            PH_BEGIN { EpiGate E{B_XB, GIN(19) + j * 2 * D, (const float*)(ws + WS_LS8) + j * D, B_LA, B_BX}; run_gemm(c, B_XB, 1024, (const bf16_t*)(ws + WS_RGGATE) + (size_t)j * 2048 * 256, 256, RP, 2048, 256, 1, 256, E); } PH_END
            PH_BEGIN rg_scan_phase(c, B_LA, B_BX, B_P, GIN(3) + (size_t)j * NS * D, B_UB, out + O_PRGH + j * 8 * D, out + O_SRGH + j * NS * D); PH_END
        } else if (kind == 1) {
            PH_BEGIN gdn_conv_phase(c, B_P, GIN(23), GIN(4), B_AB, GIN(24), GIN(25), B_Q, B_K, B_V, B_QKVS, B_GB, out + O_PGDC, out + O_SGDC); PH_END
            PH_BEGIN gdn_prep_phase(c, B_Q, B_K, B_V, B_GB, B_UT, B_NW, B_QD, B_KDT, B_QKG, B_GL); PH_END
            PH_BEGIN gdn_seq_phase(c, B_UT, B_NW, B_QD, B_KDT, B_QKG, B_GL, B_OF, out + O_PGDS, B_QKVS, B_GB, GIN(5), out + O_SGDS); PH_END
            PH_BEGIN gdn_post_phase(c, B_OF, B_GATE, GIN(26), B_UB); PH_END
        } else {
            PH_BEGIN ssd_conv_phase(c, B_P, GIN(29), GIN(30), GIN(6), B_DTR, GIN(32), B_BM, B_CM, B_XSN, B_DT, B_XST, B_BMT, out + O_PSSC, out + O_SSSC); PH_END
            PH_BEGIN ssd_seq_phase(c, B_XST, B_BM, B_CM, B_BMT, B_DT, GIN(31), GIN(33), B_P, out + O_PSSH, B_XSN, GIN(7), out + O_SSSH); PH_END
            PH_BEGIN ssd_post_phase(c, B_P, B_ZB, GIN(34), B_YN); PH_END
        }
        PH_BEGIN {
            const bf16_t* oA = kind == 2 ? B_YN : B_UB; const int oK = kind == 2 ? 2048 : 1024;
            const bf16_t* oB = kind == 0 ? (const bf16_t*)(ws + WS_RGOUT) + (size_t)j * 1024 * 1024 : (kind == 1 ? (const bf16_t*)(ws + WS_GDNOUT) : (const bf16_t*)(ws + WS_SSDOUT));
            const bool fuse = c.G == 256;
            res_gemm(c, oA, oB, oK, B_XP, B_X, B_MODL + 2048, fuse ? B_MODL + 4 * 1024 : nullptr, B_MODL + 3 * 1024, B_UB, (float*)(ws + WS_XS), (unsigned*)(ws + WS_CNT) + (size_t)(2 * L) * 4096); } PH_END
        PH_BEGIN norm_mod_phase(c, B_X, B_X + (size_t)NP * D, B_MODL + 4 * 1024, B_MODL + 3 * 1024, B_UB, c.G == 256 ? NP : 0); PH_END
        PH_BEGIN { EpiSplit E{2, B_P, 4096, 4096, nullptr, 0, 4096, nullptr, 0, 0}; run_gemm(c, B_UB, 1024, (const bf16_t*)(ws + WS_WUP) + (size_t)L * 4096 * 1024, 1024, RP, 4096, 1024, 0, 0, E); } PH_END
        PH_BEGIN { const bool fuse = c.G == 256 && L < 3; const float* modN = B_MOD + (size_t)(L + 1) * NSEQ * MODW;
            res_gemm(c, B_P, (const bf16_t*)(ws + WS_WDN) + (size_t)L * 4096 * 1024, 4096, B_X, B_X, B_MODL + 5 * 1024, fuse ? modN + 1024 : nullptr, modN, B_UB, (float*)(ws + WS_XS), (unsigned*)(ws + WS_CNT) + (size_t)(2 * L + 1) * 4096); } PH_END
    }
    PH_BEGIN final_norm_phase(c, B_X, GIN(14), out + O_Y); PH_END
}
constexpr int N_PHASES = 40;

extern "C" void kernel_launch(void* const* d_in, const int* in_sizes, int n_in, void* d_out, int out_size, void* d_ws, size_t ws_size, hipStream_t stream) {
    static int grid = 0;
    if (grid == 0) {
        int dev = 0, cus = 0, per_cu = 0;
        (void)hipGetDevice(&dev);
        (void)hipDeviceGetAttribute(&cus, hipDeviceAttributeMultiprocessorCount, dev);
        (void)hipFuncSetAttribute((const void*)mega, hipFuncAttributeMaxDynamicSharedMemorySize, LDS_BYTES);
        (void)hipOccupancyMaxActiveBlocksPerMultiprocessor(&per_cu, (const void*)mega, 512, LDS_BYTES);
        if (per_cu < 1) { fprintf(stderr, "kernel_launch: occupancy query reports %d blocks/CU\n", per_cu); }
        grid = cus > 0 ? cus : 256;
        if (ws_size < WS_END) { fprintf(stderr, "kernel_launch: workspace too small: need %zu, have %zu\n", (size_t)WS_END, ws_size); grid = -1; }
        if (n_in != 36) { fprintf(stderr, "kernel_launch: expected 36 inputs, got %d\n", n_in); grid = -1; }
    }
    if (grid < 0) return;
    Args a{};
    for (int i = 0; i < 36; ++i) a.in[i] = (const float*)d_in[i];
    a.out = (float*)d_out; a.ws = (unsigned char*)d_ws; a.lo = 0; a.hi = N_PHASES;
    void* args[] = {&a};
    hipError_t e = hipLaunchCooperativeKernel((const void*)mega, dim3(grid), dim3(512), args, LDS_BYTES, stream);
    if (e != hipSuccess) fprintf(stderr, "kernel_launch: cooperative launch failed: %s (grid %d)\n", hipGetErrorString(e), grid);
}
```

```cpp
#include <hip/hip_runtime.h>
#include <hip/hip_cooperative_groups.h>
#include <cstdio>
#include <type_traits>
namespace cg = cooperative_groups;

namespace pg8 {
#define PG8_LAS __attribute__((address_space(3)))
typedef unsigned short bf16_t;
typedef short bf16x8 __attribute__((ext_vector_type(8)));
typedef float f32x4 __attribute__((ext_vector_type(4)));
typedef unsigned u32x4 __attribute__((ext_vector_type(4)));
constexpr int BM = 256, BK = 64, HALF = 128, HTB = HALF * BK * 2  , STAGE_BYTES = 8 * HTB, NXCD = 8, WGM = 8;

__host__ __device__ __forceinline__ int lds_byte(int r, int c) { const int st = (r >> 4) * 2 + (c >> 5), rr = r & 15, cc = c & 31, ob = rr * 64 + cc * 2; return st * 1024 + (ob ^ (((ob >> 9) & 1) << 5)); }
__host__ __device__ __forceinline__ void stage_rc(int b, int& R, int& C) { const int st = b / 1024, sb = b % 1024, swz = sb ^ (((sb >> 9) & 1) << 5); R = (st >> 1) * 16 + swz / 64; C = (st & 1) * 32 + (swz % 64) / 2; }
__host__ __device__ __forceinline__ int perm32(int rho) { const int n = rho >> 4, i = rho & 15; return 8 * (i >> 2) + 4 * n + (i & 3); }

struct Unit { int pm, pn; };
struct Gemm { const bf16_t* A; const bf16_t* Bt; int M, N, K, lda, ldb, ksh, kmul, kmulb, bmask; };

struct StaticOrder {
    int nM, nN, nwg, G, c;
    __host__ __device__ void init(int M, int N, int G_, int c_) { nM = M / BM; nN = N / BM; nwg = nM * nN; G = G_; c = c_; }
    __host__ __device__ bool next(int i, Unit& u) const {
        const long L = (long)i * G + c; if (L >= nwg) return false;
        int wgid = (int)L; { const int q = nwg / NXCD, r = nwg % NXCD, xcd = wgid % NXCD, off = wgid / NXCD; wgid = (xcd < r ? xcd * (q + 1) : r * (q + 1) + (xcd - r) * q) + off; }
        const int nig = WGM * nN, gid = wgid / nig, fm = gid * WGM, gsz = (nM - fm) < WGM ? (nM - fm) : WGM;
        u.pm = fm + ((wgid % nig) % gsz); u.pn = (wgid % nig) / gsz; return true;
    }
    __device__ __forceinline__ void a_ready(const Unit&) const {}
    __device__ __forceinline__ void done(const Unit&) const {}
};
__device__ __forceinline__ unsigned cvt_pk_bf16(float lo, float hi) { unsigned r; asm volatile("v_cvt_pk_bf16_f32 %0, %1, %2" : "=v"(r) : "v"(lo), "v"(hi)); return r; }
typedef float f32x2 __attribute__((ext_vector_type(2)));
template <class Epi, class Sched>
__device__ __forceinline__ void gemm_phase(PG8_LAS unsigned char* lds, const Gemm g, const Sched& S, const Epi& E, const int tid_in) {
    const int tid = tid_in, wid = __builtin_amdgcn_readfirstlane(tid >> 6), lane = tid & 63, wr = wid >> 2, wc = wid & 3, fr = lane & 15, fq = lane >> 4;
    const int K = g.K, nt = K / BK;

    unsigned voffA[2], voffB[2];
#pragma unroll
    for (int i = 0; i < 2; ++i) { int R, C; stage_rc(tid * 16 + i * 8192, R, C); const int Rb = Epi::PERM ? ((R & ~31) + perm32(R & 31)) : R;
        voffA[i] = (unsigned)(R * g.lda + C) * 2u; voffB[i] = (unsigned)(Rb * g.ldb + C) * 2u; }
    const size_t kstep = (size_t)(BK * 2);
    const size_t hstepA = (size_t)HALF * g.lda * 2, hstepB = (size_t)HALF * g.ldb * 2;
    const size_t tstepA = 2 * hstepA, tstepB = 2 * hstepB;
    const unsigned ldsw = (unsigned)wid * 1024u;
    const int aoff = lds_byte(wr * 64 + fr, fq * 8), boff = lds_byte(wc * 32 + fr, fq * 8);
#define PG8_SA(b, h) (((b) * 2 + (h)) * HTB)
#define PG8_SB(b, h) ((4 + (b) * 2 + (h)) * HTB)
#define PG8_STAGE(bufoff, gbase, voff) do { _Pragma("unroll") for (int _i = 0; _i < 2; ++_i) \
        __builtin_amdgcn_global_load_lds((const unsigned*)((const char*)(gbase) + (voff)[_i]), (PG8_LAS unsigned*)(lds + (bufoff) + ldsw + _i * 8192), 16, 0, 0); } while (0)
#define PG8_LDA(dst, b, h) do { _Pragma("unroll") for (int m = 0; m < 4; ++m) _Pragma("unroll") for (int k = 0; k < 2; ++k) dst[m][k] = *(const PG8_LAS bf16x8*)(lds + PG8_SA(b, h) + aoff + m * 2048 + k * 1024); } while (0)
#define PG8_LDB(dst, b, h) do { _Pragma("unroll") for (int n = 0; n < 2; ++n) _Pragma("unroll") for (int k = 0; k < 2; ++k) dst[n][k] = *(const PG8_LAS bf16x8*)(lds + PG8_SB(b, h) + boff + n * 2048 + k * 1024); } while (0)
#define PG8_MMA(ai, bj, At, Bt) do { __builtin_amdgcn_s_setprio(1); _Pragma("unroll") for (int m = 0; m < 4; ++m) _Pragma("unroll") for (int n = 0; n < 2; ++n) _Pragma("unroll") for (int k = 0; k < 2; ++k) \
        acc[ai][bj][m][n] = __builtin_amdgcn_mfma_f32_16x16x32_bf16(Bt[n][k], At[m][k], acc[ai][bj][m][n], 0, 0, 0); __builtin_amdgcn_s_setprio(0); } while (0)
#define PG8_WAIT_V(n) asm volatile("s_waitcnt vmcnt(" #n ")" ::: "memory")
#define PG8_WAIT_L(n) asm volatile("s_waitcnt lgkmcnt(" #n ")" ::: "memory")
#define PG8_BAR __builtin_amdgcn_s_barrier()
#define PG8_SCHED __builtin_amdgcn_sched_barrier(0)
    Unit cur, nxt; int ui = 0;
    if (!S.next(0, cur)) return;
    f32x4 acc[2][2][4][2];
#pragma unroll
    for (int a = 0; a < 2; ++a)
#pragma unroll
        for (int b = 0; b < 2; ++b)
#pragma unroll
            for (int m = 0; m < 4; ++m)
#pragma unroll
                for (int n = 0; n < 2; ++n) acc[a][b][m][n] = (f32x4){0.f, 0.f, 0.f, 0.f};
    bf16x8 At[4][2], B0[2][2], B1[2][2];
    const char* cA = (const char*)g.A + (size_t)cur.pm * tstepA + (size_t)((cur.pn >> g.ksh) * g.kmul) * 2; const char* cB = (const char*)g.Bt + (size_t)(cur.pn & g.bmask) * tstepB + (size_t)((cur.pn >> g.ksh) * g.kmulb) * 2;
    S.a_ready(cur);
    PG8_STAGE(PG8_SB(0, 0), cB, voffB); PG8_STAGE(PG8_SA(0, 0), cA, voffA); PG8_STAGE(PG8_SB(0, 1), cB + hstepB, voffB); PG8_STAGE(PG8_SA(0, 1), cA + hstepA, voffA);
    if (wr == 1) PG8_BAR;
    PG8_WAIT_V(4); PG8_BAR;
    PG8_STAGE(PG8_SB(1, 0), cB + kstep, voffB); PG8_STAGE(PG8_SA(1, 0), cA + kstep, voffA); PG8_STAGE(PG8_SB(1, 1), cB + hstepB + kstep, voffB);
    PG8_WAIT_V(6); PG8_BAR;

    for (;;) {
        const bool has_next = S.next(ui + 1, nxt);
        const char* nA = has_next ? (const char*)g.A + (size_t)nxt.pm * tstepA + (size_t)((nxt.pn >> g.ksh) * g.kmul) * 2 : cA; const char* nB = has_next ? (const char*)g.Bt + (size_t)(nxt.pn & g.bmask) * tstepB + (size_t)((nxt.pn >> g.ksh) * g.kmulb) * 2 : cB;
        for (int t = 0; t < nt; t += 2) {
            const bool last = (t == nt - 2);
            const char* a1 = cA + (size_t)(t + 1) * kstep;
            const char* a2 = last ? nA : cA + (size_t)(t + 2) * kstep; const char* b2 = last ? nB : cB + (size_t)(t + 2) * kstep;
            const char* a3 = a2 + kstep; const char* b3 = b2 + kstep;
            if (last && has_next) S.a_ready(nxt);
            PG8_LDB(B0, 0, 0); PG8_SCHED; PG8_LDA(At, 0, 0); PG8_STAGE(PG8_SA(1, 1), a1 + hstepA, voffA);
            PG8_WAIT_L(8); PG8_BAR; PG8_WAIT_L(0); PG8_MMA(0, 0, At, B0); PG8_BAR; PG8_SCHED;
            PG8_LDB(B1, 0, 1); PG8_STAGE(PG8_SB(0, 0), b2, voffB);
            PG8_BAR; PG8_WAIT_L(0); PG8_MMA(0, 1, At, B1); PG8_BAR;
            PG8_LDA(At, 0, 1); PG8_STAGE(PG8_SA(0, 0), a2, voffA);
            PG8_BAR; PG8_WAIT_L(0); PG8_MMA(1, 0, At, B0); PG8_BAR; PG8_SCHED;
            PG8_STAGE(PG8_SB(0, 1), b2 + hstepB, voffB);
            PG8_WAIT_V(6); PG8_BAR; PG8_MMA(1, 1, At, B1); PG8_BAR;
            PG8_LDB(B0, 1, 0); PG8_SCHED; PG8_LDA(At, 1, 0); PG8_STAGE(PG8_SA(0, 1), a2 + hstepA, voffA);
            PG8_WAIT_L(8); PG8_BAR; PG8_WAIT_L(0); PG8_MMA(0, 0, At, B0); PG8_BAR; PG8_SCHED;
            PG8_LDB(B1, 1, 1); PG8_STAGE(PG8_SB(1, 0), b3, voffB);
            PG8_BAR; PG8_WAIT_L(0); PG8_MMA(0, 1, At, B1); PG8_BAR;
            PG8_LDA(At, 1, 1); PG8_STAGE(PG8_SA(1, 0), a3, voffA);
            PG8_BAR; PG8_WAIT_L(0); PG8_MMA(1, 0, At, B0); PG8_BAR; PG8_SCHED;
            PG8_STAGE(PG8_SB(1, 1), b3 + hstepB, voffB);
            PG8_WAIT_V(6); PG8_BAR; PG8_MMA(1, 1, At, B1); PG8_BAR;
        }

        if constexpr (!Epi::AFTER_DRAIN) { E(acc, cur, wr, wc, fr, fq); S.done(cur); }

        if (!has_next) break;
#pragma unroll
        for (int a = 0; a < 2; ++a)
#pragma unroll
            for (int b = 0; b < 2; ++b)
#pragma unroll
                for (int m = 0; m < 4; ++m)
#pragma unroll
                    for (int n = 0; n < 2; ++n) acc[a][b][m][n] = (f32x4){0.f, 0.f, 0.f, 0.f};
        cur = nxt; cA = nA; cB = nB; ++ui;
    }
    PG8_WAIT_V(0);
    if (wr == 0) PG8_BAR;
    PG8_BAR;
    if constexpr (Epi::AFTER_DRAIN) { E.fused(acc, cur, wr, wc, fr, fq, lds, wid, lane); S.done(cur); }

#undef PG8_SA
#undef PG8_SB
#undef PG8_STAGE
#undef PG8_LDA
#undef PG8_LDB
#undef PG8_MMA
#undef PG8_WAIT_V
#undef PG8_WAIT_L
#undef PG8_BAR
#undef PG8_SCHED
}
}
using pg8::bf16_t; using pg8::bf16x8; using pg8::f32x4; using pg8::u32x4; using pg8::f32x2;
typedef unsigned u32x2 __attribute__((ext_vector_type(2)));
#define LAS __attribute__((address_space(3)))
#define GAS __attribute__((address_space(1)))
#define GIN(k) ((const float*)(const GAS float*)a.in[k])
typedef LAS unsigned char* ldsp;
#define DI __device__ __forceinline__
#define LDS_BAR() do { asm volatile("s_waitcnt lgkmcnt(0)" ::: "memory"); __builtin_amdgcn_s_barrier(); asm volatile("" ::: "memory"); } while (0)
#define MFMA16(a, b, c) __builtin_amdgcn_mfma_f32_16x16x32_bf16((a), (b), (c), 0, 0, 0)

constexpr int D = 1024, NP = 16384, NS = 128, NR = NP + NS, RP = 16640, SEQL = 2048, NSEQ = 136, MODW = 6144;
constexpr int GDN_N = 4112, GDN_NP = 4352, SSD_N = 5152, SSD_NP = 5376;
constexpr float EPS = 1e-6f;
constexpr int LDS_BYTES = 132096;
constexpr size_t al256(size_t x) { return (x + 255) & ~(size_t)255; }
constexpr size_t WS_WUP = 0;
constexpr size_t WS_WDN = WS_WUP + (size_t)4 * 4096 * 1024 * 2;
constexpr size_t WS_RGIN = WS_WDN + (size_t)4 * 4096 * 1024 * 2;
constexpr size_t WS_RGGATE = WS_RGIN + (size_t)2 * 2048 * 1024 * 2;
constexpr size_t WS_RGOUT = WS_RGGATE + (size_t)2 * 2048 * 256 * 2;
constexpr size_t WS_GDNIN = WS_RGOUT + (size_t)2 * 1024 * 1024 * 2;
constexpr size_t WS_GDNOUT = WS_GDNIN + (size_t)GDN_NP * 1024 * 2;
constexpr size_t WS_SSDIN = WS_GDNOUT + (size_t)1024 * 1024 * 2;
constexpr size_t WS_SSDOUT = WS_SSDIN + (size_t)SSD_NP * 1024 * 2;
constexpr size_t WS_SC = WS_SSDOUT + (size_t)1024 * 2048 * 2;
constexpr size_t WS_MOD = WS_SC + (size_t)256 * 1024 * 2;
constexpr size_t WS_AB = al256(WS_MOD + (size_t)4 * NSEQ * MODW * 4);
constexpr size_t WS_GB = WS_AB + (size_t)RP * 16 * 4;
constexpr size_t WS_DTR = WS_GB + (size_t)RP * 16 * 4;
constexpr size_t WS_DT = WS_DTR + (size_t)RP * 32 * 4;
constexpr size_t WS_GL = WS_DT + (size_t)RP * 32 * 4;
constexpr size_t WS_XSN = WS_GL + 2048 * 4;
constexpr size_t WS_QKVS = WS_XSN + (size_t)128 * 2048 * 2;
constexpr size_t WS_LS8 = WS_QKVS + (size_t)3 * 128 * 1024 * 2;
constexpr size_t WS_BAR = al256(WS_LS8 + 2 * 1024 * 4);
constexpr size_t WS_XS = al256(WS_BAR + 16384);
constexpr size_t WS_CNT = WS_XS + (size_t)NP * 4 * 4;
constexpr size_t WS_X = al256(WS_CNT + (size_t)8 * 64 * 64 * 4);
constexpr size_t WS_UB = WS_X + (size_t)RP * 1024 * 4;
constexpr size_t WS_P = WS_UB + (size_t)RP * 1024 * 2;
constexpr size_t P_BYTES = (size_t)RP * 5120 * 2;
constexpr size_t WS_S = WS_P + P_BYTES;
constexpr size_t S_BYTES = (size_t)RP * 1024 * 10;
constexpr size_t WS_END = WS_S + S_BYTES;
constexpr int O_Y = 0, O_PRGC = 16908288, O_PRGH = O_PRGC + 49152, O_PGDC = O_PRGH + 16384, O_PGDS = O_PGDC + 73728, O_PSSC = O_PGDS + 1048576, O_PSSH = O_PSSC + 73728,
              O_SRGC = O_PSSH + 2097152, O_SRGH = O_SRGC + 786432, O_SGDC = O_SRGH + 262144, O_SGDS = O_SGDC + 1179648, O_SSSC = O_SGDS + 16777216, O_SSSH = O_SSSC + 1179648;

struct Args { const float* in[36]; float* out; unsigned char* ws; int lo, hi; };
struct Ctx { ldsp lds; int tid, lane, wave, bid, G; };

DI float bf2f(unsigned short b) { return __uint_as_float(((unsigned)b) << 16); }
DI unsigned pk2(float lo, float hi) { typedef float f2_ __attribute__((ext_vector_type(2))); typedef __bf16 b2_ __attribute__((ext_vector_type(2))); const b2_ r = __builtin_convertvector((f2_){lo, hi}, b2_); return __builtin_bit_cast(unsigned, r); }
DI unsigned f2bf(float f) { return pk2(f, f) & 0xffffu; }
DI float lo16(unsigned w) { return __uint_as_float(w << 16); }
DI float hi16(unsigned w) { return __uint_as_float(w & 0xffff0000u); }
DI void unpack8(u32x4 w, float* f) { f[0] = lo16(w.x); f[1] = hi16(w.x); f[2] = lo16(w.y); f[3] = hi16(w.y); f[4] = lo16(w.z); f[5] = hi16(w.z); f[6] = lo16(w.w); f[7] = hi16(w.w); }
DI u32x4 pack8(const float* f) { u32x4 w; w.x = pk2(f[0], f[1]); w.y = pk2(f[2], f[3]); w.z = pk2(f[4], f[5]); w.w = pk2(f[6], f[7]); return w; }
DI float sigmoidf_(float x) { return __builtin_amdgcn_rcpf(1.0f + __expf(-x)); }
DI float siluf_(float x) { return x * __builtin_amdgcn_rcpf(1.0f + __expf(-x)); }
DI float softplusf_(float x) { return x > 20.f ? x : log1pf(__expf(x)); }
DI float gelu_tanh(float x) { const float y = 1.5957691216f * (x + 0.044715f * x * x * x); return x * __builtin_amdgcn_rcpf(1.0f + __expf(-y)); }
DI float wave_sum(float v) {
#pragma unroll
    for (int o = 1; o < 64; o <<= 1) v += __shfl_xor(v, o);
    return v;
}
DI int seq_of(int row) { int q = row < NP ? (row >> 11) : 8 + row - NP; return q > NSEQ - 1 ? NSEQ - 1 : q; }

#define XB_TMO      128
#define XB_XCNT(j)  (256  + 64 * (j))
#define XB_XSUB(j)  (1280 + 64 * (j))
#define XB_XGEN(j)  (2304 + 64 * (j))
#define XB_TOP      3328
#define XB_TOPGEN   3392
#define XCD_BAR_WORDS 3456
#define XB_SPIN_CAP (1u << 18)

__device__ __forceinline__ unsigned xb_ld(unsigned* p)              { return __hip_atomic_load(p, __ATOMIC_RELAXED, __HIP_MEMORY_SCOPE_AGENT); }
__device__ __forceinline__ unsigned xb_add(unsigned* p, unsigned v) { return __hip_atomic_fetch_add(p, v, __ATOMIC_RELAXED, __HIP_MEMORY_SCOPE_AGENT); }
__device__ __forceinline__ unsigned xb_xcc_id() { return (unsigned)__builtin_amdgcn_s_getreg((3 << 11) | 20) & 0xFu; }
#define XB_SPIN(cond, bar) do { unsigned _sp = 0; while (cond) { __builtin_amdgcn_s_sleep(1); \
    if ((++_sp & 255u) == 0u) { if (xb_ld(&(bar)[XB_TMO])) break; if (_sp > XB_SPIN_CAP) { atomicAdd(&(bar)[XB_TMO], 1u); break; } } } } while (0)

struct XcdBarrier {
    unsigned* bar; unsigned x;
    volatile LAS unsigned* st;
};

__device__ __forceinline__ XcdBarrier xcd_barrier_post(unsigned* bar, volatile LAS unsigned* st) {
    XcdBarrier b; b.bar = bar; b.x = xb_xcc_id(); b.st = st;
    if (threadIdx.x == 0) (void)xb_add(&bar[XB_XCNT(b.x)], 1u);
    return b;
}
__device__ __forceinline__ void xcd_barrier_complete(unsigned* bar, unsigned x, unsigned& nloc, unsigned& nx) {
    const unsigned G = gridDim.x * gridDim.y * gridDim.z;
    unsigned sum, cnt, mine, sp = 0u;
    for (;;) {
        sum = 0u; cnt = 0u; mine = 0u;
#pragma unroll
        for (unsigned j = 0; j < 16; ++j) { const unsigned c = xb_ld(&bar[XB_XCNT(j)]); sum += c; cnt += (c > 0u) ? 1u : 0u; mine = (j == x) ? c : mine; }
        if (sum == G) break;
        __builtin_amdgcn_s_sleep(1);
        if ((++sp & 255u) == 0u) { if (xb_ld(&bar[XB_TMO])) break; if (sp > XB_SPIN_CAP) { atomicAdd(&bar[XB_TMO], 1u); break; } }
    }
    nloc = mine > 0u ? mine : 1u; nx = cnt > 0u ? cnt : 1u;
}

__device__ __forceinline__ void xcd_barrier(const XcdBarrier& b) {
    asm volatile("s_waitcnt vmcnt(0)" ::: "memory");
    __syncthreads();
    if (threadIdx.x == 0) {
        unsigned* bar = b.bar;
        __builtin_amdgcn_s_waitcnt(0);
        unsigned nloc = b.st[0], nx = b.st[1];
        if (nloc == 0u) { xcd_barrier_complete(bar, b.x, nloc, nx); b.st[0] = nloc; b.st[1] = nx; }
        const unsigned old = xb_add(&bar[XB_XSUB(b.x)], 1u);
        const unsigned gen = old / nloc;
        if (old + 1u == (gen + 1u) * nloc) {
            __builtin_amdgcn_fence(__ATOMIC_RELEASE, "agent");
            asm volatile("s_waitcnt vmcnt(0)" ::: "memory");
            const unsigned og = xb_add(&bar[XB_TOP], 1u);
            const unsigned tg = og / nx;
            if (og + 1u == (tg + 1u) * nx) xb_add(&bar[XB_TOPGEN], 1u);
            else XB_SPIN(xb_ld(&bar[XB_TOPGEN]) == tg, bar);
            __builtin_amdgcn_fence(__ATOMIC_ACQUIRE, "agent");
            xb_add(&bar[XB_XGEN(b.x)], 1u);
            asm volatile("s_waitcnt vmcnt(0)" ::: "memory");
        } else {
            XB_SPIN(xb_ld(&bar[XB_XGEN(b.x)]) == gen, bar);
            __builtin_amdgcn_fence(__ATOMIC_ACQUIRE, "agent");
            asm volatile("s_waitcnt vmcnt(0)" ::: "memory");
        }
    }
    __syncthreads();
}

struct EpiMod {
    static constexpr bool PERM = false, AFTER_DRAIN = false;
    float* MOD; const float* bias;
    DI void operator()(const f32x4 (&acc)[2][2][4][2], const pg8::Unit& u, int wr, int wc, int fr, int fq) const {
        const int row0 = u.pm * 256 + wr * 64 + fr, col0 = u.pn * 256 + wc * 32 + 4 * fq;
#pragma unroll
        for (int ai = 0; ai < 2; ++ai)
#pragma unroll
            for (int m = 0; m < 4; ++m) { const int row = row0 + ai * 128 + m * 16;
                if (row < NSEQ) {
#pragma unroll
                    for (int bj = 0; bj < 2; ++bj)
#pragma unroll
                        for (int n = 0; n < 2; ++n) { const int col = col0 + bj * 128 + n * 16, layer = col / MODW, c = col - layer * MODW;
                            *(f32x4*)(MOD + ((size_t)layer * NSEQ + row) * MODW + c) = acc[ai][bj][m][n] + *(const f32x4*)(bias + col); } } }
    }
};
struct EpiRes {
    static constexpr bool PERM = false, AFTER_DRAIN = false;
    const float* bp; const float* bs; float* X; const float* gate;
    DI void operator()(const f32x4 (&acc)[2][2][4][2], const pg8::Unit& u, int wr, int wc, int fr, int fq) const {
        const int row0 = u.pm * 256 + wr * 64 + fr, col0 = u.pn * 256 + wc * 32 + 4 * fq;
#pragma unroll
        for (int ai = 0; ai < 2; ++ai)
#pragma unroll
            for (int m = 0; m < 4; ++m) { const int row = row0 + ai * 128 + m * 16;
                if (row < NR) { const float* base = row < NP ? bp + (size_t)row * D : bs + (size_t)(row - NP) * D; const float* gp = gate + (size_t)seq_of(row) * MODW; float* o = X + (size_t)row * D;
#pragma unroll
                    for (int bj = 0; bj < 2; ++bj)
#pragma unroll
                        for (int n = 0; n < 2; ++n) { const int col = col0 + bj * 128 + n * 16;
                            *(f32x4*)(o + col) = *(const f32x4*)(base + col) + *(const f32x4*)(gp + col) * acc[ai][bj][m][n]; } }
                asm volatile("" ::: "memory"); }
    }
};
struct EpiResNorm {
    static constexpr bool PERM = false, AFTER_DRAIN = true;
    const float* bp; float* X; const float* gate; const float* sc; const float* sh; bf16_t* UB; float* xs; unsigned* cnt;
    DI void operator()(const f32x4 (&)[2][2][4][2], const pg8::Unit&, int, int, int, int) const {}
    DI void fused(f32x4 (&acc)[2][2][4][2], const pg8::Unit& u, int wr, int wc, int fr, int fq, PG8_LAS unsigned char* lds, int wid, int lane) const {
        LAS float* Pp = (LAS float*)lds; LAS float* Sr = (LAS float*)(lds + 8192);
        const int row0 = u.pm * 256 + wr * 64 + fr, col0 = u.pn * 256 + wc * 32 + 4 * fq; const int q = (u.pm * 256) >> 11;
        const float* gp = gate + (size_t)q * MODW + col0;
#pragma unroll
        for (int ai = 0; ai < 2; ++ai)
#pragma unroll
            for (int m = 0; m < 4; ++m) { int row = row0 + ai * 128 + m * 16; asm volatile("" : "+v"(row)); const float* base = bp + (size_t)row * D + col0; float* o = X + (size_t)row * D + col0; float s = 0.f;
#pragma unroll
                for (int bj = 0; bj < 2; ++bj)
#pragma unroll
                    for (int n = 0; n < 2; ++n) { const int co = bj * 128 + n * 16; const f32x4 v = *(const f32x4*)(base + co) + *(const f32x4*)(gp + co) * acc[ai][bj][m][n];
                        acc[ai][bj][m][n] = v; *(f32x4*)(o + co) = v; s += (v.x * v.x + v.y * v.y) + (v.z * v.z + v.w * v.w); }
                s += __shfl_xor(s, 16); s += __shfl_xor(s, 32);
                if (fq == 0) Pp[(ai * 128 + wr * 64 + m * 16 + fr) * 4 + wc] = s;
                asm volatile("" ::: "memory"); }
        asm volatile("s_waitcnt lgkmcnt(0)" ::: "memory"); __builtin_amdgcn_s_barrier(); asm volatile("" ::: "memory");
        const int prow = wid * 32 + (lane & 31);
        if (lane < 32) { const float t = (Pp[prow * 4 + 0] + Pp[prow * 4 + 1]) + (Pp[prow * 4 + 2] + Pp[prow * 4 + 3]);
            __hip_atomic_store(xs + ((size_t)(u.pm * 256 + prow) * 4 + u.pn), t, __ATOMIC_RELAXED, __HIP_MEMORY_SCOPE_AGENT); }
        asm volatile("s_waitcnt vmcnt(0)" ::: "memory");
        if (lane == 0) __hip_atomic_fetch_add(cnt + 64 * u.pm, 1u, __ATOMIC_RELAXED, __HIP_MEMORY_SCOPE_AGENT);
        if (wid == 0) { unsigned spins = 0;
            while ((unsigned)__builtin_amdgcn_readfirstlane(__hip_atomic_load(cnt + 64 * u.pm, __ATOMIC_RELAXED, __HIP_MEMORY_SCOPE_AGENT)) < 32u) { __builtin_amdgcn_s_sleep(2); if (++spins > (1u << 22)) break; }
            __builtin_amdgcn_fence(__ATOMIC_ACQUIRE, "agent"); }
        asm volatile("s_waitcnt vmcnt(0) lgkmcnt(0)" ::: "memory"); __builtin_amdgcn_s_barrier(); asm volatile("" ::: "memory");
        if (lane < 32) { const float* sl = xs + (size_t)(u.pm * 256 + prow) * 4; float t = 0.f;
#pragma unroll
            for (int k = 0; k < 4; ++k) t += __hip_atomic_load(sl + k, __ATOMIC_RELAXED, __HIP_MEMORY_SCOPE_AGENT);
            Sr[prow] = rsqrtf(t * (1.0f / D) + EPS); }
        asm volatile("s_waitcnt lgkmcnt(0)" ::: "memory"); __builtin_amdgcn_s_barrier(); asm volatile("" ::: "memory");
        const float* scp = sc + (size_t)q * MODW + col0; const float* shp = sh + (size_t)q * MODW + col0;
#pragma unroll
        for (int ai = 0; ai < 2; ++ai)
#pragma unroll
            for (int m = 0; m < 4; ++m) { int lrow = ai * 128 + wr * 64 + m * 16 + fr; asm volatile("" : "+v"(lrow)); const float rstd = Sr[lrow]; bf16_t* o = UB + (size_t)(u.pm * 256 + lrow) * D + col0;
#pragma unroll
                for (int bj = 0; bj < 2; ++bj)
#pragma unroll
                    for (int n = 0; n < 2; ++n) { const int co = bj * 128 + n * 16; const f32x4 v = acc[ai][bj][m][n] * rstd * (*(const f32x4*)(scp + co) + 1.0f) + *(const f32x4*)(shp + co);
                        u32x2 w; w.x = pk2(v.x, v.y); w.y = pk2(v.z, v.w); *(u32x2*)(o + co) = w; }
                asm volatile("" ::: "memory"); }
    }
};
struct EpiResAtomic {
    static constexpr bool PERM = false, AFTER_DRAIN = false;
    float* X; const float* gate;
    DI void operator()(const f32x4 (&acc)[2][2][4][2], const pg8::Unit& u, int wr, int wc, int fr, int fq) const {
        const int row0 = NP + wr * 64 + fr, col0 = (u.pn & 3) * 256 + wc * 32 + 4 * fq;
#pragma unroll
        for (int ai = 0; ai < 2; ++ai)
#pragma unroll
            for (int m = 0; m < 4; ++m) { int row = row0 + ai * 128 + m * 16; asm volatile("" : "+v"(row));
                if (row < NR) { const float* gp = gate + (size_t)seq_of(row) * MODW + col0; float* o = X + (size_t)row * D + col0;
#pragma unroll
                    for (int bj = 0; bj < 2; ++bj)
#pragma unroll
                        for (int n = 0; n < 2; ++n) { const f32x4 gv = *(const f32x4*)(gp + bj * 128 + n * 16) * acc[ai][bj][m][n];
#pragma unroll
                            for (int e = 0; e < 4; ++e) __hip_atomic_fetch_add(o + bj * 128 + n * 16 + e, gv[e], __ATOMIC_RELAXED, __HIP_MEMORY_SCOPE_AGENT); } }
                asm volatile("" ::: "memory"); }
    }
};
struct EpiSplit {
    static constexpr bool PERM = true, AFTER_DRAIN = false;
    int act; bf16_t* O0; int ld0, b1; bf16_t* O1; int ld1, b2; float* F; int ldf, ntail;
    DI void operator()(const f32x4 (&acc)[2][2][4][2], const pg8::Unit& u, int wr, int wc, int fr, int fq) const {
        const int row0 = u.pm * 256 + wr * 64 + fr; const int colt = u.pn * 256;
        if (colt >= b2) {
            const int c0 = colt - b2 + wc * 32 + 8 * fq;
#pragma unroll
            for (int ai = 0; ai < 2; ++ai)
#pragma unroll
                for (int m = 0; m < 4; ++m) { const int row = row0 + ai * 128 + m * 16;
#pragma unroll
                    for (int bj = 0; bj < 2; ++bj)
#pragma unroll
                        for (int n = 0; n < 2; ++n) { const int c = c0 + bj * 128 + 4 * n; if (c < ntail) *(f32x4*)(F + (size_t)row * ldf + c) = acc[ai][bj][m][n]; } }
            return;
        }
        const bool s0 = colt < b1; bf16_t* base = s0 ? O0 : O1; const int ld = s0 ? ld0 : ld1; const int col0 = (s0 ? colt : colt - b1) + wc * 32 + 8 * fq;
#pragma unroll
        for (int ai = 0; ai < 2; ++ai)
#pragma unroll
            for (int m = 0; m < 4; ++m) { bf16_t* rowp = base + (size_t)(row0 + ai * 128 + m * 16) * ld + col0;
#pragma unroll
                for (int bj = 0; bj < 2; ++bj) { f32x4 v0 = acc[ai][bj][m][0], v1 = acc[ai][bj][m][1];
                    if (act == 1 && s0) {
#pragma unroll
                        for (int j = 0; j < 4; ++j) { v0[j] = gelu_tanh(v0[j]); v1[j] = gelu_tanh(v1[j]); } }
                    if (act == 2) {
#pragma unroll
                        for (int j = 0; j < 4; ++j) { const float a = fmaxf(v0[j], 0.f), b = fmaxf(v1[j], 0.f); v0[j] = a * a; v1[j] = b * b; } }
                    u32x4 w; w.x = pg8::cvt_pk_bf16(v0[0], v0[1]); w.y = pg8::cvt_pk_bf16(v0[2], v0[3]); w.z = pg8::cvt_pk_bf16(v1[0], v1[1]); w.w = pg8::cvt_pk_bf16(v1[2], v1[3]);
                    *(u32x4*)(rowp + bj * 128) = w; } }
    }
};
struct EpiGate {
    static constexpr bool PERM = false, AFTER_DRAIN = false;
    const bf16_t* XB; const float* gb; const float* ls8; float* LA; float* BX;
    DI void operator()(const f32x4 (&acc)[2][2][4][2], const pg8::Unit& u, int wr, int wc, int fr, int fq) const {
        const int row0 = u.pm * 256 + wr * 64 + fr, ch0 = u.pn * 128 + wc * 32 + 4 * fq;
#pragma unroll
        for (int n = 0; n < 2; ++n) { const int ch = ch0 + n * 16; const f32x4 br = *(const f32x4*)(gb + ch), bi = *(const f32x4*)(gb + D + ch), ls = *(const f32x4*)(ls8 + ch);
#pragma unroll
            for (int ai = 0; ai < 2; ++ai)
#pragma unroll
                for (int m = 0; m < 4; ++m) { const int row = row0 + ai * 128 + m * 16; int o = row * D + ch; asm volatile("" : "+v"(o));
                    if (row < NR) { const u32x2 xw = *(const u32x2*)(XB + o);
                        const float xb[4] = {lo16(xw.x), hi16(xw.x), lo16(xw.y), hi16(xw.y)}; f32x4 la, bx;
#pragma unroll
                        for (int j = 0; j < 4; ++j) { const float r = sigmoidf_(acc[ai][0][m][n][j] + br[j]), ig = sigmoidf_(acc[ai][1][m][n][j] + bi[j]);
                            const float l = r * ls[j], a = __expf(l); la[j] = l; bx[j] = __builtin_amdgcn_sqrtf(fmaxf(1.0f - a * a, 0.f)) * ig * xb[j]; }
                        *(f32x4*)(LA + o) = la; *(f32x4*)(BX + o) = bx; }
                    asm volatile("" ::: "memory"); } }
    }
};
DI void transpose_item(const float* W, int K, int N, bf16_t* WT, int row_off, LAS float* scr, int kb, int nb, int lane) {
    const int k0 = 64 * kb, n0 = 32 * nb; const int n4 = (lane & 7) * 4, kr = lane >> 3;
    const GAS float* Wg = (const GAS float*)W; GAS bf16_t* WTg = (GAS bf16_t*)WT;
    f32x4 v[8];
    if (n0 + 32 <= N) {
#pragma unroll
        for (int i = 0; i < 8; ++i) v[i] = *(const GAS f32x4*)(Wg + (size_t)(k0 + i * 8 + kr) * N + n0 + n4);
    } else {
#pragma unroll
        for (int i = 0; i < 8; ++i) { const GAS float* src = Wg + (size_t)(k0 + i * 8 + kr) * N + n0 + n4;
#pragma unroll
            for (int e = 0; e < 4; ++e) v[i][e] = (n0 + n4 + e < N) ? src[e] : 0.f; }
    }
#pragma unroll
    for (int i = 0; i < 8; ++i) { LAS float* d = scr + (i * 8 + kr) * 33 + n4; d[0] = v[i].x; d[1] = v[i].y; d[2] = v[i].z; d[3] = v[i].w; }
    asm volatile("s_waitcnt lgkmcnt(0)" ::: "memory");
    const int c = lane & 7;
#pragma unroll
    for (int j = 0; j < 4; ++j) { const int n = (lane >> 3) + 8 * j; const LAS float* s = scr + (8 * c) * 33 + n;
        u32x4 o; o.x = pk2(s[0 * 33], s[1 * 33]); o.y = pk2(s[2 * 33], s[3 * 33]); o.z = pk2(s[4 * 33], s[5 * 33]); o.w = pk2(s[6 * 33], s[7 * 33]);
        if (n0 + n < N) *(GAS u32x4*)(WTg + (size_t)(row_off + n0 + n) * K + k0 + 8 * c) = o; }
    asm volatile("s_waitcnt lgkmcnt(0)" ::: "memory");
}
struct TJob { const float* W; bf16_t* WT; int K, N, mode, aux; };
template <class ArgsRef> DI void prep_phase(const Ctx& c, const ArgsRef& a, bool first) {
    unsigned char* ws = a.ws;
    LAS TJob* jobs = (LAS TJob*)(c.lds + 131072 - 4096); LAS int* cum = (LAS int*)(c.lds + 131072 - 512);
    constexpr int NJ = 40;
    if (c.tid == 0) {
        int j = 0;
        auto add = [&](const float* W, bf16_t* WT, int K, int N, int mode, int aux) { jobs[j].W = W; jobs[j].WT = WT; jobs[j].K = K; jobs[j].N = N; jobs[j].mode = mode; jobs[j].aux = aux; ++j; };
        for (int i = 0; i < 4; ++i) add(GIN(10) + (size_t)i * 1024 * MODW, (bf16_t*)(ws + WS_P) + (size_t)i * MODW * 1024, 1024, MODW, 0, 0);
        for (int i = 0; i < 4; ++i) add(GIN(12) + (size_t)i * 1024 * 4096, (bf16_t*)(ws + WS_WUP) + (size_t)i * 4096 * 1024, 1024, 4096, 0, 0);
        for (int i = 0; i < 4; ++i) add(GIN(13) + (size_t)i * 1024 * 4096, (bf16_t*)(ws + WS_WDN) + (size_t)i * 4096 * 1024, 4096, 1024, 0, 0);
        for (int i = 0; i < 2; ++i) add(GIN(15) + (size_t)i * 1024 * 2048, (bf16_t*)(ws + WS_RGIN) + (size_t)i * 2048 * 1024, 1024, 2048, 0, 0);
        for (int i = 0; i < 16; ++i) add(GIN(18) + (size_t)i * 65536, (bf16_t*)(ws + WS_RGGATE) + (size_t)(i >> 3) * 2048 * 256, 256, 256, 1, i & 7);
        for (int i = 0; i < 2; ++i) add(GIN(21) + (size_t)i * 1024 * 1024, (bf16_t*)(ws + WS_RGOUT) + (size_t)i * 1024 * 1024, 1024, 1024, 0, 0);
        add(GIN(22), (bf16_t*)(ws + WS_GDNIN), 1024, GDN_N, 0, 0);
        add(GIN(27), (bf16_t*)(ws + WS_GDNOUT), 1024, 1024, 0, 0);
        add(GIN(28), (bf16_t*)(ws + WS_SSDIN), 1024, SSD_N, 0, 0);
        add(GIN(35), (bf16_t*)(ws + WS_SSDOUT), 2048, 1024, 0, 0);
        int s = 0; for (int i = 0; i < NJ; ++i) { if (i < j) s += (jobs[i].K / 64) * ((jobs[i].N + 31) / 32); cum[i] = s; }
    }
    __syncthreads();
    const int total = cum[NJ - 1]; const int gw = c.bid * 8 + c.wave, NGW = c.G * 8;
    LAS float* scr = (LAS float*)(c.lds + c.wave * 8704);
    for (int it = gw; it < total; it += NGW) {
        int j = 0; while (cum[j] <= it) ++j;
        const int r = it - (j ? cum[j - 1] : 0); const int K = jobs[j].K, N = jobs[j].N, nblk = (N + 31) / 32, kb = r / nblk, nb = r % nblk;
        int row_off = 0;
        if (jobs[j].mode == 1) { const int g = jobs[j].aux >> 2, blk = jobs[j].aux & 3, n0 = nb * 32; row_off = 256 * (2 * blk + (n0 >> 7)) + 128 * g + (n0 & 127) - n0; }
        transpose_item(jobs[j].W, K, N, jobs[j].WT, row_off, scr, kb, nb, c.lane);
    }
    const int gt = c.bid * 512 + c.tid, NT = c.G * 512;
    bf16_t* SC = (bf16_t*)(ws + WS_SC);
    for (int i = gt; i < 256 * 128; i += NT) { const int row = i >> 7, c8 = (i & 127) * 8; float f[8];
        if (row < NSEQ) { const float* src = row < 8 ? GIN(8) + row * D + c8 : GIN(9) + (row - 8) * D + c8;
#pragma unroll
            for (int e = 0; e < 8; ++e) f[e] = siluf_(src[e]); }
        else {
#pragma unroll
            for (int e = 0; e < 8; ++e) f[e] = 0.f; }
        *(u32x4*)(SC + (size_t)row * D + c8) = pack8(f); }
    for (int i = gt; i < 2 * D; i += NT) ((float*)(ws + WS_LS8))[i] = -8.0f * log1pf(__expf(-GIN(20)[i]));
    for (int i = gt; i < 8 * 64 * 64; i += NT) ((unsigned*)(ws + WS_CNT))[i] = 0u;
    for (int i = gt; i < NS * D / 4; i += NT) ((f32x4*)(ws + WS_X + (size_t)NP * D * 4))[i] = ((const f32x4*)GIN(1))[i];
    const u32x4 z4 = {0u, 0u, 0u, 0u};
    for (int i = gt; i < (GDN_NP - GDN_N) * 128; i += NT) *(u32x4*)((bf16_t*)(ws + WS_GDNIN) + (size_t)GDN_N * 1024 + (size_t)i * 8) = z4;
    for (int i = gt; i < (SSD_NP - SSD_N) * 128; i += NT) *(u32x4*)((bf16_t*)(ws + WS_SSDIN) + (size_t)SSD_N * 1024 + (size_t)i * 8) = z4;
}

DI void norm_mod_phase(const Ctx& c, const float* __restrict__ xp, const float* __restrict__ xs, const float* __restrict__ sc, const float* __restrict__ sh, bf16_t* __restrict__ out, int r_begin) {
    const int stride = c.G * 8;
    for (int r = r_begin + c.bid * 8 + c.wave; r < NR; r += 2 * stride) {
        const int r2 = r + stride; const bool two = r2 < NR; const int rb = two ? r2 : r;
        const float* xa = r < NP ? xp + (size_t)r * D : xs + (size_t)(r - NP) * D; const float* xb = rb < NP ? xp + (size_t)rb * D : xs + (size_t)(rb - NP) * D;
        f32x4 va[4], vb[4]; float sa = 0.f, sb = 0.f;
#pragma unroll
        for (int j = 0; j < 4; ++j) { va[j] = *(const f32x4*)(xa + c.lane * 4 + 256 * j); vb[j] = *(const f32x4*)(xb + c.lane * 4 + 256 * j); }
#pragma unroll
        for (int j = 0; j < 4; ++j) { sa += (va[j].x * va[j].x + va[j].y * va[j].y) + (va[j].z * va[j].z + va[j].w * va[j].w); sb += (vb[j].x * vb[j].x + vb[j].y * vb[j].y) + (vb[j].z * vb[j].z + vb[j].w * vb[j].w); }
        const float ra = rsqrtf(wave_sum(sa) * (1.0f / D) + EPS), rbs = rsqrtf(wave_sum(sb) * (1.0f / D) + EPS);
        const int qa = seq_of(r), qb = seq_of(rb);
#pragma unroll
        for (int j = 0; j < 4; ++j) { const int col = c.lane * 4 + 256 * j;
            { const f32x4 s1 = *(const f32x4*)(sc + (size_t)qa * MODW + col), s2 = *(const f32x4*)(sh + (size_t)qa * MODW + col);
              const f32x4 o = va[j] * ra * (s1 + 1.0f) + s2; u32x2 w; w.x = pk2(o.x, o.y); w.y = pk2(o.z, o.w); *(u32x2*)(out + (size_t)r * D + col) = w; }
            if (two) { const f32x4 s1 = *(const f32x4*)(sc + (size_t)qb * MODW + col), s2 = *(const f32x4*)(sh + (size_t)qb * MODW + col);
              const f32x4 o = vb[j] * rbs * (s1 + 1.0f) + s2; u32x2 w; w.x = pk2(o.x, o.y); w.y = pk2(o.z, o.w); *(u32x2*)(out + (size_t)r2 * D + col) = w; } }
    }
}
DI void final_norm_phase(const Ctx& c, const float* X, const float* g, float* out) {
    for (int r = c.bid * 8 + c.wave; r < NR; r += c.G * 8) {
        const float* xr = X + (size_t)r * D; f32x4 v[4]; float ss = 0.f;
#pragma unroll
        for (int j = 0; j < 4; ++j) { v[j] = *(const f32x4*)(xr + c.lane * 4 + 256 * j); ss += (v[j].x * v[j].x + v[j].y * v[j].y) + (v[j].z * v[j].z + v[j].w * v[j].w); }
        const float rstd = rsqrtf(wave_sum(ss) * (1.0f / D) + EPS);
#pragma unroll
        for (int j = 0; j < 4; ++j) { const int col = c.lane * 4 + 256 * j; *(f32x4*)(out + (size_t)r * D + col) = v[j] * rstd * *(const f32x4*)(g + col); }
    }
}

DI void conv8(const bf16_t* P, int ld, int row, int t, const float* st, int nch, const float* w, const float* b, int ch, float* f, float* cur) {
    float x[4][8];
    unpack8(*(const u32x4*)(P + (size_t)row * ld), x[3]);
#pragma unroll
    for (int k = 0; k < 3; ++k) {
        if (t < 0) { const f32x4 a0 = *(const f32x4*)(st + k * nch + ch), a1 = *(const f32x4*)(st + k * nch + ch + 4); x[k][0] = a0.x; x[k][1] = a0.y; x[k][2] = a0.z; x[k][3] = a0.w; x[k][4] = a1.x; x[k][5] = a1.y; x[k][6] = a1.z; x[k][7] = a1.w; }
        else if (t - 3 + k >= 0) unpack8(*(const u32x4*)(P + (size_t)(row - 3 + k) * ld), x[k]);
        else {
#pragma unroll
            for (int e = 0; e < 8; ++e) x[k][e] = 0.f; }
    }
#pragma unroll
    for (int e = 0; e < 8; ++e) { f[e] = b ? b[ch + e] : 0.f; cur[e] = x[3][e]; }
#pragma unroll
    for (int k = 0; k < 4; ++k) { const f32x4 w0 = *(const f32x4*)(w + k * nch + ch), w1 = *(const f32x4*)(w + k * nch + ch + 4);
        f[0] += x[k][0] * w0.x; f[1] += x[k][1] * w0.y; f[2] += x[k][2] * w0.z; f[3] += x[k][3] * w0.w; f[4] += x[k][4] * w1.x; f[5] += x[k][5] * w1.y; f[6] += x[k][6] * w1.z; f[7] += x[k][7] * w1.w; }
}
DI void conv_state8(int row, int t, const float* cur, const float* st, int nch, int ch, float* pout  , float* sout  ) {
    if (t >= 0) { if (t >= SEQL - 3) { float* o = pout + ((size_t)(row >> 11) * 3 + (t - (SEQL - 3))) * nch + ch; *(f32x4*)o = (f32x4){cur[0], cur[1], cur[2], cur[3]}; *(f32x4*)(o + 4) = (f32x4){cur[4], cur[5], cur[6], cur[7]}; } }
    else { const int s = row - NP; float* o = sout + (size_t)s * 3 * nch + ch;
        *(f32x4*)o = *(const f32x4*)(st + nch + ch); *(f32x4*)(o + 4) = *(const f32x4*)(st + nch + ch + 4);
        *(f32x4*)(o + nch) = *(const f32x4*)(st + 2 * nch + ch); *(f32x4*)(o + nch + 4) = *(const f32x4*)(st + 2 * nch + ch + 4);
        *(f32x4*)(o + 2 * nch) = (f32x4){cur[0], cur[1], cur[2], cur[3]}; *(f32x4*)(o + 2 * nch + 4) = (f32x4){cur[4], cur[5], cur[6], cur[7]}; }
}

DI void conv8_slide(const bf16_t* Pc  , int ld, int r0, const float* w, const float* b, int nch, int ch, float (&out)[8][8], u32x4 (&raw)[11]) {
    const bool head = (r0 & (SEQL - 1)) == 0; const u32x4 z = {0u, 0u, 0u, 0u};
#pragma unroll
    for (int k = 0; k < 11; ++k) raw[k] = (k < 3 && head) ? z : *(const u32x4*)(Pc + (size_t)(r0 - 3 + k) * ld);
    float wk[4][8], bb[8];
#pragma unroll
    for (int k = 0; k < 4; ++k) { const f32x4 w0 = *(const f32x4*)(w + k * nch + ch), w1 = *(const f32x4*)(w + k * nch + ch + 4); wk[k][0] = w0.x; wk[k][1] = w0.y; wk[k][2] = w0.z; wk[k][3] = w0.w; wk[k][4] = w1.x; wk[k][5] = w1.y; wk[k][6] = w1.z; wk[k][7] = w1.w; }
#pragma unroll
    for (int e = 0; e < 8; ++e) bb[e] = b ? b[ch + e] : 0.f;
#pragma unroll
    for (int t = 0; t < 8; ++t)
#pragma unroll
        for (int e = 0; e < 8; ++e) out[t][e] = bb[e];
#pragma unroll
    for (int k = 0; k < 11; ++k) { float x[8]; unpack8(raw[k], x);
#pragma unroll
        for (int t = 0; t < 8; ++t) { const int tap = k - t; if (tap >= 0 && tap < 4) {
#pragma unroll
            for (int e = 0; e < 8; ++e) out[t][e] += x[e] * wk[tap][e]; } } }
}
DI void prompt_conv_state(const Ctx& c, const bf16_t* P, int ld, int nch, float* pout) {
    for (int i = c.bid * 512 + c.tid; i < 8 * 3 * nch; i += c.G * 512) { const int ch = i % nch, r = i / nch, k = r % 3, b = r / 3;
        pout[i] = bf2f(P[(size_t)(b * SEQL + SEQL - 3 + k) * ld + ch]); }
}
DI void rg_conv_phase(const Ctx& c, const bf16_t* P  , const float* cw, const float* cb, const float* st  , bf16_t* XB, float* pout, float* sout) {
    for (int i = c.bid * 512 + c.tid; i < (NP / 8) * 128; i += c.G * 512) {
        const int r0 = (i >> 7) * 8, ch = (i & 127) * 8; float o[8][8]; u32x4 raw[11];
        conv8_slide(P + 1024 + ch, 2048, r0, cw, cb, D, ch, o, raw);
#pragma unroll
        for (int t = 0; t < 8; ++t) *(u32x4*)(XB + (size_t)(r0 + t) * D + ch) = pack8(o[t]);
    }
    for (int i = c.bid * 512 + c.tid; i < NS * 128; i += c.G * 512) {
        const int row = NP + (i >> 7), ch = (i & 127) * 8; const float* sp = st + (size_t)(row - NP) * 3 * D;
        float f[8], cur[8]; conv8(P + 1024 + ch, 2048, row, -1, sp, D, cw, cb, ch, f, cur);
        *(u32x4*)(XB + (size_t)row * D + ch) = pack8(f);
        conv_state8(row, -1, cur, sp, D, ch, pout, sout);
    }
    prompt_conv_state(c, P + 1024, 2048, D, pout);
}
DI void rg_scan_phase(const Ctx& c, const float* __restrict__ LA, const float* __restrict__ BX, const bf16_t* __restrict__ P  , const float* h0  , bf16_t* __restrict__ HY, float* ph  , float* sh  ) {
    LAS float* sA = (LAS float*)c.lds; LAS float* sB = sA + 512;
    for (int it = c.bid; it < 256; it += c.G) {
        const int b = it >> 5, ch = (it & 31) * 32 + (c.tid & 31), seg = c.tid >> 5; const int r0 = b * SEQL + seg * 128;
        const float* lap = LA + (size_t)r0 * D + ch; const float* bxp = BX + (size_t)r0 * D + ch; const bf16_t* yp = P + (size_t)r0 * 2048 + ch; bf16_t* op = HY + (size_t)r0 * D + ch;
        float h = 0.f, ap = 0.f;
#pragma unroll 1
        for (int t0 = 0; t0 < 128; t0 += 16) { float la[16], bx[16];
#pragma unroll
            for (int u = 0; u < 16; ++u) { la[u] = lap[(size_t)(t0 + u) * D]; bx[u] = bxp[(size_t)(t0 + u) * D]; }
#pragma unroll
            for (int u = 0; u < 16; ++u) { h = __expf(la[u]) * h + bx[u]; ap += la[u]; } }
        sA[c.tid] = __expf(ap); sB[c.tid] = h;
        __syncthreads();
        float hin = 0.f;
        for (int s = 0; s < seg; ++s) hin = sA[s * 32 + (c.tid & 31)] * hin + sB[s * 32 + (c.tid & 31)];
        h = hin;
#pragma unroll 1
        for (int t0 = 0; t0 < 128; t0 += 16) { float la[16], bx[16]; bf16_t yv[16];
#pragma unroll
            for (int u = 0; u < 16; ++u) { la[u] = lap[(size_t)(t0 + u) * D]; bx[u] = bxp[(size_t)(t0 + u) * D]; yv[u] = yp[(size_t)(t0 + u) * 2048]; }
#pragma unroll
            for (int u = 0; u < 16; ++u) { h = __expf(la[u]) * h + bx[u]; op[(size_t)(t0 + u) * D] = (bf16_t)f2bf(h * bf2f(yv[u])); } }
        if (seg == 15) ph[b * D + ch] = h;
        __syncthreads();
    }
    for (int i = c.bid * 512 + c.tid; i < NS * D; i += c.G * 512) { const int s = i >> 10, ch = i & 1023; const size_t o = (size_t)(NP + s) * D + ch;
        const float h = __expf(LA[o]) * h0[i] + BX[o]; sh[i] = h; HY[o] = (bf16_t)f2bf(h * bf2f(P[(size_t)(NP + s) * 2048 + ch])); }
}
DI void gdn_conv_phase(const Ctx& c, const bf16_t* P, const float* cw  , const float* st  , const float* AB, const float* A_log, const float* dt_bias,
                       bf16_t* Q, bf16_t* K, bf16_t* V, bf16_t* QKVS, float* GB, float* pout, float* sout) {
    for (int wt = c.bid * 8 + c.wave; wt < (NP / 8) * 6; wt += c.G * 8) {
        const int seg = wt % 6, r0 = (wt / 6) * 8, ch = seg * 512 + c.lane * 8; float o[8][8]; u32x4 raw[11];
        conv8_slide(P + ch, 3072, r0, cw, nullptr, 3072, ch, o, raw);
        bf16_t* dst = (seg < 2 ? Q : (seg < 4 ? K : V)) + (seg & 1) * 512 + c.lane * 8;
#pragma unroll
        for (int t = 0; t < 8; ++t) { float ss = 0.f;
#pragma unroll
            for (int e = 0; e < 8; ++e) { o[t][e] = siluf_(o[t][e]); ss += o[t][e] * o[t][e]; }
            if (seg < 4) { ss += __shfl_xor(ss, 1); ss += __shfl_xor(ss, 2); ss += __shfl_xor(ss, 4); ss += __shfl_xor(ss, 8);
                const float sc = rsqrtf(ss + EPS) * (seg < 2 ? 0.08838834764831845f : 1.0f);
#pragma unroll
                for (int e = 0; e < 8; ++e) o[t][e] *= sc; }
            *(u32x4*)(dst + (size_t)(r0 + t) * D) = pack8(o[t]); }
    }
    for (int row = NP + c.bid * 8 + c.wave; row < NR; row += c.G * 8) {
        const float* sp = st + (size_t)(row - NP) * 3 * 3072;
#pragma unroll 1
        for (int pass = 0; pass < 6; ++pass) {
            const int ch = pass * 512 + c.lane * 8; float f[8], cur[8];
            conv8(P + ch, 3072, row, -1, sp, 3072, cw, nullptr, ch, f, cur);
            conv_state8(row, -1, cur, sp, 3072, ch, pout, sout);
            float ss = 0.f;
#pragma unroll
            for (int e = 0; e < 8; ++e) { f[e] = siluf_(f[e]); ss += f[e] * f[e]; }
            if (pass < 4) { ss += __shfl_xor(ss, 1); ss += __shfl_xor(ss, 2); ss += __shfl_xor(ss, 4); ss += __shfl_xor(ss, 8);
                const float sc = rsqrtf(ss + EPS) * (pass < 2 ? 0.08838834764831845f : 1.0f);
#pragma unroll
                for (int e = 0; e < 8; ++e) f[e] *= sc; }
            *(u32x4*)(QKVS + ((size_t)(pass >> 1) * NS + (row - NP)) * D + (pass & 1) * 512 + c.lane * 8) = pack8(f);
        }
    }
    for (int i = c.bid * 512 + c.tid; i < NR * 8; i += c.G * 512) { const int row = i >> 3, h = i & 7; const float a_in = AB[(size_t)row * 16 + h], b_in = AB[(size_t)row * 16 + 8 + h];
        GB[(size_t)row * 16 + h] = -__expf(A_log[h]) * softplusf_(a_in + dt_bias[h]); GB[(size_t)row * 16 + 8 + h] = sigmoidf_(b_in); }
    prompt_conv_state(c, P, 3072, 3072, pout);
}
DI void gdn_prep_phase(const Ctx& c, const bf16_t* Q, const bf16_t* K, const bf16_t* V, const float* GB, float* UT, bf16_t* NW, bf16_t* QD, bf16_t* KDT, bf16_t* QKG, float* GL) {
    const int half = c.tid >> 8, t = c.tid & 255, w4 = c.wave & 3, lr = c.lane & 15, quad = c.lane >> 4;
    ldsp L = c.lds + half * 65536; ldsp kS = L, qS = L + 17408; LAS float* AT = (LAS float*)(L + 34816); LAS float* Gs = (LAS float*)(L + 51200); LAS float* Bs = Gs + 64; LAS float* EGs = Gs + 128;
    for (int pair = c.bid; pair < 1024; pair += c.G) {
        const int item = pair * 2 + half, n = item & 31, h = (item >> 5) & 7, b = item >> 8, r0 = b * SEQL + n * 64;
        if (t < 64) { float G = GB[(size_t)(r0 + t) * 16 + h]; const float be = GB[(size_t)(r0 + t) * 16 + 8 + h];
#pragma unroll
            for (int o = 1; o < 64; o <<= 1) { const float v = __shfl_up(G, o); if (c.lane >= o) G += v; }
            Gs[t] = G; Bs[t] = be; EGs[t] = __expf(G); }
#pragma unroll
        for (int i = 0; i < 4; ++i) { const int ci = t + i * 256, row = ci >> 4, cc = ci & 15; const size_t go = (size_t)(r0 + row) * D + h * 128 + cc * 8;
            *(LAS u32x4*)(kS + row * 272 + cc * 16) = *(const u32x4*)(K + go); *(LAS u32x4*)(qS + row * 272 + cc * 16) = *(const u32x4*)(Q + go); }
        __syncthreads();
        {
            const int ib = w4; float Gi[4], bi[4];
#pragma unroll
            for (int jj = 0; jj < 4; ++jj) { Gi[jj] = Gs[ib * 16 + quad * 4 + jj]; bi[jj] = Bs[ib * 16 + quad * 4 + jj]; }
            bf16_t* qkg = QKG + (size_t)item * 4096;
#pragma unroll 1
            for (int jb = 0; jb < 4; ++jb) {
                if (jb <= ib) {
                    f32x4 akk = {0.f, 0.f, 0.f, 0.f}, aqk = {0.f, 0.f, 0.f, 0.f};
#pragma unroll
                    for (int ks = 0; ks < 4; ++ks) { const bf16x8 ak = *(const LAS bf16x8*)(kS + (ib * 16 + lr) * 272 + ks * 64 + quad * 16), aq = *(const LAS bf16x8*)(qS + (ib * 16 + lr) * 272 + ks * 64 + quad * 16),
                                                                  bk = *(const LAS bf16x8*)(kS + (jb * 16 + lr) * 272 + ks * 64 + quad * 16);
                        akk = MFMA16(ak, bk, akk); aqk = MFMA16(aq, bk, aqk); }
                    const int j = jb * 16 + lr; const float Gj = Gs[j]; f32x4 av;
#pragma unroll
                    for (int jj = 0; jj < 4; ++jj) { const int i = ib * 16 + quad * 4 + jj; const float dec = i >= j ? __expf(Gi[jj] - Gj) : 0.f;
                        av[jj] = i > j ? bi[jj] * akk[jj] * dec : 0.f; qkg[i * 64 + j] = (bf16_t)f2bf(aqk[jj] * dec); }
                    *(LAS f32x4*)(AT + j * 64 + ib * 16 + quad * 4) = av;
                } else {
#pragma unroll
                    for (int jj = 0; jj < 4; ++jj) qkg[(ib * 16 + quad * 4 + jj) * 64 + jb * 16 + lr] = 0;
                }
            }
        }
#pragma unroll
        for (int i = 0; i < 4; ++i) { const int ci = t + i * 256, row = ci >> 4, cc = ci & 15; float f[8]; unpack8(*(const LAS u32x4*)(qS + row * 272 + cc * 16), f); const float eg = EGs[row];
#pragma unroll
            for (int e = 0; e < 8; ++e) f[e] *= eg;
            *(u32x4*)(QD + (size_t)(r0 + row) * D + h * 128 + cc * 8) = pack8(f); }
        { const int dk = t & 127, chf = t >> 7; const float Gl = Gs[63];
#pragma unroll
            for (int c8 = 0; c8 < 4; ++c8) { const int c0 = chf * 32 + c8 * 8; float f[8];
#pragma unroll
                for (int e = 0; e < 8; ++e) f[e] = bf2f(*(const LAS bf16_t*)(kS + (c0 + e) * 272 + dk * 2)) * __expf(Gl - Gs[c0 + e]);
                *(u32x4*)(KDT + ((size_t)item * 128 + dk) * 64 + c0) = pack8(f); }
            if (t == 0) GL[item] = __expf(Gl); }
        __syncthreads();
#pragma unroll
        for (int i = 0; i < 4; ++i) { const int ci = t + i * 256, row = ci >> 4, cc = ci & 15; *(LAS u32x4*)(qS + row * 272 + cc * 16) = *(const u32x4*)(V + (size_t)(r0 + row) * D + h * 128 + cc * 8); }
        __syncthreads();
        {
            float x[64];
            if (t < 128) {
#pragma unroll
                for (int i = 0; i < 64; ++i) x[i] = bf2f(*(const LAS bf16_t*)(qS + i * 272 + t * 2)) * Bs[i];
            } else {
#pragma unroll
                for (int i = 0; i < 64; ++i) x[i] = bf2f(*(const LAS bf16_t*)(kS + i * 272 + (t - 128) * 2)) * Bs[i] * EGs[i];
            }
#pragma unroll
            for (int j = 0; j < 63; ++j) {
#pragma unroll
                for (int i4 = ((j + 1) & ~3); i4 < 64; i4 += 4) { const f32x4 av = *(const LAS f32x4*)(AT + j * 64 + i4);
                    if (i4 + 0 > j) x[i4 + 0] -= av.x * x[j];
                    if (i4 + 1 > j) x[i4 + 1] -= av.y * x[j];
                    if (i4 + 2 > j) x[i4 + 2] -= av.z * x[j];
                    if (i4 + 3 > j) x[i4 + 3] -= av.w * x[j]; }
            }
            __syncthreads();
            if (t < 128) { float* o = UT + ((size_t)item * 128 + t) * 64;
#pragma unroll
                for (int i = 0; i < 16; ++i) *(f32x4*)(o + 4 * i) = (f32x4){x[4 * i], x[4 * i + 1], x[4 * i + 2], x[4 * i + 3]};
            } else {
#pragma unroll
                for (int i = 0; i < 64; ++i) *(LAS bf16_t*)(kS + i * 272 + (t - 128) * 2) = (bf16_t)f2bf(-x[i]);
            }
        }
        __syncthreads();
#pragma unroll
        for (int i = 0; i < 4; ++i) { const int ci = t + i * 256, row = ci >> 4, cc = ci & 15; *(u32x4*)(NW + (size_t)(r0 + row) * D + h * 128 + cc * 8) = *(const LAS u32x4*)(kS + row * 272 + cc * 16); }
        __syncthreads();
    }
}
DI void gdn_seq_phase(const Ctx& c, const float* UT, const bf16_t* NW, const bf16_t* QD, const bf16_t* KDT, const bf16_t* QKG, const float* GL, float* O, float* pS,
                      const bf16_t* QKVS, const float* GB, const float* S0, float* sS) {
    const int lr = c.lane & 15, quad = c.lane >> 4, w = c.wave;
    ldsp Ws = c.lds, Qs = c.lds + 17408, KTs = c.lds + 34816, QKs = c.lds + 53248, Sts = c.lds + 62464, VTs = c.lds + 71168;
    for (int it0 = c.bid; it0 < 256; it0 += c.G) {
        const int cb = (it0 >> 3) & 3, bh = (it0 & 7) * 8 + (it0 >> 5), b = bh >> 3, h = bh & 7, ci = w >> 1, vi = w & 1;
        f32x4 Sacc[2] = {{0.f, 0.f, 0.f, 0.f}, {0.f, 0.f, 0.f, 0.f}};
        for (int i = c.tid; i < 8704 / 4; i += 512) ((LAS unsigned*)Sts)[i] = 0u;
        u32x4 pf[2][7]; f32x4 put[2]; float pgl[2];
        typedef std::integral_constant<int, 0> I0; typedef std::integral_constant<int, 1> I1;
        auto fetch = [&](int n, auto SL) { constexpr int sl = decltype(SL)::value; const int pit = bh * 32 + n, r0 = b * SEQL + n * 64;
            put[sl] = *(const f32x4*)(UT + ((size_t)pit * 128 + cb * 32 + vi * 16 + lr) * 64 + ci * 16 + quad * 4); pgl[sl] = GL[pit];
#pragma unroll
            for (int i = 0; i < 2; ++i) { const int cidx = c.tid + i * 512, row = cidx >> 4, cc = cidx & 15; const size_t go = (size_t)(r0 + row) * D + h * 128 + cc * 8; pf[sl][i] = *(const u32x4*)(NW + go); pf[sl][2 + i] = *(const u32x4*)(QD + go); }
#pragma unroll
            for (int i = 0; i < 2; ++i) { const int cidx = c.tid + i * 512; pf[sl][4 + i] = *(const u32x4*)(KDT + (size_t)pit * 8192 + cidx * 8); }
            pf[sl][6] = *(const u32x4*)(QKG + (size_t)pit * 4096 + c.tid * 8); };
        auto stash = [&](auto SL) { constexpr int sl = decltype(SL)::value;
#pragma unroll
            for (int i = 0; i < 2; ++i) { const int cidx = c.tid + i * 512, row = cidx >> 4, cc = cidx & 15; *(LAS u32x4*)(Ws + row * 272 + cc * 16) = pf[sl][i]; *(LAS u32x4*)(Qs + row * 272 + cc * 16) = pf[sl][2 + i]; }
#pragma unroll
            for (int i = 0; i < 2; ++i) { const int cidx = c.tid + i * 512, row = cidx >> 3, cc = cidx & 7; *(LAS u32x4*)(KTs + row * 144 + cc * 16) = pf[sl][4 + i]; }
            { const int row = c.tid >> 3, cc = c.tid & 7; *(LAS u32x4*)(QKs + row * 144 + cc * 16) = pf[sl][6]; } };
        fetch(0, I0{}); stash(I0{}); fetch(1, I1{});
        __syncthreads();
        const int sv = c.tid & 127, spart = c.tid >> 7; LAS float* sqf = (LAS float*)(c.lds + 80000); LAS float* skf = sqf + 128; LAS float* sred = sqf + 256;
        float s0[32]; bf16_t sqk = 0, svv = 0; float seg = 0.f, sbeta = 0.f; int sit = NS * 8;
#pragma unroll
        for (int i = 0; i < 32; ++i) s0[i] = 0.f;
        auto chunk = [&](int n, auto PAR) { constexpr int par = decltype(PAR)::value;
            const int r0 = b * SEQL + n * 64;
            f32x4 acc = put[par]; const float gl = pgl[par];
            if (n + 2 < 32) fetch(n + 2, PAR);
#pragma unroll
            for (int ks = 0; ks < 4; ++ks) acc = MFMA16(*(const LAS bf16x8*)(Ws + (ci * 16 + lr) * 272 + ks * 64 + quad * 16), *(const LAS bf16x8*)(Sts + (vi * 16 + lr) * 272 + ks * 64 + quad * 16), acc);
            { u32x2 wv; wv.x = pk2(acc[0], acc[1]); wv.y = pk2(acc[2], acc[3]); *(LAS u32x2*)(VTs + (vi * 16 + lr) * 144 + (ci * 16 + quad * 4) * 2) = wv; }
            LDS_BAR();
            { const int st3 = n & 7;
                if (st3 == 0) { sit = (it0 == c.bid) ? c.bid + (n >> 3) * c.G : NS * 8;
                    if (sit < NS * 8) { const int s2 = sit >> 3, h2 = sit & 7, row2 = NP + s2;
                        const float* sp = S0 + ((size_t)(s2 * 8 + h2) * 128 + spart * 32) * 128 + sv;
#pragma unroll
                        for (int i = 0; i < 32; ++i) s0[i] = sp[(size_t)i * 128];
                        if (c.tid < 128) sqk = QKVS[(size_t)s2 * D + h2 * 128 + c.tid]; else if (c.tid < 256) sqk = QKVS[(size_t)(NS + s2) * D + h2 * 128 + c.tid - 128];
                        svv = QKVS[(size_t)(2 * NS + s2) * D + h2 * 128 + sv]; seg = __expf(GB[(size_t)row2 * 16 + h2]); sbeta = GB[(size_t)row2 * 16 + 8 + h2]; } }
                else if (st3 == 1 && sit < NS * 8) { float ksum = 0.f, qsum = 0.f, qk = 0.f;
#pragma unroll
                    for (int i = 0; i < 32; ++i) { const float kk = skf[spart * 32 + i], qq = sqf[spart * 32 + i]; ksum += kk * s0[i]; qsum += qq * s0[i]; qk += qq * kk; }
                    sred[spart * 128 + sv] = ksum; sred[512 + spart * 128 + sv] = qsum; sred[1024 + spart * 128 + sv] = qk; }
                else if (st3 == 2 && sit < NS * 8) { const int s2 = sit >> 3, h2 = sit & 7, row2 = NP + s2;
                    const float ksum = sred[sv] + sred[128 + sv] + sred[256 + sv] + sred[384 + sv], qsum = sred[512 + sv] + sred[640 + sv] + sred[768 + sv] + sred[896 + sv], qk = sred[1024 + sv] + sred[1152 + sv] + sred[1280 + sv] + sred[1408 + sv];
                    const float vn = sbeta * (bf2f(svv) - seg * ksum);
                    if (spart == 0) O[(size_t)row2 * D + h2 * 128 + sv] = seg * qsum + qk * vn;
                    float* so = sS + ((size_t)(s2 * 8 + h2) * 128 + spart * 32) * 128 + sv;
#pragma unroll
                    for (int i = 0; i < 32; ++i) so[(size_t)i * 128] = seg * s0[i] + skf[spart * 32 + i] * vn; } }
            f32x4 ao = {0.f, 0.f, 0.f, 0.f};
#pragma unroll
            for (int ks = 0; ks < 4; ++ks) ao = MFMA16(*(const LAS bf16x8*)(Qs + (ci * 16 + lr) * 272 + ks * 64 + quad * 16), *(const LAS bf16x8*)(Sts + (vi * 16 + lr) * 272 + ks * 64 + quad * 16), ao);
#pragma unroll
            for (int ks = 0; ks < 2; ++ks) ao = MFMA16(*(const LAS bf16x8*)(QKs + (ci * 16 + lr) * 144 + ks * 64 + quad * 16), *(const LAS bf16x8*)(VTs + (vi * 16 + lr) * 144 + ks * 64 + quad * 16), ao);
#pragma unroll
            for (int jj = 0; jj < 4; ++jj) O[(size_t)(r0 + ci * 16 + quad * 4 + jj) * D + h * 128 + cb * 32 + vi * 16 + lr] = ao[jj];
#pragma unroll
            for (int v2 = 0; v2 < 2; ++v2) { Sacc[v2] = Sacc[v2] * gl;
#pragma unroll
                for (int ks = 0; ks < 2; ++ks) Sacc[v2] = MFMA16(*(const LAS bf16x8*)(KTs + (w * 16 + lr) * 144 + ks * 64 + quad * 16), *(const LAS bf16x8*)(VTs + (v2 * 16 + lr) * 144 + ks * 64 + quad * 16), Sacc[v2]); }
            LDS_BAR();
            if ((n & 7) == 0 && sit < NS * 8 && c.tid < 256) sqf[c.tid] = bf2f(sqk);
#pragma unroll
            for (int v2 = 0; v2 < 2; ++v2) { u32x2 wv; wv.x = pk2(Sacc[v2][0], Sacc[v2][1]); wv.y = pk2(Sacc[v2][2], Sacc[v2][3]); *(LAS u32x2*)(Sts + (v2 * 16 + lr) * 272 + (w * 16 + quad * 4) * 2) = wv; }
            if (n + 1 < 32) stash(std::integral_constant<int, par ^ 1>{});
            LDS_BAR();
        };
#pragma unroll 1
        for (int n = 0; n < 32; n += 2) { chunk(n, I0{}); chunk(n + 1, I1{}); }
#pragma unroll
        for (int v2 = 0; v2 < 2; ++v2)
#pragma unroll
            for (int jj = 0; jj < 4; ++jj) pS[((size_t)bh * 128 + w * 16 + quad * 4 + jj) * 128 + cb * 32 + v2 * 16 + lr] = Sacc[v2][jj];
        __syncthreads();
    }
    LAS float* qf = (LAS float*)c.lds; LAS float* kf = qf + 128; LAS float* red = qf + 256;
    for (int it = (c.bid < 256 ? c.bid + 4 * c.G : c.bid); it < NS * 8; it += c.G) {
        const int s = it >> 3, h = it & 7, row = NP + s, v = c.tid & 127, part = c.tid >> 7;
        __syncthreads();
        if (c.tid < 128) qf[c.tid] = bf2f(QKVS[(size_t)s * D + h * 128 + c.tid]); else if (c.tid < 256) kf[c.tid - 128] = bf2f(QKVS[(size_t)(NS + s) * D + h * 128 + c.tid - 128]);
        __syncthreads();
        const float eg = __expf(GB[(size_t)row * 16 + h]), beta = GB[(size_t)row * 16 + 8 + h];
        const float* sp = S0 + ((size_t)(s * 8 + h) * 128 + part * 32) * 128 + v;
        float s0[32], ksum = 0.f, qsum = 0.f, qk = 0.f;
#pragma unroll
        for (int i = 0; i < 32; ++i) { s0[i] = sp[(size_t)i * 128]; const float kk = kf[part * 32 + i], qq = qf[part * 32 + i]; ksum += kk * s0[i]; qsum += qq * s0[i]; qk += qq * kk; }
        red[part * 128 + v] = ksum; red[512 + part * 128 + v] = qsum; red[1024 + part * 128 + v] = qk;
        __syncthreads();
        ksum = red[v] + red[128 + v] + red[256 + v] + red[384 + v]; qsum = red[512 + v] + red[640 + v] + red[768 + v] + red[896 + v]; qk = red[1024 + v] + red[1152 + v] + red[1280 + v] + red[1408 + v];
        const float vv = bf2f(QKVS[(size_t)(2 * NS + s) * D + h * 128 + v]); const float vn = beta * (vv - eg * ksum);
        if (part == 0) O[(size_t)row * D + h * 128 + v] = eg * qsum + qk * vn;
        float* so = sS + ((size_t)(s * 8 + h) * 128 + part * 32) * 128 + v;
#pragma unroll
        for (int i = 0; i < 32; ++i) so[(size_t)i * 128] = eg * s0[i] + kf[part * 32 + i] * vn;
    }
}
DI void gdn_post_phase(const Ctx& c, const float* O, const bf16_t* GATE, const float* ng, bf16_t* OG) {
    for (int row = c.bid * 8 + c.wave; row < NR; row += c.G * 8) {
#pragma unroll
        for (int pass = 0; pass < 2; ++pass) { const int col = pass * 512 + c.lane * 8, dv = (c.lane & 15) * 8;
            const f32x4 a = *(const f32x4*)(O + (size_t)row * D + col), b2 = *(const f32x4*)(O + (size_t)row * D + col + 4); float f[8] = {a.x, a.y, a.z, a.w, b2.x, b2.y, b2.z, b2.w}, g[8];
            float ss = 0.f;
#pragma unroll
            for (int e = 0; e < 8; ++e) ss += f[e] * f[e];
            ss += __shfl_xor(ss, 1); ss += __shfl_xor(ss, 2); ss += __shfl_xor(ss, 4); ss += __shfl_xor(ss, 8);
            const float rstd = rsqrtf(ss * (1.0f / 128.0f) + EPS);
            unpack8(*(const u32x4*)(GATE + (size_t)row * D + col), g);
#pragma unroll
            for (int e = 0; e < 8; ++e) f[e] = f[e] * rstd * ng[dv + e] * siluf_(g[e]);
            *(u32x4*)(OG + (size_t)row * D + col) = pack8(f); }
    }
}
DI void ssd_conv_phase(const Ctx& c, const bf16_t* P, const float* cw, const float* cb, const float* st  , const float* DTR, const float* dt_bias,
                       bf16_t* BM, bf16_t* CM, bf16_t* XSN, float* DT, bf16_t* XST, bf16_t* BMT, float* pout, float* sout) {
    for (int wt = c.bid * 8 + c.wave; wt < (NP / 8) * 6; wt += c.G * 8) {
        const int seg = wt % 6, rb = wt / 6, r0 = rb * 8, ch = seg * 512 + c.lane * 8, bn = rb >> 3, s8 = rb & 7; float o[8][8]; u32x4 raw[11];
        conv8_slide(P + ch, 3072, r0, cw, cb, 3072, ch, o, raw);
#pragma unroll
        for (int t = 0; t < 8; ++t)
#pragma unroll
            for (int e = 0; e < 8; ++e) o[t][e] = siluf_(o[t][e]);
        if (seg >= 4) { bf16_t* dst = (seg == 4 ? BM : CM) + c.lane * 8;
#pragma unroll
            for (int t = 0; t < 8; ++t) *(u32x4*)(dst + (size_t)(r0 + t) * 512) = pack8(o[t]); }
        if (seg <= 4) { bf16_t* dst = seg < 4 ? XST + ((size_t)bn * 2048 + ch) * 64 + s8 * 8 : BMT + ((size_t)bn * 512 + c.lane * 8) * 64 + s8 * 8;
#pragma unroll
            for (int e = 0; e < 8; ++e) { const float col[8] = {o[0][e], o[1][e], o[2][e], o[3][e], o[4][e], o[5][e], o[6][e], o[7][e]}; *(u32x4*)(dst + (size_t)e * 64) = pack8(col); } }
    }
    for (int row = NP + c.bid * 8 + c.wave; row < NR; row += c.G * 8) {
        const float* sp = st + (size_t)(row - NP) * 3 * 3072;
#pragma unroll 1
        for (int pass = 0; pass < 6; ++pass) {
            const int ch = pass * 512 + c.lane * 8; float f[8], cur[8];
            conv8(P + ch, 3072, row, -1, sp, 3072, cw, cb, ch, f, cur);
            conv_state8(row, -1, cur, sp, 3072, ch, pout, sout);
#pragma unroll
            for (int e = 0; e < 8; ++e) f[e] = siluf_(f[e]);
            if (pass < 4) *(u32x4*)(XSN + (size_t)(row - NP) * 2048 + ch) = pack8(f);
            else if (pass == 4) *(u32x4*)(BM + (size_t)row * 512 + c.lane * 8) = pack8(f);
            else *(u32x4*)(CM + (size_t)row * 512 + c.lane * 8) = pack8(f);
        }
    }
    for (int i = c.bid * 512 + c.tid; i < NR * 32; i += c.G * 512) DT[i] = softplusf_(DTR[i] + dt_bias[i & 31]);
    prompt_conv_state(c, P, 3072, 3072, pout);
}
DI void ssd_seq_phase(const Ctx& c, const bf16_t* XST, const bf16_t* BM, const bf16_t* CM, const bf16_t* BMT, const float* DT, const float* A_log, const float* Dsk, bf16_t* Y, float* pH,
                      const bf16_t* XSN, const float* H0, float* sH) {
    const int lr = c.lane & 15, quad = c.lane >> 4, w = c.wave;
    ldsp Cs = c.lds, Bs = c.lds + 17408, BTs = c.lds + 34816, XTs = c.lds + 53248, XDs = c.lds + 62464, XRs = c.lds + 71680, Ms = c.lds + 80896, Hs = c.lds + 90112;
    LAS float* DTs = (LAS float*)(c.lds + 107520); LAS float* ACs = DTs + 64;
    for (int it0 = c.bid; it0 < 256; it0 += c.G) {
        const int pr = (it0 & 7) * 4 + (it0 >> 6), b = pr >> 2, g = pr & 3, hd = g * 8 + ((it0 >> 3) & 7), item = b * 32 + hd; const float A = -__expf(A_log[hd]), Dk = Dsk[hd];
        f32x4 hacc[4];
#pragma unroll
        for (int i = 0; i < 4; ++i) hacc[i] = (f32x4){0.f, 0.f, 0.f, 0.f};
        __syncthreads();
        for (int i = c.tid; i < 17408 / 4; i += 512) ((LAS unsigned*)Hs)[i] = 0u;
        u32x4 pC[2], pB[2], pT[2], pX; float pdt = 0.f;
        auto fetch = [&](int n) { const int bn = b * 32 + n, r0 = b * SEQL + n * 64;
            if (c.tid < 64) pdt = DT[(size_t)(r0 + c.tid) * 32 + hd];
#pragma unroll
            for (int i = 0; i < 2; ++i) { const int ci = c.tid + i * 512, row = ci >> 4, cc = ci & 15; const size_t go = (size_t)(r0 + row) * 512 + g * 128 + cc * 8; pC[i] = *(const u32x4*)(CM + go); pB[i] = *(const u32x4*)(BM + go); }
#pragma unroll
            for (int i = 0; i < 2; ++i) { const int ci = c.tid + i * 512, row = ci >> 3, cc = ci & 7; pT[i] = *(const u32x4*)(BMT + ((size_t)bn * 512 + g * 128 + row) * 64 + cc * 8); }
            pX = *(const u32x4*)(XST + ((size_t)bn * 2048 + hd * 64 + (c.tid >> 3)) * 64 + (c.tid & 7) * 8); };
        fetch(0);
        const int sp_ = c.tid >> 3, snp = c.tid & 7; LAS float* SBf = (LAS float*)(c.lds + 108032);
        f32x4 shc[4]; bf16_t sbc = 0; float sdt = 0.f, sxv = 0.f; int sit = NS * 32;
#pragma unroll
        for (int i = 0; i < 4; ++i) shc[i] = (f32x4){0.f, 0.f, 0.f, 0.f};
#pragma unroll 1
        for (int n = 0; n < 32; ++n) {
            const int r0 = b * SEQL + n * 64;
            if (c.tid < 64) { const float dt = pdt; float ac = dt * A;
#pragma unroll
                for (int o = 1; o < 64; o <<= 1) { const float v = __shfl_up(ac, o); if (c.lane >= o) ac += v; }
                DTs[c.tid] = dt; ACs[c.tid] = ac; }
#pragma unroll
            for (int i = 0; i < 2; ++i) { const int ci = c.tid + i * 512, row = ci >> 4, cc = ci & 15; *(LAS u32x4*)(Cs + row * 272 + cc * 16) = pC[i]; *(LAS u32x4*)(Bs + row * 272 + cc * 16) = pB[i]; }
#pragma unroll
            for (int i = 0; i < 2; ++i) { const int ci = c.tid + i * 512, row = ci >> 3, cc = ci & 7; *(LAS u32x4*)(BTs + row * 144 + cc * 16) = pT[i]; }
            const int xrow = c.tid >> 3, xcc = c.tid & 7; const u32x4 xraw = pX;
            LDS_BAR();
            if ((n & 1) == 0) {
                sit = (it0 == c.bid) ? c.bid + (n >> 1) * c.G : NS * 32;
                if (sit < NS * 32) { const int s2 = sit >> 5, hd2 = sit & 31, g2 = hd2 >> 3, row2 = NP + s2;
                    if (c.tid < 128) sbc = BM[(size_t)row2 * 512 + g2 * 128 + c.tid]; else if (c.tid < 256) sbc = CM[(size_t)row2 * 512 + g2 * 128 + c.tid - 128];
                    const float* hp = H0 + ((size_t)sit * 64 + sp_) * 128 + snp * 16;
#pragma unroll
                    for (int i = 0; i < 4; ++i) shc[i] = *(const f32x4*)(hp + 4 * i);
                    sdt = DT[(size_t)row2 * 32 + hd2]; sxv = bf2f(XSN[(size_t)s2 * 2048 + hd2 * 64 + sp_]); }
            } else if (sit < NS * 32) { const int s2 = sit >> 5, hd2 = sit & 31, row2 = NP + s2;
                const float ea = __expf(-sdt * __expf(A_log[hd2])), Dk2 = Dsk[hd2], xdt = sxv * sdt;
                float* ho = sH + ((size_t)sit * 64 + sp_) * 128 + snp * 16; float yo = 0.f, cbp = 0.f;
#pragma unroll
                for (int i = 0; i < 4; ++i) { f32x4 o4;
#pragma unroll
                    for (int e = 0; e < 4; ++e) { const int nn = snp * 16 + 4 * i + e; const float bv = SBf[nn], cv = SBf[128 + nn]; yo += cv * shc[i][e]; cbp += cv * bv; o4[e] = ea * shc[i][e] + xdt * bv; }
                    *(f32x4*)(ho + 4 * i) = o4; }
                yo += __shfl_xor(yo, 1); yo += __shfl_xor(yo, 2); yo += __shfl_xor(yo, 4); cbp += __shfl_xor(cbp, 1); cbp += __shfl_xor(cbp, 2); cbp += __shfl_xor(cbp, 4);
                if (snp == 0) Y[(size_t)row2 * 2048 + hd2 * 64 + sp_] = (bf16_t)f2bf(cbp * xdt + ea * yo + Dk2 * sxv);
            }
            if (n + 1 < 32) fetch(n + 1);
            { float f[8], fd[8]; unpack8(xraw, f); const float al = ACs[63];
#pragma unroll
                for (int e = 0; e < 8; ++e) { const int s = xcc * 8 + e; f[e] *= DTs[s]; fd[e] = f[e] * __expf(al - ACs[s]); }
                *(LAS u32x4*)(XRs + xrow * 144 + xcc * 16) = xraw; *(LAS u32x4*)(XTs + xrow * 144 + xcc * 16) = pack8(f); *(LAS u32x4*)(XDs + xrow * 144 + xcc * 16) = pack8(fd); }
            LDS_BAR();
            const int li = w >> 1; float acl[4];
#pragma unroll
            for (int jj = 0; jj < 4; ++jj) acl[jj] = ACs[li * 16 + quad * 4 + jj];
            f32x4 aoff[2];
#pragma unroll
            for (int q2 = 0; q2 < 2; ++q2) { const int sj = 2 * (w & 1) + q2;
                if (sj <= li) { f32x4 a = {0.f, 0.f, 0.f, 0.f};
#pragma unroll
                    for (int ks = 0; ks < 4; ++ks) a = MFMA16(*(const LAS bf16x8*)(Cs + (li * 16 + lr) * 272 + ks * 64 + quad * 16), *(const LAS bf16x8*)(Bs + (sj * 16 + lr) * 272 + ks * 64 + quad * 16), a);
                    const int s = sj * 16 + lr; const float as = ACs[s];
#pragma unroll
                    for (int jj = 0; jj < 4; ++jj) { const int l = li * 16 + quad * 4 + jj; *(LAS bf16_t*)(Ms + l * 144 + s * 2) = (bf16_t)f2bf(l >= s ? a[jj] * __expf(acl[jj] - as) : 0.f); }
                } else {
#pragma unroll
                    for (int jj = 0; jj < 4; ++jj) *(LAS bf16_t*)(Ms + (li * 16 + quad * 4 + jj) * 144 + (sj * 16 + lr) * 2) = 0;
                }
                const int pj = 2 * (w & 1) + q2; f32x4 a2 = {0.f, 0.f, 0.f, 0.f};
#pragma unroll
                for (int ks = 0; ks < 4; ++ks) a2 = MFMA16(*(const LAS bf16x8*)(Cs + (li * 16 + lr) * 272 + ks * 64 + quad * 16), *(const LAS bf16x8*)(Hs + (pj * 16 + lr) * 272 + ks * 64 + quad * 16), a2);
                aoff[q2] = a2; }
            LDS_BAR();
#pragma unroll
            for (int q2 = 0; q2 < 2; ++q2) { const int pj = 2 * (w & 1) + q2; f32x4 a = {0.f, 0.f, 0.f, 0.f};
#pragma unroll
                for (int ks = 0; ks < 2; ++ks) a = MFMA16(*(const LAS bf16x8*)(Ms + (li * 16 + lr) * 144 + ks * 64 + quad * 16), *(const LAS bf16x8*)(XTs + (pj * 16 + lr) * 144 + ks * 64 + quad * 16), a);
                const u32x2 xr = *(const LAS u32x2*)(XRs + (pj * 16 + lr) * 144 + (li * 16 + quad * 4) * 2); const float xv[4] = {lo16(xr.x), hi16(xr.x), lo16(xr.y), hi16(xr.y)};
#pragma unroll
                for (int jj = 0; jj < 4; ++jj) { const float yv = a[jj] + __expf(acl[jj]) * aoff[q2][jj] + Dk * xv[jj];
                    Y[(size_t)(r0 + li * 16 + quad * 4 + jj) * 2048 + hd * 64 + pj * 16 + lr] = (bf16_t)f2bf(yv); } }
            { const float cd = __expf(ACs[63]);
#pragma unroll
                for (int pj = 0; pj < 4; ++pj) { hacc[pj] = hacc[pj] * cd;
#pragma unroll
                    for (int ks = 0; ks < 2; ++ks) hacc[pj] = MFMA16(*(const LAS bf16x8*)(BTs + (w * 16 + lr) * 144 + ks * 64 + quad * 16), *(const LAS bf16x8*)(XDs + (pj * 16 + lr) * 144 + ks * 64 + quad * 16), hacc[pj]); } }
            LDS_BAR();
#pragma unroll
            for (int pj = 0; pj < 4; ++pj) { u32x2 wv; wv.x = pk2(hacc[pj][0], hacc[pj][1]); wv.y = pk2(hacc[pj][2], hacc[pj][3]); *(LAS u32x2*)(Hs + (pj * 16 + lr) * 272 + (w * 16 + quad * 4) * 2) = wv; }
            if ((n & 1) == 0 && sit < NS * 32 && c.tid < 256) SBf[c.tid] = bf2f(sbc);
        }
#pragma unroll
        for (int pj = 0; pj < 4; ++pj) *(f32x4*)(pH + ((size_t)item * 64 + pj * 16 + lr) * 128 + w * 16 + quad * 4) = hacc[pj];
    }
    LAS float* Bf = (LAS float*)c.lds; LAS float* Cf = Bf + 128;
    {
        const int p = c.tid >> 3, np = c.tid & 7;
        f32x4 hn[4];
        const int it0 = c.bid < 256 ? c.bid + 16 * c.G : c.bid;
        if (it0 < NS * 32) { const float* hp = H0 + ((size_t)it0 * 64 + p) * 128 + np * 16;
#pragma unroll
            for (int i = 0; i < 4; ++i) hn[i] = *(const f32x4*)(hp + 4 * i); }
#pragma unroll 1
        for (int it = it0; it < NS * 32; it += c.G) {
            const int s = it >> 5, hd = it & 31, g = hd >> 3, row = NP + s;
            f32x4 hc[4];
#pragma unroll
            for (int i = 0; i < 4; ++i) hc[i] = hn[i];
            if (it + c.G < NS * 32) { const float* hp = H0 + ((size_t)(it + c.G) * 64 + p) * 128 + np * 16;
#pragma unroll
                for (int i = 0; i < 4; ++i) hn[i] = *(const f32x4*)(hp + 4 * i); }
            __syncthreads();
            if (c.tid < 128) Bf[c.tid] = bf2f(BM[(size_t)row * 512 + g * 128 + c.tid]); else if (c.tid < 256) Cf[c.tid - 128] = bf2f(CM[(size_t)row * 512 + g * 128 + c.tid - 128]);
            const float dt = DT[(size_t)row * 32 + hd], ea = __expf(-dt * __expf(A_log[hd])), Dk = Dsk[hd];
            const float xv = bf2f(XSN[(size_t)s * 2048 + hd * 64 + p]), xdt = xv * dt;
            __syncthreads();
            float* ho = sH + ((size_t)it * 64 + p) * 128 + np * 16;
            float yo = 0.f, cbp = 0.f;
#pragma unroll
            for (int i = 0; i < 4; ++i) { f32x4 o4;
#pragma unroll
                for (int e = 0; e < 4; ++e) { const int nn = np * 16 + 4 * i + e; const float bv = Bf[nn], cv = Cf[nn]; yo += cv * hc[i][e]; cbp += cv * bv; o4[e] = ea * hc[i][e] + xdt * bv; }
                *(f32x4*)(ho + 4 * i) = o4; }
            yo += __shfl_xor(yo, 1); yo += __shfl_xor(yo, 2); yo += __shfl_xor(yo, 4); cbp += __shfl_xor(cbp, 1); cbp += __shfl_xor(cbp, 2); cbp += __shfl_xor(cbp, 4);
            if (np == 0) Y[(size_t)row * 2048 + hd * 64 + p] = (bf16_t)f2bf(cbp * xdt + ea * yo + Dk * xv);
        }
    }
}
DI void ssd_post_phase(const Ctx& c, const bf16_t* Y, const bf16_t* ZB, const float* ng, bf16_t* YN) {
    for (int row = c.bid * 8 + c.wave; row < NR; row += c.G * 8) {
#pragma unroll
        for (int gi = 0; gi < 4; ++gi) { const int col = gi * 512 + c.lane * 8; float y[8], z[8];
            unpack8(*(const u32x4*)(Y + (size_t)row * 2048 + col), y); unpack8(*(const u32x4*)(ZB + (size_t)row * 2048 + col), z);
            float ss = 0.f;
#pragma unroll
            for (int e = 0; e < 8; ++e) { y[e] *= siluf_(z[e]); ss += y[e] * y[e]; }
            const float rstd = rsqrtf(wave_sum(ss) * (1.0f / 512.0f) + EPS);
#pragma unroll
            for (int e = 0; e < 8; ++e) y[e] = y[e] * rstd * ng[col + e];
            *(u32x4*)(YN + (size_t)row * 2048 + col) = pack8(y); }
    }
}
template <class Epi> DI void run_gemm(const Ctx& c, const bf16_t* A, int lda, const bf16_t* Bt, int ldb, int M, int N, int K, int ksh, int kmul, const Epi& E, int kmulb = 0, int bmask = 0x7fffffff) {
    asm volatile("" : "+s"(K));
    pg8::Gemm g{A, Bt, M, N, K, lda, ldb, ksh, kmul, kmulb, bmask}; pg8::StaticOrder S; S.init(M, N, c.G, c.bid);
    pg8::gemm_phase<Epi, pg8::StaticOrder>(c.lds, g, S, E, c.tid);
}
DI void res_gemm(const Ctx& c, const bf16_t* A, const bf16_t* Bt, int K, const float* bp, float* X, const float* gate, const float* nsc, const float* nsh, bf16_t* UB, float* xs, unsigned* cnt) {
    if (nsc != nullptr) { EpiResNorm E{bp, X, gate, nsc, nsh, UB, xs, cnt}; run_gemm(c, A, K, Bt, K, NP, 1024, K, 0, 0, E); }
    else { EpiRes E{bp, X + (size_t)NP * D, X, gate}; run_gemm(c, A, K, Bt, K, NP, 1024, K, 0, 0, E); }
    { EpiResAtomic E{X, gate}; run_gemm(c, A + (size_t)NP * K, K, Bt, K, 256, 4 * K, 256, 2, 256, E, 256, 3); }
}
#define B_X ((float*)(ws + WS_X))
#define B_UB ((bf16_t*)(ws + WS_UB))
#define B_P ((bf16_t*)(ws + WS_P))
#define B_S (ws + WS_S)
#define B_MOD ((float*)(ws + WS_MOD))
#define B_MODL (B_MOD + (size_t)L * NSEQ * MODW)
#define B_XP (L == 0 ? GIN(0) : (const float*)B_X)
#define B_XS (L == 0 ? GIN(1) : (const float*)(B_X + (size_t)NP * D))
#define B_XB ((bf16_t*)B_S)
#define B_LA ((float*)(B_S + (size_t)RP * 1024 * 2))
#define B_BX ((float*)(B_S + (size_t)RP * 1024 * 6))
#define B_Q ((bf16_t*)B_S)
#define B_K (B_Q + (size_t)RP * D)
#define B_V (B_Q + (size_t)2 * RP * D)
#define B_GATE (B_Q + (size_t)3 * RP * D)
#define B_QKG (B_Q + (size_t)4 * RP * D)
#define B_AB ((float*)(ws + WS_AB))
#define B_GB ((float*)(ws + WS_GB))
#define B_GL ((float*)(ws + WS_GL))
#define B_QKVS ((bf16_t*)(ws + WS_QKVS))
#define B_UT ((float*)B_P)
#define B_NW ((bf16_t*)(ws + WS_P + (size_t)NP * D * 4))
#define B_QD (B_NW + (size_t)NP * D)
#define B_KDT (B_NW + (size_t)2 * NP * D)
#define B_OF ((float*)B_S)
#define B_XST ((bf16_t*)B_S)
#define B_BM (B_XST + (size_t)NP * 2048)
#define B_CM (B_BM + (size_t)RP * 512)
#define B_BMT (B_CM + (size_t)RP * 512)
#define B_ZB (B_P + (size_t)RP * 3072)
#define B_YN ((bf16_t*)B_S)
#define B_DTR ((float*)(ws + WS_DTR))
#define B_DT ((float*)(ws + WS_DT))
#define B_XSN ((bf16_t*)(ws + WS_XSN))
__global__ void __launch_bounds__(512, 2) mega(Args a) {
    extern __shared__ __attribute__((aligned(16))) unsigned char lds_raw[];
    cg::grid_group grid = cg::this_grid();
    Ctx c0; c0.lds = (ldsp)lds_raw; c0.tid = threadIdx.x; c0.lane = c0.tid & 63; c0.wave = __builtin_amdgcn_readfirstlane(c0.tid >> 6); c0.bid = blockIdx.x; c0.G = gridDim.x;
    int ph = 0; const int lo = a.lo, hi = a.hi;
    volatile LAS unsigned* bst = (volatile LAS unsigned*)(c0.lds + 131072);
    if (c0.tid < 2) bst[c0.tid] = 0u;
    __syncthreads();
    XcdBarrier xbar = xcd_barrier_post((unsigned*)(a.ws + WS_BAR), bst);
    if (a.lo == 0x7fffffff) grid.sync();
#ifndef REPMASK
#define REPMASK 0ull
#endif
#ifndef SYNCREP
#define SYNCREP 1
#endif
#define PH_BEGIN if (ph >= lo && ph < hi) { const int nrep_ = ((REPMASK >> ph) & 1ull) ? 2 : 1; for (int rep_ = 0; rep_ < nrep_; ++rep_) { if (rep_) xcd_barrier(xbar); const __attribute__((address_space(4))) Args* ap_ = (const __attribute__((address_space(4))) Args*)__builtin_amdgcn_kernarg_segment_ptr(); asm volatile("" : "+s"(ap_)); const __attribute__((address_space(4))) Args& a = *ap_; Ctx c = c0; GAS unsigned char* wsg_ = (GAS unsigned char*)a.ws; GAS float* outg_ = (GAS float*)a.out; asm volatile("" : "+s"(wsg_)); asm volatile("" : "+s"(outg_)); unsigned char* ws = (unsigned char*)wsg_; float* out = (float*)outg_; { int t_ = c0.tid; asm volatile("" : "+v"(t_)); asm volatile("" : "+s"(c.G)); asm volatile("" : "+s"(c.bid)); c.tid = t_; c.lane = t_ & 63; c.wave = __builtin_amdgcn_readfirstlane(t_ >> 6); } (void)out;
#define PH_END } if (ph + 1 < hi) { for (int s_ = 0; s_ < SYNCREP; ++s_) { xcd_barrier(xbar); } } } ++ph;

    PH_BEGIN prep_phase(c, a, true);
#ifdef PREP2
    __syncthreads(); prep_phase(c, a, false);
#endif
    PH_END
    PH_BEGIN { EpiMod E{B_MOD, GIN(11)}; run_gemm(c, (const bf16_t*)(ws + WS_SC), 1024, B_P, 1024, 256, 4 * MODW, 1024, 0, 0, E); } PH_END
#pragma unroll 1
    for (int L = 0; L < 4; ++L) {
        const int kind = L % 3, j = L / 3;
        PH_BEGIN norm_mod_phase(c, B_XP, B_XS, B_MODL + 1024, B_MODL, B_UB, (L > 0 && c.G == 256) ? NP : 0); PH_END
        PH_BEGIN {
            EpiSplit E; const bf16_t* Bt; int N;
            if (kind == 0) { E = EpiSplit{1, B_P, 2048, 1024, B_P + 1024, 2048, 2048, nullptr, 0, 0}; Bt = (const bf16_t*)(ws + WS_RGIN) + (size_t)j * 2048 * 1024; N = 2048; }
            else if (kind == 1) { E = EpiSplit{0, B_P, 3072, 3072, B_GATE, 1024, 4096, B_AB, 16, 16}; Bt = (const bf16_t*)(ws + WS_GDNIN); N = GDN_NP; }
            else { E = EpiSplit{0, B_ZB, 2048, 2048, B_P, 3072, 5120, B_DTR, 32, 32}; Bt = (const bf16_t*)(ws + WS_SSDIN); N = SSD_NP; }
            run_gemm(c, B_UB, 1024, Bt, 1024, RP, N, 1024, 0, 0, E); } PH_END
        if (kind == 0) {
            PH_BEGIN rg_conv_phase(c, B_P, GIN(16) + j * 4 * D, GIN(17) + j * D, GIN(2) + (size_t)j * NS * 3 * D, B_XB, out + O_PRGC + j * 8 * 3 * D, out + O_SRGC + j * NS * 3 * D); PH_END
            PH_BEGIN { EpiGate E{B_XB, GIN(19) + j * 2 * D, (const float*)(ws + WS_LS8) + j * D, B_LA, B_BX}; run_gemm(c, B_XB, 1024, (const bf16_t*)(ws + WS_RGGATE) + (size_t)j * 2048 * 256, 256, RP, 2048, 256, 1, 256, E); } PH_END
            PH_BEGIN rg_scan_phase(c, B_LA, B_BX, B_P, GIN(3) + (size_t)j * NS * D, B_UB, out + O_PRGH + j * 8 * D, out + O_SRGH + j * NS * D); PH_END
        } else if (kind == 1) {
            PH_BEGIN gdn_conv_phase(c, B_P, GIN(23), GIN(4), B_AB, GIN(24), GIN(25), B_Q, B_K, B_V, B_QKVS, B_GB, out + O_PGDC, out + O_SGDC); PH_END
            PH_BEGIN gdn_prep_phase(c, B_Q, B_K, B_V, B_GB, B_UT, B_NW, B_QD, B_KDT, B_QKG, B_GL); PH_END
            PH_BEGIN gdn_seq_phase(c, B_UT, B_NW, B_QD, B_KDT, B_QKG, B_GL, B_OF, out + O_PGDS, B_QKVS, B_GB, GIN(5), out + O_SGDS); PH_END
            PH_BEGIN gdn_post_phase(c, B_OF, B_GATE, GIN(26), B_UB); PH_END
        } else {
            PH_BEGIN ssd_conv_phase(c, B_P, GIN(29), GIN(30), GIN(6), B_DTR, GIN(32), B_BM, B_CM, B_XSN, B_DT, B_XST, B_BMT, out + O_PSSC, out + O_SSSC); PH_END
            PH_BEGIN ssd_seq_phase(c, B_XST, B_BM, B_CM, B_BMT, B_DT, GIN(31), GIN(33), B_P, out + O_PSSH, B_XSN, GIN(7), out + O_SSSH); PH_END
            PH_BEGIN ssd_post_phase(c, B_P, B_ZB, GIN(34), B_YN); PH_END
        }
        PH_BEGIN {
            const bf16_t* oA = kind == 2 ? B_YN : B_UB; const int oK = kind == 2 ? 2048 : 1024;
            const bf16_t* oB = kind == 0 ? (const bf16_t*)(ws + WS_RGOUT) + (size_t)j * 1024 * 1024 : (kind == 1 ? (const bf16_t*)(ws + WS_GDNOUT) : (const bf16_t*)(ws + WS_SSDOUT));
            const bool fuse = c.G == 256;
            res_gemm(c, oA, oB, oK, B_XP, B_X, B_MODL + 2048, fuse ? B_MODL + 4 * 1024 : nullptr, B_MODL + 3 * 1024, B_UB, (float*)(ws + WS_XS), (unsigned*)(ws + WS_CNT) + (size_t)(2 * L) * 4096); } PH_END
        PH_BEGIN norm_mod_phase(c, B_X, B_X + (size_t)NP * D, B_MODL + 4 * 1024, B_MODL + 3 * 1024, B_UB, c.G == 256 ? NP : 0); PH_END
        PH_BEGIN { EpiSplit E{2, B_P, 4096, 4096, nullptr, 0, 4096, nullptr, 0, 0}; run_gemm(c, B_UB, 1024, (const bf16_t*)(ws + WS_WUP) + (size_t)L * 4096 * 1024, 1024, RP, 4096, 1024, 0, 0, E); } PH_END
        PH_BEGIN { const bool fuse = c.G == 256 && L < 3; const float* modN = B_MOD + (size_t)(L + 1) * NSEQ * MODW;
            res_gemm(c, B_P, (const bf16_t*)(ws + WS_WDN) + (size_t)L * 4096 * 1024, 4096, B_X, B_X, B_MODL + 5 * 1024, fuse ? modN + 1024 : nullptr, modN, B_UB, (float*)(ws + WS_XS), (unsigned*)(ws + WS_CNT) + (size_t)(2 * L + 1) * 4096); } PH_END
    }
    PH_BEGIN final_norm_phase(c, B_X, GIN(14), out + O_Y); PH_END
}
constexpr int N_PHASES = 40;

extern "C" void kernel_launch(void* const* d_in, const int* in_sizes, int n_in, void* d_out, int out_size, void* d_ws, size_t ws_size, hipStream_t stream) {
    static int grid = 0;
    if (grid == 0) {
        int dev = 0, cus = 0, per_cu = 0;
        (void)hipGetDevice(&dev);
        (void)hipDeviceGetAttribute(&cus, hipDeviceAttributeMultiprocessorCount, dev);
        (void)hipFuncSetAttribute((const void*)mega, hipFuncAttributeMaxDynamicSharedMemorySize, LDS_BYTES);
        (void)hipOccupancyMaxActiveBlocksPerMultiprocessor(&per_cu, (const void*)mega, 512, LDS_BYTES);
        if (per_cu < 1) { fprintf(stderr, "kernel_launch: occupancy query reports %d blocks/CU\n", per_cu); }
        grid = cus > 0 ? cus : 256;
        if (ws_size < WS_END) { fprintf(stderr, "kernel_launch: workspace too small: need %zu, have %zu\n", (size_t)WS_END, ws_size); grid = -1; }
        if (n_in != 36) { fprintf(stderr, "kernel_launch: expected 36 inputs, got %d\n", n_in); grid = -1; }
    }
    if (grid < 0) return;
    Args a{};
    for (int i = 0; i < 36; ++i) a.in[i] = (const float*)d_in[i];
    a.out = (float*)d_out; a.ws = (unsigned char*)d_ws; a.lo = 0; a.hi = N_PHASES;
    (void)hipMemsetAsync((unsigned char*)d_ws + WS_BAR, 0, 16384, stream);
    void* args[] = {&a};
    hipError_t e = hipLaunchCooperativeKernel((const void*)mega, dim3(grid), dim3(512), args, LDS_BYTES, stream);
    if (e != hipSuccess) fprintf(stderr, "kernel_launch: cooperative launch failed: %s (grid %d)\n", hipGetErrorString(e), grid);
}
```
